# Optimizing an MI355X kernel written in HIP

```python
import jax
import jax.numpy as jnp
from jax import lax
import numpy as np

D_MODEL = 1024
BATCH = 4
SEQ = 8192
DEPTH = 1

ML_HEADS = 4
ML_HEAD_DIM = 128
ML_WIDTH = ML_HEADS * ML_HEAD_DIM
ML_CHUNK = 128
CONV_WIDTH = 4
ATT_Q_HEADS = 8
ATT_KV_HEADS = 2
ATT_HEAD_DIM = 64
ATT_WIDTH = ATT_Q_HEADS * ATT_HEAD_DIM
ATT_KV_WIDTH = ATT_KV_HEADS * ATT_HEAD_DIM
WINDOW = 128
ROPE_THETA = 10000.0
D_MIX = ML_WIDTH + ATT_WIDTH
COL_SIZES = (2 * ML_WIDTH, ML_WIDTH, ML_WIDTH, ML_HEADS, ML_HEADS, ATT_WIDTH, ATT_KV_WIDTH, ATT_KV_WIDTH)
SPLIT_POINTS = tuple(sum(COL_SIZES[:i + 1]) for i in range(len(COL_SIZES) - 1))
D_IN_PROJ = sum(COL_SIZES)
N_GROUPS = 4
EXPERTS_PER_GROUP = 8
N_EXPERTS = N_GROUPS * EXPERTS_PER_GROUP
TOP_K_INNER = 2
D_EXPERT = 256
LN_EPS = 1e-5
ALPHA = (2.0 * DEPTH) ** 0.25
BETA = (8.0 * DEPTH) ** -0.25

kernel_name = "hymba_mlstm_swa_hiermoe_deepnorm"


def layer_norm(x, w, b):
    xf = x.astype(jnp.float32)
    mu = jnp.mean(xf, axis=-1, keepdims=True)
    var = jnp.mean(jnp.square(xf - mu), axis=-1, keepdims=True)
    return ((xf - mu) * lax.rsqrt(var + LN_EPS) * w + b).astype(x.dtype)


def causal_depthwise_conv(u, w, b):
    S = u.shape[1]
    up = jnp.pad(u, ((0, 0), (CONV_WIDTH - 1, 0), (0, 0)))
    out = b
    for j in range(CONV_WIDTH):
        out = out + w[j] * up[:, j:j + S]
    return out


def _to_chunks(a):
    B, S, H = a.shape[:3]
    a = a.reshape((B, S // ML_CHUNK, ML_CHUNK, H) + a.shape[3:])
    perm = (1, 0, 3, 2) + tuple(range(4, a.ndim))
    return a.transpose(perm)


def mlstm_chunkwise(q, k, v, i_pre, f_pre):
    B, S, H, D = q.shape
    L = ML_CHUNK
    f32 = jnp.float32
    qc = _to_chunks(q.astype(f32))
    kc = _to_chunks(k.astype(f32) * (D ** -0.5))
    vc = _to_chunks(v.astype(f32))
    ic = _to_chunks(i_pre.astype(f32))
    lfc = _to_chunks(jax.nn.log_sigmoid(f_pre.astype(f32)))
    causal = jnp.tril(jnp.ones((L, L), dtype=bool))

    def step(carry, xs):
        C, n, m = carry
        q_, k_, v_, i_, lf_ = xs
        b = jnp.cumsum(lf_, axis=-1)
        log_intra = jnp.where(causal, b[..., :, None] - b[..., None, :] + i_[..., None, :], -jnp.inf)
        log_inter = b + m[..., None]
        m_row = jnp.maximum(log_inter, jnp.max(log_intra, axis=-1))
        w_intra = jnp.exp(log_intra - m_row[..., None])
        w_inter = jnp.exp(log_inter - m_row)
        s = jnp.einsum("bhld,bhsd->bhls", q_, k_) * w_intra
        num = (w_inter[..., None] * jnp.einsum("bhed,bhld->bhle", C, q_)
               + jnp.einsum("bhls,bhse->bhle", s, v_))
        den = w_inter * jnp.einsum("bhd,bhld->bhl", n, q_) + jnp.sum(s, axis=-1)
        h = num / jnp.maximum(jnp.abs(den), jnp.exp(-m_row))[..., None]
        b_last = b[..., -1]
        log_w = b_last[..., None] - b + i_
        m_new = jnp.maximum(b_last + m, jnp.max(log_w, axis=-1))
        decay = jnp.exp(b_last + m - m_new)
        w = jnp.exp(log_w - m_new[..., None])
        C_new = decay[..., None, None] * C + jnp.einsum("bhs,bhse,bhsd->bhed", w, v_, k_)
        n_new = decay[..., None] * n + jnp.einsum("bhs,bhsd->bhd", w, k_)
        return (C_new, n_new, m_new), h

    init = (jnp.zeros((B, H, D, D), f32), jnp.zeros((B, H, D), f32), jnp.zeros((B, H), f32))
    _, hc = lax.scan(step, init, (qc, kc, vc, ic, lfc))
    return hc.transpose(1, 0, 3, 2, 4).reshape(B, S, H, D)


def rope(x):
    S, D = x.shape[1], x.shape[3]
    half = D // 2
    inv_freq = ROPE_THETA ** (-jnp.arange(half, dtype=jnp.float32) / half)
    ang = jnp.arange(S, dtype=jnp.float32)[:, None] * inv_freq[None, :]
    cos = jnp.cos(ang)[None, :, None, :]
    sin = jnp.sin(ang)[None, :, None, :]
    xf = x.astype(jnp.float32)
    x1, x2 = xf[..., :half], xf[..., half:]
    return jnp.concatenate([x1 * cos - x2 * sin, x1 * sin + x2 * cos], axis=-1).astype(x.dtype)


def swa_with_sinks(q, k, v, sinks):
    B, S, HQ, D = q.shape
    HKV = k.shape[2]
    G = HQ // HKV
    Lb = WINDOW
    NB = S // Lb
    qb = q.reshape(B, NB, Lb, HKV, G, D)
    kb = k.reshape(B, NB, Lb, HKV, D)
    vb = v.reshape(B, NB, Lb, HKV, D)
    pad = ((0, 0), (1, 0), (0, 0), (0, 0), (0, 0))
    kk = jnp.concatenate([jnp.pad(kb, pad)[:, :-1], kb], axis=2)
    vv = jnp.concatenate([jnp.pad(vb, pad)[:, :-1], vb], axis=2)
    scores = jnp.einsum("bnqhgd,bnkhd->bnhgqk", qb, kk).astype(jnp.float32) * (D ** -0.5)
    qi = jnp.arange(Lb)[:, None]
    kj = jnp.arange(2 * Lb)[None, :]
    diff = Lb + qi - kj
    band = (diff >= 0) & (diff < WINDOW)
    blk = jnp.arange(NB)[:, None, None]
    valid = band[None] & ((blk * Lb + kj[None] - Lb) >= 0)
    scores = jnp.where(valid[None, :, None, None], scores, -jnp.inf)
    sink = jnp.broadcast_to(sinks.astype(jnp.float32).reshape(1, 1, HKV, G, 1, 1),
                            scores.shape[:-1] + (1,))
    probs = jax.nn.softmax(jnp.concatenate([scores, sink], axis=-1), axis=-1)[..., :-1]
    out = jnp.einsum("bnhgqk,bnkhd->bnqhgd", probs.astype(v.dtype), vv)
    return out.reshape(B, S, HQ * D)


def hybrid_mixer(x, w_in, conv_w, conv_b, gate_bias, norm_w, sinks, w_out):
    B, S, _ = x.shape
    proj = x @ w_in
    ml_qk, ml_v, ml_o, ml_i, ml_f, a_q, a_k, a_v = jnp.split(proj, SPLIT_POINTS, axis=-1)
    ml_qk = jax.nn.silu(causal_depthwise_conv(ml_qk, conv_w, conv_b))
    ml_q, ml_k = jnp.split(ml_qk, 2, axis=-1)
    hd = (B, S, ML_HEADS, ML_HEAD_DIM)
    h = mlstm_chunkwise(ml_q.reshape(hd), ml_k.reshape(hd), ml_v.reshape(hd),
                        ml_i + gate_bias[0], ml_f + gate_bias[1])
    mu = jnp.mean(h, axis=-1, keepdims=True)
    var = jnp.mean(jnp.square(h - mu), axis=-1, keepdims=True)
    h = ((h - mu) * lax.rsqrt(var + LN_EPS)).reshape(B, S, ML_WIDTH) * norm_w
    ml_out = (jax.nn.sigmoid(ml_o.astype(jnp.float32)) * h).astype(x.dtype)
    q = rope(a_q.reshape(B, S, ATT_Q_HEADS, ATT_HEAD_DIM))
    k = rope(a_k.reshape(B, S, ATT_KV_HEADS, ATT_HEAD_DIM))
    v = a_v.reshape(B, S, ATT_KV_HEADS, ATT_HEAD_DIM)
    att_out = swa_with_sinks(q, k, v, sinks)
    return jnp.concatenate([ml_out, att_out], axis=-1) @ w_out


def hierarchical_moe(x, w_group_router, b_group_router, w_expert_router, b_expert_router,
                     w_exp_gate, w_exp_up, w_exp_down):
    B, S, Dm = x.shape
    xt = x.reshape(B * S, Dm)
    g_logits = (xt @ w_group_router + b_group_router).astype(jnp.float32)
    g_prob = jax.nn.softmax(g_logits, axis=-1)
    g_idx = jnp.argmax(g_logits, axis=-1)
    g_p = jnp.take_along_axis(g_prob, g_idx[:, None], axis=-1)[:, 0]
    e_logits = (xt @ w_expert_router + b_expert_router).astype(jnp.float32)
    e_logits = e_logits.reshape(-1, N_GROUPS, EXPERTS_PER_GROUP)
    e_in = jnp.take_along_axis(e_logits, g_idx[:, None, None], axis=1)[:, 0]
    top_v, top_i = lax.top_k(e_in, TOP_K_INNER)
    top_w = jax.nn.softmax(top_v, axis=-1) * g_p[:, None]
    expert_id = g_idx[:, None] * EXPERTS_PER_GROUP + top_i
    combine = jnp.sum(jax.nn.one_hot(expert_id, N_EXPERTS, dtype=jnp.float32) * top_w[..., None],
                      axis=1).astype(x.dtype)
    out = jnp.zeros_like(xt)
    for e in range(N_EXPERTS):
        h = jax.nn.silu(xt @ w_exp_gate[e]) * (xt @ w_exp_up[e])
        out = out + combine[:, e:e + 1] * (h @ w_exp_down[e])
    return out.reshape(B, S, Dm)


def setup_inputs(seed: int = 0) -> dict:
    key = jax.random.key(seed)
    ks = jax.random.split(key, 21)
    f32 = jnp.float32

    def nrm(k, shape, scale):
        return jax.random.normal(k, shape, f32) * scale

    x = nrm(ks[0], (BATCH, SEQ, D_MODEL), 1.0)
    w_in = nrm(ks[1], (DEPTH, D_MODEL, D_IN_PROJ), D_MODEL ** -0.5)
    conv_w = nrm(ks[2], (DEPTH, CONV_WIDTH, 2 * ML_WIDTH), CONV_WIDTH ** -0.5)
    conv_b = nrm(ks[3], (DEPTH, 2 * ML_WIDTH), 0.02)
    i_bias = nrm(ks[4], (DEPTH, ML_HEADS), 0.1)
    f_bias = jnp.linspace(3.0, 6.0, ML_HEADS, dtype=f32)[None, :] + nrm(ks[5], (DEPTH, ML_HEADS), 0.1)
    mlstm_gate_bias = jnp.stack([i_bias, f_bias], axis=1)
    mlstm_norm_w = 1.0 + nrm(ks[6], (DEPTH, ML_WIDTH), 0.02)
    attn_sinks = nrm(ks[7], (DEPTH, ATT_Q_HEADS), 0.5)
    w_out = nrm(ks[8], (DEPTH, D_MIX, D_MODEL), (D_MIX ** -0.5) * BETA)
    ln1_w = 1.0 + nrm(ks[9], (DEPTH, D_MODEL), 0.02)
    ln1_b = nrm(ks[10], (DEPTH, D_MODEL), 0.02)
    w_group_router = nrm(ks[11], (DEPTH, D_MODEL, N_GROUPS), D_MODEL ** -0.5)
    b_group_router = nrm(ks[12], (DEPTH, N_GROUPS), 0.01)
    w_expert_router = nrm(ks[13], (DEPTH, D_MODEL, N_EXPERTS), D_MODEL ** -0.5)
    b_expert_router = nrm(ks[14], (DEPTH, N_EXPERTS), 0.01)
    w_exp_gate = nrm(ks[15], (DEPTH, N_EXPERTS, D_MODEL, D_EXPERT), D_MODEL ** -0.5)
    w_exp_up = nrm(ks[16], (DEPTH, N_EXPERTS, D_MODEL, D_EXPERT), D_MODEL ** -0.5)
    w_exp_down = nrm(ks[17], (DEPTH, N_EXPERTS, D_EXPERT, D_MODEL), (D_EXPERT ** -0.5) * BETA)
    ln2_w = 1.0 + nrm(ks[18], (DEPTH, D_MODEL), 0.02)
    ln2_b = nrm(ks[19], (DEPTH, D_MODEL), 0.02)
    return {"x": x, "w_in": w_in, "conv_w": conv_w, "conv_b": conv_b,
            "mlstm_gate_bias": mlstm_gate_bias, "mlstm_norm_w": mlstm_norm_w,
            "attn_sinks": attn_sinks, "w_out": w_out, "ln1_w": ln1_w, "ln1_b": ln1_b,
            "w_group_router": w_group_router, "b_group_router": b_group_router,
            "w_expert_router": w_expert_router, "b_expert_router": b_expert_router,
            "w_exp_gate": w_exp_gate, "w_exp_up": w_exp_up, "w_exp_down": w_exp_down,
            "ln2_w": ln2_w, "ln2_b": ln2_b}


def reference(x, w_in, conv_w, conv_b, mlstm_gate_bias, mlstm_norm_w, attn_sinks, w_out,
              ln1_w, ln1_b, w_group_router, b_group_router, w_expert_router, b_expert_router,
              w_exp_gate, w_exp_up, w_exp_down, ln2_w, ln2_b):
    for l in range(DEPTH):
        y = hybrid_mixer(x, w_in[l], conv_w[l], conv_b[l], mlstm_gate_bias[l], mlstm_norm_w[l],
                         attn_sinks[l], w_out[l])
        x = layer_norm(ALPHA * x + y, ln1_w[l], ln1_b[l])
        y = hierarchical_moe(x, w_group_router[l], b_group_router[l], w_expert_router[l],
                             b_expert_router[l], w_exp_gate[l], w_exp_up[l], w_exp_down[l])
        x = layer_norm(ALPHA * x + y, ln2_w[l], ln2_b[l])
    return x
```

```cpp
#include <hip/hip_runtime.h>
#include <cstdio>
#include <cstdint>

typedef unsigned short bf16_t;

constexpr int BATCH = 4, SEQ = 8192, T = BATCH * SEQ, DM = 1024;
constexpr int MLH = 4, MLD = 128, MLW = 512;
constexpr int AQH = 8, AKH = 2, AHD = 64;
constexpr int DIN = 2824;
constexpr int NV = 2816;
constexpr int NGRP = 4, EPG = 8, NEXP = 32, DEXP = 256;
constexpr float LN_EPS = 1e-5f;
constexpr float ALPHA = 1.189207115002721f;
constexpr int PC_MQ = 0, PC_MK = 512, PC_MV = 1024, PC_MO = 1536, PC_AQ = 2048, PC_AK = 2560, PC_AV = 2688;

constexpr size_t MiB = 1u << 20;
constexpr size_t WS_CTL = 0, WS_TAB = 1 * MiB, WS_GATES = 3 * MiB, WS_RT = 4 * MiB, WS_MISC = 5 * MiB;
constexpr size_t WS_WIN = 8 * MiB, WS_WOUT = 14 * MiB, WS_WGU = 16 * MiB, WS_WD = 48 * MiB;
constexpr size_t WS_PROJ = 64 * MiB, WS_X1F = 64 * MiB, WS_Y = 192 * MiB;
constexpr size_t WS_MIX = 240 * MiB, WS_CST = 304 * MiB, WS_H = 340 * MiB, WS_X1B = 376 * MiB, WS_END = 440 * MiB;

struct P {
    const float *x, *w_in, *conv_w, *conv_b, *gate_bias, *norm_w, *sinks, *w_out, *ln1_w, *ln1_b;
    const float *w_gr, *b_gr, *w_er, *b_er, *w_eg, *w_eu, *w_ed, *ln2_w, *ln2_b;
    float* out; unsigned char* ws;
};

__device__ __forceinline__ float bf2f(bf16_t v) { return __uint_as_float((unsigned)v << 16); }
__device__ __forceinline__ bf16_t f2bf(float f) { unsigned u = __float_as_uint(f); return (bf16_t)((u + 0x7fffu + ((u >> 16) & 1u)) >> 16); }
__device__ __forceinline__ float wave_sum(float v) {
#pragma unroll
    for (int o = 1; o < 64; o <<= 1) v += __shfl_xor(v, o);
    return v;
}
__device__ __forceinline__ float wave_max(float v) {
#pragma unroll
    for (int o = 1; o < 64; o <<= 1) v = fmaxf(v, __shfl_xor(v, o));
    return v;
}
__device__ __forceinline__ float silu_f(float v) { return v / (1.f + expf(-v)); }
__device__ __forceinline__ float sigmoid_f(float v) { return 1.f / (1.f + expf(-v)); }
__device__ __forceinline__ float logsigmoid_f(float v) { return fminf(v, 0.f) - log1pf(expf(-fabsf(v))); }
__device__ __forceinline__ int rope_pos(int d) { return d < 32 ? 8 * (d >> 2) + (d & 3) : 8 * ((d - 32) >> 2) + 4 + (d & 3); }
__device__ __forceinline__ int vcol_to_orig(int v) { return v < 2048 ? v : (v < NV ? v + 8 : v - NV + 2048); }

__device__ void ph_tab(const P& p, int bid, int nb) {
    float2* tab = (float2*)(p.ws + WS_TAB);
    for (int i = bid * 512 + threadIdx.x; i < SEQ * 32; i += nb * 512) {
        const int pos = i >> 5, f = i & 31;
        const double ang = (double)pos * pow(10000.0, -(double)f / 32.0);
        tab[i] = make_float2((float)cos(ang), (float)sin(ang));
    }
}

template <class AF, class BF>
__device__ __forceinline__ void naive_tile(AF af, BF bfn, int row0, int col0, int K, float* As, float* Bs, float* Ct) {
    const int tid = threadIdx.x, ty = tid >> 4, tx = tid & 15;
    float acc[4][4];
#pragma unroll
    for (int i = 0; i < 4; ++i)
#pragma unroll
        for (int j = 0; j < 4; ++j) acc[i][j] = 0.f;
    for (int k0 = 0; k0 < K; k0 += 16) {
#pragma unroll
        for (int i = 0; i < 4; ++i) { const int e = tid + 512 * i, r = e >> 4, kk = e & 15; As[kk * 132 + r] = af(row0 + r, k0 + kk); }
#pragma unroll
        for (int i = 0; i < 2; ++i) { const int e = tid + 512 * i, kk = e >> 6, c = e & 63; Bs[kk * 64 + c] = bfn(k0 + kk, col0 + c); }
        __syncthreads();
#pragma unroll
        for (int kk = 0; kk < 16; ++kk) {
            float a[4], b[4];
#pragma unroll
            for (int i = 0; i < 4; ++i) { a[i] = As[kk * 132 + 4 * ty + i]; b[i] = Bs[kk * 64 + 4 * tx + i]; }
#pragma unroll
            for (int i = 0; i < 4; ++i)
#pragma unroll
                for (int j = 0; j < 4; ++j) acc[i][j] += a[i] * b[j];
        }
        __syncthreads();
    }
#pragma unroll
    for (int i = 0; i < 4; ++i)
#pragma unroll
        for (int j = 0; j < 4; ++j) Ct[(4 * ty + i) * 65 + 4 * tx + j] = acc[i][j];
    __syncthreads();
}

__device__ void ph_inproj_naive(const P& p, unsigned char* lds, int bid, int nb) {
    float* As = (float*)lds; float* Bs = As + 16 * 132; float* Ct = Bs + 16 * 64;
    bf16_t* proj = (bf16_t*)(p.ws + WS_PROJ);
    float* gates = (float*)(p.ws + WS_GATES);
    const float2* tab = (const float2*)(p.ws + WS_TAB);
    const float* x = p.x; const float* w = p.w_in;
    constexpr int NCT = (DIN + 63) / 64;
    const int ntiles = (T / 128) * NCT;
    const int tid = threadIdx.x;
    for (int it = bid; it < ntiles; it += nb) {
        const int rt = it / NCT, ct = it % NCT, row0 = rt * 128, col0 = ct * 64;
        naive_tile([&](int r, int k) { return x[(size_t)r * DM + k]; },
                   [&](int k, int vc) { return vc < DIN ? w[(size_t)k * DIN + vcol_to_orig(vc)] : 0.f; },
                   row0, col0, DM, As, Bs, Ct);
        if (col0 >= NV) {
            for (int e = tid; e < 128 * 8; e += 512) { const int r = e >> 3, c = e & 7; gates[(size_t)(row0 + r) * 8 + c] = Ct[r * 65 + c] + p.gate_bias[c]; }
        } else if (col0 >= PC_AQ && col0 < PC_AV) {
            for (int e = tid; e < 128 * 32; e += 512) {
                const int r = e >> 5, d = e & 31; const int pos = (row0 + r) & (SEQ - 1);
                const float2 cs = tab[pos * 32 + d]; const float x1 = Ct[r * 65 + d], x2 = Ct[r * 65 + d + 32];
                bf16_t* o = proj + (size_t)(row0 + r) * NV + col0;
                o[rope_pos(d)] = f2bf(x1 * cs.x - x2 * cs.y); o[rope_pos(d + 32)] = f2bf(x1 * cs.y + x2 * cs.x);
            }
        } else {
            for (int e = tid; e < 128 * 64; e += 512) { const int r = e >> 6, c = e & 63; proj[(size_t)(row0 + r) * NV + col0 + c] = f2bf(Ct[r * 65 + c]); }
        }
        __syncthreads();
    }
}

__device__ void ph_mlstm_naive(const P& p, unsigned char* lds, int bid, int nb) {
    constexpr int TB = 16;
    float* qs = (float*)lds;
    float* ks = qs + TB * 128;
    float* vs = ks + TB * 128;
    float* hs = vs + TB * 128;
    float* gi = hs + TB * 128;
    float* gl = gi + TB;
    const bf16_t* proj = (const bf16_t*)(p.ws + WS_PROJ);
    const float* gates = (const float*)(p.ws + WS_GATES);
    bf16_t* mix = (bf16_t*)(p.ws + WS_MIX);
    const int tid = threadIdx.x, lane = tid & 63, wv = tid >> 6;
    const int e = tid >> 2, dq = tid & 3;
    for (int it = bid; it < BATCH * MLH; it += nb) {
        const int b = it / MLH, h = it % MLH;
        float C[32], n[32];
#pragma unroll
        for (int j = 0; j < 32; ++j) { C[j] = 0.f; n[j] = 0.f; }
        float m = 0.f;
        for (int t0 = 0; t0 < SEQ; t0 += TB) {
            for (int idx = tid; idx < TB * 256; idx += 512) {
                const int tok = idx >> 8, c = idx & 255; const int t = t0 + tok;
                const int ch = (c < 128) ? (h * 128 + c) : (512 + h * 128 + (c - 128));
                float a = p.conv_b[ch];
#pragma unroll
                for (int j = 0; j < 4; ++j) { const int tt = t - 3 + j; if (tt >= 0) a += p.conv_w[j * 1024 + ch] * bf2f(proj[(size_t)(b * SEQ + tt) * NV + ch]); }
                a = silu_f(a);
                if (c < 128) qs[tok * 128 + c] = a; else ks[tok * 128 + (c - 128)] = a * 0.08838834764831845f;
            }
            for (int idx = tid; idx < TB * 128; idx += 512) { const int tok = idx >> 7, c = idx & 127; vs[idx] = bf2f(proj[(size_t)(b * SEQ + t0 + tok) * NV + PC_MV + h * 128 + c]); }
            if (tid < TB) { const float* g = gates + (size_t)(b * SEQ + t0 + tid) * 8; gi[tid] = g[h]; gl[tid] = logsigmoid_f(g[4 + h]); }
            __syncthreads();
            for (int tok = 0; tok < TB; ++tok) {
                const float iv = gi[tok], lf = gl[tok];
                const float mn = fmaxf(lf + m, iv), fd = expf(lf + m - mn), iw = expf(iv - mn);
                const float ve = vs[tok * 128 + e] * iw;
                float nump = 0.f, denp = 0.f;
#pragma unroll
                for (int j = 0; j < 32; ++j) {
                    const float kk = ks[tok * 128 + dq * 32 + j], qq = qs[tok * 128 + dq * 32 + j];
                    C[j] = fd * C[j] + ve * kk; n[j] = fd * n[j] + iw * kk;
                    nump += C[j] * qq; denp += n[j] * qq;
                }
                nump += __shfl_xor(nump, 1); nump += __shfl_xor(nump, 2);
                denp += __shfl_xor(denp, 1); denp += __shfl_xor(denp, 2);
                if (dq == 0) hs[tok * 128 + e] = nump / fmaxf(fabsf(denp), expf(-mn));
                m = mn;
            }
            __syncthreads();
            for (int tk = wv * 2; tk < wv * 2 + 2; ++tk) {
                const float h0 = hs[tk * 128 + lane], h1 = hs[tk * 128 + 64 + lane];
                const float mu = wave_sum(h0 + h1) * (1.f / 128.f);
                const float d0 = h0 - mu, d1 = h1 - mu;
                const float var = wave_sum(d0 * d0 + d1 * d1) * (1.f / 128.f);
                const float rs = 1.f / sqrtf(var + LN_EPS);
                const size_t row = (size_t)(b * SEQ + t0 + tk);
                const float o0 = bf2f(proj[row * NV + PC_MO + h * 128 + lane]), o1 = bf2f(proj[row * NV + PC_MO + h * 128 + 64 + lane]);
                mix[row * DM + h * 128 + lane] = f2bf(sigmoid_f(o0) * d0 * rs * p.norm_w[h * 128 + lane]);
                mix[row * DM + h * 128 + 64 + lane] = f2bf(sigmoid_f(o1) * d1 * rs * p.norm_w[h * 128 + 64 + lane]);
            }
            __syncthreads();
        }
    }
}

__device__ void ph_swa_naive(const P& p, unsigned char* lds, int bid, int nb) {
    const int tid = threadIdx.x, lane = tid & 63, wv = tid >> 6;
    float* qsh = (float*)lds + wv * 192;
    float* psh = qsh + 64;
    const bf16_t* proj = (const bf16_t*)(p.ws + WS_PROJ);
    bf16_t* mix = (bf16_t*)(p.ws + WS_MIX);
    const long nitems = (long)T * AQH;
    for (long it = (long)bid * 8 + wv; it < nitems; it += (long)nb * 8) {
        const int hq = (int)(it & 7); const int row = (int)(it >> 3); const int s = row & (SEQ - 1); const int kvh = hq >> 2;
        qsh[lane] = bf2f(proj[(size_t)row * NV + PC_AQ + hq * 64 + lane]);
        __builtin_amdgcn_wave_barrier();
        float sc[2]; bool val[2];
#pragma unroll
        for (int u = 0; u < 2; ++u) {
            const int kidx = lane + 64 * u; const int kpos = s - 127 + kidx; val[u] = kpos >= 0;
            float a = 0.f;
            if (val[u]) { const bf16_t* kr = proj + (size_t)(row - 127 + kidx) * NV + PC_AK + kvh * 64;
                for (int d = 0; d < 64; ++d) a += qsh[d] * bf2f(kr[d]); }
            sc[u] = val[u] ? a * 0.125f : -INFINITY;
        }
        const float sink = p.sinks[hq];
        const float mx = fmaxf(wave_max(fmaxf(sc[0], sc[1])), sink);
        const float p0 = val[0] ? expf(sc[0] - mx) : 0.f, p1 = val[1] ? expf(sc[1] - mx) : 0.f;
        const float den = wave_sum(p0 + p1) + expf(sink - mx);
        psh[lane] = p0; psh[lane + 64] = p1;
        __builtin_amdgcn_wave_barrier();
        float o = 0.f;
        for (int kidx = 0; kidx < 128; ++kidx) { const int kpos = s - 127 + kidx; if (kpos >= 0) o += psh[kidx] * bf2f(proj[(size_t)(row - 127 + kidx) * NV + PC_AV + kvh * 64 + lane]); }
        mix[(size_t)row * DM + 512 + hq * 64 + lane] = f2bf(o / den);
        __builtin_amdgcn_wave_barrier();
    }
}

__device__ void ph_outproj_naive(const P& p, unsigned char* lds, int bid, int nb) {
    float* As = (float*)lds; float* Bs = As + 16 * 132; float* Ct = Bs + 16 * 64;
    const bf16_t* mix = (const bf16_t*)(p.ws + WS_MIX);
    float* y = (float*)(p.ws + WS_X1F);
    const float* w = p.w_out;
    const int ntiles = (T / 128) * (DM / 64);
    const int tid = threadIdx.x;
    for (int it = bid; it < ntiles; it += nb) {
        const int rt = it / (DM / 64), ct = it % (DM / 64), row0 = rt * 128, col0 = ct * 64;
        naive_tile([&](int r, int k) { return bf2f(mix[(size_t)r * DM + k]); },
                   [&](int k, int c) { return w[(size_t)k * DM + c]; }, row0, col0, DM, As, Bs, Ct);
        for (int e = tid; e < 128 * 64; e += 512) { const int r = e >> 6, c = e & 63; y[(size_t)(row0 + r) * DM + col0 + c] = Ct[r * 65 + c]; }
        __syncthreads();
    }
}

__device__ void ph_ln1_naive(const P& p, int bid, int nb) {
    const int tid = threadIdx.x, lane = tid & 63, wv = tid >> 6;
    float* x1 = (float*)(p.ws + WS_X1F); bf16_t* x1b = (bf16_t*)(p.ws + WS_X1B);
    for (int row = bid * 8 + wv; row < T; row += nb * 8) {
        float v[16]; float s = 0.f;
#pragma unroll
        for (int i = 0; i < 16; ++i) { const int c = i * 64 + lane; v[i] = ALPHA * p.x[(size_t)row * DM + c] + x1[(size_t)row * DM + c]; s += v[i]; }
        const float mu = wave_sum(s) * (1.f / DM); float q = 0.f;
#pragma unroll
        for (int i = 0; i < 16; ++i) { v[i] -= mu; q += v[i] * v[i]; }
        const float rs = 1.f / sqrtf(wave_sum(q) * (1.f / DM) + LN_EPS);
#pragma unroll
        for (int i = 0; i < 16; ++i) { const int c = i * 64 + lane; const float o = v[i] * rs * p.ln1_w[c] + p.ln1_b[c]; x1[(size_t)row * DM + c] = o; x1b[(size_t)row * DM + c] = f2bf(o); }
    }
}

__device__ void ph_route_naive(const P& p, int bid, int nb) {
    const int tid = threadIdx.x, lane = tid & 63, wv = tid >> 6;
    const float* x1 = (const float*)(p.ws + WS_X1F);
    int* rt_e = (int*)(p.ws + WS_RT); float* rt_w = (float*)(p.ws + WS_RT + 512 * 1024);
    for (int row = bid * 8 + wv; row < T; row += nb * 8) {
        float lg[36];
#pragma unroll
        for (int j = 0; j < 36; ++j) lg[j] = 0.f;
        for (int i = 0; i < 16; ++i) {
            const int d = i * 64 + lane; const float xv = x1[(size_t)row * DM + d];
#pragma unroll
            for (int j = 0; j < 4; ++j) lg[j] += xv * p.w_gr[d * 4 + j];
#pragma unroll
            for (int j = 0; j < 32; ++j) lg[4 + j] += xv * p.w_er[d * 32 + j];
        }
#pragma unroll
        for (int j = 0; j < 36; ++j) lg[j] = wave_sum(lg[j]);
        if (lane == 0) {
            float g[4]; int gi = 0;
#pragma unroll
            for (int j = 0; j < 4; ++j) g[j] = lg[j] + p.b_gr[j];
            float gm = g[0];
#pragma unroll
            for (int j = 1; j < 4; ++j) if (g[j] > gm) { gm = g[j]; gi = j; }
            float gs = 0.f;
#pragma unroll
            for (int j = 0; j < 4; ++j) gs += expf(g[j] - gm);
            const float gp = 1.f / gs;
            float ev[8];
#pragma unroll
            for (int j = 0; j < 8; ++j) { float a = 0.f;
#pragma unroll
                for (int q = 0; q < 4; ++q) a = (q == gi) ? (lg[4 + q * 8 + j] + p.b_er[q * 8 + j]) : a;
                ev[j] = a; }
            int i0 = 0; float v0 = ev[0];
#pragma unroll
            for (int j = 1; j < 8; ++j) if (ev[j] > v0) { v0 = ev[j]; i0 = j; }
            int i1 = -1; float v1 = -INFINITY;
#pragma unroll
            for (int j = 0; j < 8; ++j) if (j != i0 && ev[j] > v1) { v1 = ev[j]; i1 = j; }
            const float e1 = expf(v1 - v0); const float w0 = gp / (1.f + e1), w1 = gp * e1 / (1.f + e1);
            rt_e[row * 2] = gi * 8 + i0; rt_e[row * 2 + 1] = gi * 8 + i1; rt_w[row * 2] = w0; rt_w[row * 2 + 1] = w1;
        }
    }
}

__device__ void ph_moe_naive(const P& p, unsigned char* lds, int bid, int nb) {
    float* xs = (float*)lds;
    float* gu = xs + 1024;
    float* hs = gu + 512;
    float* red = hs + 512;
    const int tid = threadIdx.x, lane = tid & 63, wv = tid >> 6;
    const float* x1 = (const float*)(p.ws + WS_X1F); const bf16_t* x1b = (const bf16_t*)(p.ws + WS_X1B);
    const int* rt_e = (const int*)(p.ws + WS_RT); const float* rt_w = (const float*)(p.ws + WS_RT + 512 * 1024);
    for (int row = bid; row < T; row += nb) {
        xs[tid] = bf2f(x1b[(size_t)row * DM + tid]); xs[tid + 512] = bf2f(x1b[(size_t)row * DM + tid + 512]);
        __syncthreads();
        for (int k = 0; k < 2; ++k) {
            const int e = rt_e[row * 2 + k]; const float wk = rt_w[row * 2 + k];
            const float* W = (tid < 256 ? p.w_eg : p.w_eu) + (size_t)e * DM * DEXP + (tid & 255);
            float a = 0.f;
            for (int d = 0; d < DM; ++d) a += xs[d] * W[(size_t)d * DEXP];
            gu[tid] = a;
            __syncthreads();
            if (tid < 256) hs[k * 256 + tid] = silu_f(gu[tid]) * gu[256 + tid] * wk;
            __syncthreads();
        }
        float acc[2] = {0.f, 0.f};
        for (int k = 0; k < 2; ++k) {
            const int e = rt_e[row * 2 + k]; const float* W = p.w_ed + (size_t)e * DEXP * DM;
            for (int j = 0; j < DEXP; ++j) { const float hv = hs[k * 256 + j]; acc[0] += hv * W[(size_t)j * DM + tid]; acc[1] += hv * W[(size_t)j * DM + tid + 512]; }
        }
        float v0 = ALPHA * x1[(size_t)row * DM + tid] + acc[0], v1 = ALPHA * x1[(size_t)row * DM + tid + 512] + acc[1];
        float s = wave_sum(v0 + v1); if (lane == 0) red[wv] = s; __syncthreads();
        float mu = 0.f;
#pragma unroll
        for (int i = 0; i < 8; ++i) mu += red[i];
        mu *= (1.f / DM); v0 -= mu; v1 -= mu;
        float q = wave_sum(v0 * v0 + v1 * v1); if (lane == 0) red[8 + wv] = q; __syncthreads();
        float var = 0.f;
#pragma unroll
        for (int i = 0; i < 8; ++i) var += red[8 + i];
        const float rs = 1.f / sqrtf(var * (1.f / DM) + LN_EPS);
        p.out[(size_t)row * DM + tid] = v0 * rs * p.ln2_w[tid] + p.ln2_b[tid];
        p.out[(size_t)row * DM + tid + 512] = v1 * rs * p.ln2_w[tid + 512] + p.ln2_b[tid + 512];
        __syncthreads();
    }
}

extern __shared__ __attribute__((aligned(16))) unsigned char g_lds[];
__global__ void __launch_bounds__(512, 2) k_tab(P p) { ph_tab(p, blockIdx.x, gridDim.x); }
__global__ void __launch_bounds__(512, 2) k_inproj(P p) { ph_inproj_naive(p, g_lds, blockIdx.x, gridDim.x); }
__global__ void __launch_bounds__(512, 2) k_mlstm(P p) { ph_mlstm_naive(p, g_lds, blockIdx.x, gridDim.x); }
__global__ void __launch_bounds__(512, 2) k_swa(P p) { ph_swa_naive(p, g_lds, blockIdx.x, gridDim.x); }
__global__ void __launch_bounds__(512, 2) k_outproj(P p) { ph_outproj_naive(p, g_lds, blockIdx.x, gridDim.x); }
__global__ void __launch_bounds__(512, 2) k_ln1(P p) { ph_ln1_naive(p, blockIdx.x, gridDim.x); }
__global__ void __launch_bounds__(512, 2) k_route(P p) { ph_route_naive(p, blockIdx.x, gridDim.x); }
__global__ void __launch_bounds__(512, 2) k_moe(P p) { ph_moe_naive(p, g_lds, blockIdx.x, gridDim.x); }

extern "C" void kernel_launch(void* const* d_in, const int* in_sizes, int n_in, void* d_out, int out_size, void* d_ws, size_t ws_size, hipStream_t stream) {
    if (n_in != 19 || in_sizes[0] != T * DM || out_size != T * DM || ws_size < WS_END) {
        fprintf(stderr, "kernel_launch: unexpected shapes (n_in %d in0 %d out %d ws %zu)\n", n_in, n_in > 0 ? in_sizes[0] : -1, out_size, ws_size); return; }
    P p{};
    const float** f = (const float**)&p;
    for (int i = 0; i < 19; ++i) f[i] = (const float*)d_in[i];
    p.out = (float*)d_out; p.ws = (unsigned char*)d_ws;
    constexpr int LDSB = 65536;
    hipLaunchKernelGGL(k_tab, dim3(512), dim3(512), 0, stream, p);
    hipLaunchKernelGGL(k_inproj, dim3(2048), dim3(512), LDSB, stream, p);
    hipLaunchKernelGGL(k_mlstm, dim3(16), dim3(512), LDSB, stream, p);
    hipLaunchKernelGGL(k_swa, dim3(2048), dim3(512), LDSB, stream, p);
    hipLaunchKernelGGL(k_outproj, dim3(2048), dim3(512), LDSB, stream, p);
    hipLaunchKernelGGL(k_ln1, dim3(2048), dim3(512), 0, stream, p);
    hipLaunchKernelGGL(k_route, dim3(2048), dim3(512), 0, stream, p);
    hipLaunchKernelGGL(k_moe, dim3(4096), dim3(512), LDSB, stream, p);
}
```

```cpp
#include <hip/hip_runtime.h>
#include <hip/hip_cooperative_groups.h>
namespace cg = cooperative_groups;
#include <cstdio>
#include <cstdint>

typedef unsigned short bf16_t;

constexpr int BATCH = 4, SEQ = 8192, T = BATCH * SEQ, DM = 1024;
constexpr int MLH = 4, MLD = 128, MLW = 512;
constexpr int AQH = 8, AKH = 2, AHD = 64;
constexpr int DIN = 2824;
constexpr int NV = 2816;
constexpr int NGRP = 4, EPG = 8, NEXP = 32, DEXP = 256;
constexpr float LN_EPS = 1e-5f;
constexpr float ALPHA = 1.189207115002721f;
constexpr int PC_MQ = 0, PC_MK = 512, PC_MV = 1024, PC_MO = 1536, PC_AQ = 2048, PC_AK = 2560, PC_AV = 2688;

constexpr size_t MiB = 1u << 20;
constexpr size_t WS_CTL = 0, WS_TAB = 1 * MiB, WS_GATES = 3 * MiB, WS_RT = 4 * MiB, WS_MISC = 5 * MiB;
constexpr size_t WS_WIN = 8 * MiB, WS_WOUT = 14 * MiB, WS_WGU = 16 * MiB, WS_WD = 48 * MiB;
constexpr size_t WS_PROJ = 64 * MiB, WS_X1F = 64 * MiB, WS_Y = 192 * MiB;
constexpr size_t WS_MIX = 240 * MiB, WS_CST = 304 * MiB, WS_H = 340 * MiB, WS_X1B = 376 * MiB, WS_END = 440 * MiB;

struct P {
    const float *x, *w_in, *conv_w, *conv_b, *gate_bias, *norm_w, *sinks, *w_out, *ln1_w, *ln1_b;
    const float *w_gr, *b_gr, *w_er, *b_er, *w_eg, *w_eu, *w_ed, *ln2_w, *ln2_b;
    float* out; unsigned char* ws;
};

__device__ __forceinline__ float bf2f(bf16_t v) { return __uint_as_float((unsigned)v << 16); }
__device__ __forceinline__ bf16_t f2bf(float f) { unsigned u = __float_as_uint(f); return (bf16_t)((u + 0x7fffu + ((u >> 16) & 1u)) >> 16); }
__device__ __forceinline__ float wave_sum(float v) {
#pragma unroll
    for (int o = 1; o < 64; o <<= 1) v += __shfl_xor(v, o);
    return v;
}
__device__ __forceinline__ float wave_max(float v) {
#pragma unroll
    for (int o = 1; o < 64; o <<= 1) v = fmaxf(v, __shfl_xor(v, o));
    return v;
}
__device__ __forceinline__ float silu_f(float v) { return v / (1.f + expf(-v)); }
__device__ __forceinline__ float sigmoid_f(float v) { return 1.f / (1.f + expf(-v)); }
__device__ __forceinline__ float logsigmoid_f(float v) { return fminf(v, 0.f) - log1pf(expf(-fabsf(v))); }
__device__ __forceinline__ int rope_pos(int d) { return d < 32 ? 8 * (d >> 2) + (d & 3) : 8 * ((d - 32) >> 2) + 4 + (d & 3); }
__device__ __forceinline__ int vcol_to_orig(int v) { return v < 2048 ? v : (v < NV ? v + 8 : v - NV + 2048); }

__device__ void ph_tab(const P& p, int bid, int nb) {
    float2* tab = (float2*)(p.ws + WS_TAB);
    for (int i = bid * 512 + threadIdx.x; i < SEQ * 32; i += nb * 512) {
        const int pos = i >> 5, f = i & 31;
        const double ang = (double)pos * pow(10000.0, -(double)f / 32.0);
        tab[i] = make_float2((float)cos(ang), (float)sin(ang));
    }
}

template <class AF, class BF>
__device__ __forceinline__ void naive_tile(AF af, BF bfn, int row0, int col0, int K, float* As, float* Bs, float* Ct) {
    const int tid = threadIdx.x, ty = tid >> 4, tx = tid & 15;
    float acc[4][4];
#pragma unroll
    for (int i = 0; i < 4; ++i)
#pragma unroll
        for (int j = 0; j < 4; ++j) acc[i][j] = 0.f;
    for (int k0 = 0; k0 < K; k0 += 16) {
#pragma unroll
        for (int i = 0; i < 4; ++i) { const int e = tid + 512 * i, r = e >> 4, kk = e & 15; As[kk * 132 + r] = af(row0 + r, k0 + kk); }
#pragma unroll
        for (int i = 0; i < 2; ++i) { const int e = tid + 512 * i, kk = e >> 6, c = e & 63; Bs[kk * 64 + c] = bfn(k0 + kk, col0 + c); }
        __syncthreads();
#pragma unroll
        for (int kk = 0; kk < 16; ++kk) {
            float a[4], b[4];
#pragma unroll
            for (int i = 0; i < 4; ++i) { a[i] = As[kk * 132 + 4 * ty + i]; b[i] = Bs[kk * 64 + 4 * tx + i]; }
#pragma unroll
            for (int i = 0; i < 4; ++i)
#pragma unroll
                for (int j = 0; j < 4; ++j) acc[i][j] += a[i] * b[j];
        }
        __syncthreads();
    }
#pragma unroll
    for (int i = 0; i < 4; ++i)
#pragma unroll
        for (int j = 0; j < 4; ++j) Ct[(4 * ty + i) * 65 + 4 * tx + j] = acc[i][j];
    __syncthreads();
}

__device__ void ph_inproj_naive(const P& p, unsigned char* lds, int bid, int nb) {
    float* As = (float*)lds; float* Bs = As + 16 * 132; float* Ct = Bs + 16 * 64;
    bf16_t* proj = (bf16_t*)(p.ws + WS_PROJ);
    float* gates = (float*)(p.ws + WS_GATES);
    const float2* tab = (const float2*)(p.ws + WS_TAB);
    const float* x = p.x; const float* w = p.w_in;
    constexpr int NCT = (DIN + 63) / 64;
    const int ntiles = (T / 128) * NCT;
    const int tid = threadIdx.x;
    for (int it = bid; it < ntiles; it += nb) {
        const int rt = it / NCT, ct = it % NCT, row0 = rt * 128, col0 = ct * 64;
        naive_tile([&](int r, int k) { return x[(size_t)r * DM + k]; },
                   [&](int k, int vc) { return vc < DIN ? w[(size_t)k * DIN + vcol_to_orig(vc)] : 0.f; },
                   row0, col0, DM, As, Bs, Ct);
        if (col0 >= NV) {
            for (int e = tid; e < 128 * 8; e += 512) { const int r = e >> 3, c = e & 7; gates[(size_t)(row0 + r) * 8 + c] = Ct[r * 65 + c] + p.gate_bias[c]; }
        } else if (col0 >= PC_AQ && col0 < PC_AV) {
            for (int e = tid; e < 128 * 32; e += 512) {
                const int r = e >> 5, d = e & 31; const int pos = (row0 + r) & (SEQ - 1);
                const float2 cs = tab[pos * 32 + d]; const float x1 = Ct[r * 65 + d], x2 = Ct[r * 65 + d + 32];
                bf16_t* o = proj + (size_t)(row0 + r) * NV + col0;
                o[rope_pos(d)] = f2bf(x1 * cs.x - x2 * cs.y); o[rope_pos(d + 32)] = f2bf(x1 * cs.y + x2 * cs.x);
            }
        } else {
            for (int e = tid; e < 128 * 64; e += 512) { const int r = e >> 6, c = e & 63; proj[(size_t)(row0 + r) * NV + col0 + c] = f2bf(Ct[r * 65 + c]); }
        }
        __syncthreads();
    }
}

__device__ void ph_mlstm_naive(const P& p, unsigned char* lds, int bid, int nb) {
    constexpr int TB = 16;
    float* qs = (float*)lds;
    float* ks = qs + TB * 128;
    float* vs = ks + TB * 128;
    float* hs = vs + TB * 128;
    float* gi = hs + TB * 128;
    float* gl = gi + TB;
    const bf16_t* proj = (const bf16_t*)(p.ws + WS_PROJ);
    const float* gates = (const float*)(p.ws + WS_GATES);
    bf16_t* mix = (bf16_t*)(p.ws + WS_MIX);
    const int tid = threadIdx.x, lane = tid & 63, wv = tid >> 6;
    const int e = tid >> 2, dq = tid & 3;
    for (int it = bid; it < BATCH * MLH; it += nb) {
        const int b = it / MLH, h = it % MLH;
        float C[32], n[32];
#pragma unroll
        for (int j = 0; j < 32; ++j) { C[j] = 0.f; n[j] = 0.f; }
        float m = 0.f;
        for (int t0 = 0; t0 < SEQ; t0 += TB) {
            for (int idx = tid; idx < TB * 256; idx += 512) {
                const int tok = idx >> 8, c = idx & 255; const int t = t0 + tok;
                const int ch = (c < 128) ? (h * 128 + c) : (512 + h * 128 + (c - 128));
                float a = p.conv_b[ch];
#pragma unroll
                for (int j = 0; j < 4; ++j) { const int tt = t - 3 + j; if (tt >= 0) a += p.conv_w[j * 1024 + ch] * bf2f(proj[(size_t)(b * SEQ + tt) * NV + ch]); }
                a = silu_f(a);
                if (c < 128) qs[tok * 128 + c] = a; else ks[tok * 128 + (c - 128)] = a * 0.08838834764831845f;
            }
            for (int idx = tid; idx < TB * 128; idx += 512) { const int tok = idx >> 7, c = idx & 127; vs[idx] = bf2f(proj[(size_t)(b * SEQ + t0 + tok) * NV + PC_MV + h * 128 + c]); }
            if (tid < TB) { const float* g = gates + (size_t)(b * SEQ + t0 + tid) * 8; gi[tid] = g[h]; gl[tid] = logsigmoid_f(g[4 + h]); }
            __syncthreads();
            for (int tok = 0; tok < TB; ++tok) {
                const float iv = gi[tok], lf = gl[tok];
                const float mn = fmaxf(lf + m, iv), fd = expf(lf + m - mn), iw = expf(iv - mn);
                const float ve = vs[tok * 128 + e] * iw;
                float nump = 0.f, denp = 0.f;
#pragma unroll
                for (int j = 0; j < 32; ++j) {
                    const float kk = ks[tok * 128 + dq * 32 + j], qq = qs[tok * 128 + dq * 32 + j];
                    C[j] = fd * C[j] + ve * kk; n[j] = fd * n[j] + iw * kk;
                    nump += C[j] * qq; denp += n[j] * qq;
                }
                nump += __shfl_xor(nump, 1); nump += __shfl_xor(nump, 2);
                denp += __shfl_xor(denp, 1); denp += __shfl_xor(denp, 2);
                if (dq == 0) hs[tok * 128 + e] = nump / fmaxf(fabsf(denp), expf(-mn));
                m = mn;
            }
            __syncthreads();
            for (int tk = wv * 2; tk < wv * 2 + 2; ++tk) {
                const float h0 = hs[tk * 128 + lane], h1 = hs[tk * 128 + 64 + lane];
                const float mu = wave_sum(h0 + h1) * (1.f / 128.f);
                const float d0 = h0 - mu, d1 = h1 - mu;
                const float var = wave_sum(d0 * d0 + d1 * d1) * (1.f / 128.f);
                const float rs = 1.f / sqrtf(var + LN_EPS);
                const size_t row = (size_t)(b * SEQ + t0 + tk);
                const float o0 = bf2f(proj[row * NV + PC_MO + h * 128 + lane]), o1 = bf2f(proj[row * NV + PC_MO + h * 128 + 64 + lane]);
                mix[row * DM + h * 128 + lane] = f2bf(sigmoid_f(o0) * d0 * rs * p.norm_w[h * 128 + lane]);
                mix[row * DM + h * 128 + 64 + lane] = f2bf(sigmoid_f(o1) * d1 * rs * p.norm_w[h * 128 + 64 + lane]);
            }
            __syncthreads();
        }
    }
}

__device__ void ph_swa_naive(const P& p, unsigned char* lds, int bid, int nb) {
    const int tid = threadIdx.x, lane = tid & 63, wv = tid >> 6;
    float* qsh = (float*)lds + wv * 192;
    float* psh = qsh + 64;
    const bf16_t* proj = (const bf16_t*)(p.ws + WS_PROJ);
    bf16_t* mix = (bf16_t*)(p.ws + WS_MIX);
    const long nitems = (long)T * AQH;
    for (long it = (long)bid * 8 + wv; it < nitems; it += (long)nb * 8) {
        const int hq = (int)(it & 7); const int row = (int)(it >> 3); const int s = row & (SEQ - 1); const int kvh = hq >> 2;
        qsh[lane] = bf2f(proj[(size_t)row * NV + PC_AQ + hq * 64 + lane]);
        __builtin_amdgcn_wave_barrier();
        float sc[2]; bool val[2];
#pragma unroll
        for (int u = 0; u < 2; ++u) {
            const int kidx = lane + 64 * u; const int kpos = s - 127 + kidx; val[u] = kpos >= 0;
            float a = 0.f;
            if (val[u]) { const bf16_t* kr = proj + (size_t)(row - 127 + kidx) * NV + PC_AK + kvh * 64;
                for (int d = 0; d < 64; ++d) a += qsh[d] * bf2f(kr[d]); }
            sc[u] = val[u] ? a * 0.125f : -INFINITY;
        }
        const float sink = p.sinks[hq];
        const float mx = fmaxf(wave_max(fmaxf(sc[0], sc[1])), sink);
        const float p0 = val[0] ? expf(sc[0] - mx) : 0.f, p1 = val[1] ? expf(sc[1] - mx) : 0.f;
        const float den = wave_sum(p0 + p1) + expf(sink - mx);
        psh[lane] = p0; psh[lane + 64] = p1;
        __builtin_amdgcn_wave_barrier();
        float o = 0.f;
        for (int kidx = 0; kidx < 128; ++kidx) { const int kpos = s - 127 + kidx; if (kpos >= 0) o += psh[kidx] * bf2f(proj[(size_t)(row - 127 + kidx) * NV + PC_AV + kvh * 64 + lane]); }
        mix[(size_t)row * DM + 512 + hq * 64 + lane] = f2bf(o / den);
        __builtin_amdgcn_wave_barrier();
    }
}

__device__ void ph_outproj_naive(const P& p, unsigned char* lds, int bid, int nb) {
    float* As = (float*)lds; float* Bs = As + 16 * 132; float* Ct = Bs + 16 * 64;
    const bf16_t* mix = (const bf16_t*)(p.ws + WS_MIX);
    float* y = (float*)(p.ws + WS_X1F);
    const float* w = p.w_out;
    const int ntiles = (T / 128) * (DM / 64);
    const int tid = threadIdx.x;
    for (int it = bid; it < ntiles; it += nb) {
        const int rt = it / (DM / 64), ct = it % (DM / 64), row0 = rt * 128, col0 = ct * 64;
        naive_tile([&](int r, int k) { return bf2f(mix[(size_t)r * DM + k]); },
                   [&](int k, int c) { return w[(size_t)k * DM + c]; }, row0, col0, DM, As, Bs, Ct);
        for (int e = tid; e < 128 * 64; e += 512) { const int r = e >> 6, c = e & 63; y[(size_t)(row0 + r) * DM + col0 + c] = Ct[r * 65 + c]; }
        __syncthreads();
    }
}

__device__ void ph_ln1_naive(const P& p, int bid, int nb) {
    const int tid = threadIdx.x, lane = tid & 63, wv = tid >> 6;
    float* x1 = (float*)(p.ws + WS_X1F); bf16_t* x1b = (bf16_t*)(p.ws + WS_X1B);
    for (int row = bid * 8 + wv; row < T; row += nb * 8) {
        float v[16]; float s = 0.f;
#pragma unroll
        for (int i = 0; i < 16; ++i) { const int c = i * 64 + lane; v[i] = ALPHA * p.x[(size_t)row * DM + c] + x1[(size_t)row * DM + c]; s += v[i]; }
        const float mu = wave_sum(s) * (1.f / DM); float q = 0.f;
#pragma unroll
        for (int i = 0; i < 16; ++i) { v[i] -= mu; q += v[i] * v[i]; }
        const float rs = 1.f / sqrtf(wave_sum(q) * (1.f / DM) + LN_EPS);
#pragma unroll
        for (int i = 0; i < 16; ++i) { const int c = i * 64 + lane; const float o = v[i] * rs * p.ln1_w[c] + p.ln1_b[c]; x1[(size_t)row * DM + c] = o; x1b[(size_t)row * DM + c] = f2bf(o); }
    }
}

__device__ void ph_route_naive(const P& p, int bid, int nb) {
    const int tid = threadIdx.x, lane = tid & 63, wv = tid >> 6;
    const float* x1 = (const float*)(p.ws + WS_X1F);
    int* rt_e = (int*)(p.ws + WS_RT); float* rt_w = (float*)(p.ws + WS_RT + 512 * 1024);
    for (int row = bid * 8 + wv; row < T; row += nb * 8) {
        float lg[36];
#pragma unroll
        for (int j = 0; j < 36; ++j) lg[j] = 0.f;
        for (int i = 0; i < 16; ++i) {
            const int d = i * 64 + lane; const float xv = x1[(size_t)row * DM + d];
#pragma unroll
            for (int j = 0; j < 4; ++j) lg[j] += xv * p.w_gr[d * 4 + j];
#pragma unroll
            for (int j = 0; j < 32; ++j) lg[4 + j] += xv * p.w_er[d * 32 + j];
        }
#pragma unroll
        for (int j = 0; j < 36; ++j) lg[j] = wave_sum(lg[j]);
        if (lane == 0) {
            float g[4]; int gi = 0;
#pragma unroll
            for (int j = 0; j < 4; ++j) g[j] = lg[j] + p.b_gr[j];
            float gm = g[0];
#pragma unroll
            for (int j = 1; j < 4; ++j) if (g[j] > gm) { gm = g[j]; gi = j; }
            float gs = 0.f;
#pragma unroll
            for (int j = 0; j < 4; ++j) gs += expf(g[j] - gm);
            const float gp = 1.f / gs;
            float ev[8];
#pragma unroll
            for (int j = 0; j < 8; ++j) { float a = 0.f;
#pragma unroll
                for (int q = 0; q < 4; ++q) a = (q == gi) ? (lg[4 + q * 8 + j] + p.b_er[q * 8 + j]) : a;
                ev[j] = a; }
            int i0 = 0; float v0 = ev[0];
#pragma unroll
            for (int j = 1; j < 8; ++j) if (ev[j] > v0) { v0 = ev[j]; i0 = j; }
            int i1 = -1; float v1 = -INFINITY;
#pragma unroll
            for (int j = 0; j < 8; ++j) if (j != i0 && ev[j] > v1) { v1 = ev[j]; i1 = j; }
            const float e1 = expf(v1 - v0); const float w0 = gp / (1.f + e1), w1 = gp * e1 / (1.f + e1);
            rt_e[row * 2] = gi * 8 + i0; rt_e[row * 2 + 1] = gi * 8 + i1; rt_w[row * 2] = w0; rt_w[row * 2 + 1] = w1;
        }
    }
}

__device__ void ph_moe_naive(const P& p, unsigned char* lds, int bid, int nb) {
    float* xs = (float*)lds;
    float* gu = xs + 1024;
    float* hs = gu + 512;
    float* red = hs + 512;
    const int tid = threadIdx.x, lane = tid & 63, wv = tid >> 6;
    const float* x1 = (const float*)(p.ws + WS_X1F); const bf16_t* x1b = (const bf16_t*)(p.ws + WS_X1B);
    const int* rt_e = (const int*)(p.ws + WS_RT); const float* rt_w = (const float*)(p.ws + WS_RT + 512 * 1024);
    for (int row = bid; row < T; row += nb) {
        xs[tid] = bf2f(x1b[(size_t)row * DM + tid]); xs[tid + 512] = bf2f(x1b[(size_t)row * DM + tid + 512]);
        __syncthreads();
        for (int k = 0; k < 2; ++k) {
            const int e = rt_e[row * 2 + k]; const float wk = rt_w[row * 2 + k];
            const float* W = (tid < 256 ? p.w_eg : p.w_eu) + (size_t)e * DM * DEXP + (tid & 255);
            float a = 0.f;
            for (int d = 0; d < DM; ++d) a += xs[d] * W[(size_t)d * DEXP];
            gu[tid] = a;
            __syncthreads();
            if (tid < 256) hs[k * 256 + tid] = silu_f(gu[tid]) * gu[256 + tid] * wk;
            __syncthreads();
        }
        float acc[2] = {0.f, 0.f};
        for (int k = 0; k < 2; ++k) {
            const int e = rt_e[row * 2 + k]; const float* W = p.w_ed + (size_t)e * DEXP * DM;
            for (int j = 0; j < DEXP; ++j) { const float hv = hs[k * 256 + j]; acc[0] += hv * W[(size_t)j * DM + tid]; acc[1] += hv * W[(size_t)j * DM + tid + 512]; }
        }
        float v0 = ALPHA * x1[(size_t)row * DM + tid] + acc[0], v1 = ALPHA * x1[(size_t)row * DM + tid + 512] + acc[1];
        float s = wave_sum(v0 + v1); if (lane == 0) red[wv] = s; __syncthreads();
        float mu = 0.f;
#pragma unroll
        for (int i = 0; i < 8; ++i) mu += red[i];
        mu *= (1.f / DM); v0 -= mu; v1 -= mu;
        float q = wave_sum(v0 * v0 + v1 * v1); if (lane == 0) red[8 + wv] = q; __syncthreads();
        float var = 0.f;
#pragma unroll
        for (int i = 0; i < 8; ++i) var += red[8 + i];
        const float rs = 1.f / sqrtf(var * (1.f / DM) + LN_EPS);
        p.out[(size_t)row * DM + tid] = v0 * rs * p.ln2_w[tid] + p.ln2_b[tid];
        p.out[(size_t)row * DM + tid + 512] = v1 * rs * p.ln2_w[tid + 512] + p.ln2_b[tid + 512];
        __syncthreads();
    }
}

extern __shared__ __attribute__((aligned(16))) unsigned char g_lds[];
constexpr int LDS_BYTES = 65536;
__global__ void __launch_bounds__(512, 2) mega_fwd(P p) {
    cg::grid_group grid = cg::this_grid();
    const int bid = blockIdx.x, nb = gridDim.x;
    ph_tab(p, bid, nb);
    grid.sync();
    ph_inproj_naive(p, g_lds, bid, nb);
    grid.sync();
    ph_swa_naive(p, g_lds, bid, nb);
    __syncthreads();
    ph_mlstm_naive(p, g_lds, nb - 1 - bid, nb);
    grid.sync();
    ph_outproj_naive(p, g_lds, bid, nb);
    grid.sync();
    ph_ln1_naive(p, bid, nb);
    ph_route_naive(p, bid, nb);
    grid.sync();
    ph_moe_naive(p, g_lds, bid, nb);
}

extern "C" void kernel_launch(void* const* d_in, const int* in_sizes, int n_in, void* d_out, int out_size, void* d_ws, size_t ws_size, hipStream_t stream) {
    if (n_in != 19 || in_sizes[0] != T * DM || out_size != T * DM || ws_size < WS_END) {
        fprintf(stderr, "kernel_launch: unexpected shapes (n_in %d in0 %d out %d ws %zu)\n", n_in, n_in > 0 ? in_sizes[0] : -1, out_size, ws_size); return; }
    static int grid_blocks = 0;
    if (!grid_blocks) {
        int dev = 0, cus = 0, per_cu = 0;
        hipGetDevice(&dev);
        hipDeviceGetAttribute(&cus, hipDeviceAttributeMultiprocessorCount, dev);
        hipFuncSetAttribute((const void*)mega_fwd, hipFuncAttributeMaxDynamicSharedMemorySize, LDS_BYTES);
        hipOccupancyMaxActiveBlocksPerMultiprocessor(&per_cu, (const void*)mega_fwd, 512, LDS_BYTES);
        if (per_cu < 1) { fprintf(stderr, "kernel_launch: occupancy query says %d blocks per CU\n", per_cu); per_cu = 1; }
        if (per_cu > 1) per_cu = 1;
        grid_blocks = cus * per_cu;
        (void)hipGetLastError();
    }
    P p{};
    const float** f = (const float**)&p;
    for (int i = 0; i < 19; ++i) f[i] = (const float*)d_in[i];
    p.out = (float*)d_out; p.ws = (unsigned char*)d_ws;
    void* args[] = {&p};
    hipError_t e = hipLaunchCooperativeKernel((const void*)mega_fwd, dim3(grid_blocks), dim3(512), args, LDS_BYTES, stream);
    if (e != hipSuccess) fprintf(stderr, "cooperative launch failed: %s (grid %d)\n", hipGetErrorString(e), grid_blocks);
}
```

```cpp
#include <hip/hip_runtime.h>
#include <hip/hip_cooperative_groups.h>
namespace cg = cooperative_groups;
#include <cstdio>
#include <cstdint>

typedef unsigned short bf16_t;

constexpr int BATCH = 4, SEQ = 8192, T = BATCH * SEQ, DM = 1024;
constexpr int MLH = 4, MLD = 128, MLW = 512;
constexpr int AQH = 8, AKH = 2, AHD = 64;
constexpr int DIN = 2824;
constexpr int NV = 2816;
constexpr int NGRP = 4, EPG = 8, NEXP = 32, DEXP = 256;
constexpr float LN_EPS = 1e-5f;
constexpr float ALPHA = 1.189207115002721f;
constexpr int PC_MQ = 0, PC_MK = 512, PC_MV = 1024, PC_MO = 1536, PC_AQ = 2048, PC_AK = 2560, PC_AV = 2688;

constexpr size_t MiB = 1u << 20;
constexpr size_t WS_CTL = 0, WS_TAB = 1 * MiB, WS_GATES = 3 * MiB, WS_RT = 4 * MiB, WS_MISC = 5 * MiB;
constexpr size_t WS_WIN = 8 * MiB, WS_WOUT = 14 * MiB, WS_WGU = 16 * MiB, WS_WD = 48 * MiB;
constexpr size_t WS_PROJ = 64 * MiB, WS_X1F = 64 * MiB, WS_Y = 192 * MiB;
constexpr size_t WS_MIX = 240 * MiB, WS_CST = 304 * MiB, WS_H = 340 * MiB, WS_X1B = 376 * MiB, WS_SLOT = 440 * MiB, WS_WLIST = 444 * MiB, WS_END = 448 * MiB;
constexpr size_t WS_WR = WS_MISC;

struct P {
    const float *x, *w_in, *conv_w, *conv_b, *gate_bias, *norm_w, *sinks, *w_out, *ln1_w, *ln1_b;
    const float *w_gr, *b_gr, *w_er, *b_er, *w_eg, *w_eu, *w_ed, *ln2_w, *ln2_b;
    float* out; unsigned char* ws;
};

__device__ __forceinline__ float bf2f(bf16_t v) { return __uint_as_float((unsigned)v << 16); }
__device__ __forceinline__ bf16_t f2bf(float f) { unsigned u = __float_as_uint(f); return (bf16_t)((u + 0x7fffu + ((u >> 16) & 1u)) >> 16); }
__device__ __forceinline__ float wave_sum(float v) {
#pragma unroll
    for (int o = 1; o < 64; o <<= 1) v += __shfl_xor(v, o);
    return v;
}
__device__ __forceinline__ float wave_max(float v) {
#pragma unroll
    for (int o = 1; o < 64; o <<= 1) v = fmaxf(v, __shfl_xor(v, o));
    return v;
}
__device__ __forceinline__ float silu_f(float v) { return v / (1.f + expf(-v)); }
__device__ __forceinline__ float sigmoid_f(float v) { return 1.f / (1.f + expf(-v)); }
__device__ __forceinline__ float logsigmoid_f(float v) { return fminf(v, 0.f) - log1pf(expf(-fabsf(v))); }
__device__ __forceinline__ int rope_pos(int d) { return d < 32 ? 8 * (d >> 2) + (d & 3) : 8 * ((d - 32) >> 2) + 4 + (d & 3); }
__device__ __forceinline__ int vcol_to_orig(int v) { return v < 2048 ? v : (v < NV ? v + 8 : v - NV + 2048); }

__device__ void ph_tab(const P& p, int bid, int nb) {
    float2* tab = (float2*)(p.ws + WS_TAB);
    for (int i = bid * 512 + threadIdx.x; i < SEQ * 32; i += nb * 512) {
        const int pos = i >> 5, f = i & 31;
        const double ang = (double)pos * pow(10000.0, -(double)f / 32.0);
        tab[i] = make_float2((float)cos(ang), (float)sin(ang));
    }
}

template <class AF, class BF>
__device__ __forceinline__ void naive_tile(AF af, BF bfn, int row0, int col0, int K, float* As, float* Bs, float* Ct) {
    const int tid = threadIdx.x, ty = tid >> 4, tx = tid & 15;
    float acc[4][4];
#pragma unroll
    for (int i = 0; i < 4; ++i)
#pragma unroll
        for (int j = 0; j < 4; ++j) acc[i][j] = 0.f;
    for (int k0 = 0; k0 < K; k0 += 16) {
#pragma unroll
        for (int i = 0; i < 4; ++i) { const int e = tid + 512 * i, r = e >> 4, kk = e & 15; As[kk * 132 + r] = af(row0 + r, k0 + kk); }
#pragma unroll
        for (int i = 0; i < 2; ++i) { const int e = tid + 512 * i, kk = e >> 6, c = e & 63; Bs[kk * 64 + c] = bfn(k0 + kk, col0 + c); }
        __syncthreads();
#pragma unroll
        for (int kk = 0; kk < 16; ++kk) {
            float a[4], b[4];
#pragma unroll
            for (int i = 0; i < 4; ++i) { a[i] = As[kk * 132 + 4 * ty + i]; b[i] = Bs[kk * 64 + 4 * tx + i]; }
#pragma unroll
            for (int i = 0; i < 4; ++i)
#pragma unroll
                for (int j = 0; j < 4; ++j) acc[i][j] += a[i] * b[j];
        }
        __syncthreads();
    }
#pragma unroll
    for (int i = 0; i < 4; ++i)
#pragma unroll
        for (int j = 0; j < 4; ++j) Ct[(4 * ty + i) * 65 + 4 * tx + j] = acc[i][j];
    __syncthreads();
}

__device__ void ph_inproj_naive(const P& p, unsigned char* lds, int bid, int nb) {
    float* As = (float*)lds; float* Bs = As + 16 * 132; float* Ct = Bs + 16 * 64;
    bf16_t* proj = (bf16_t*)(p.ws + WS_PROJ);
    float* gates = (float*)(p.ws + WS_GATES);
    const float2* tab = (const float2*)(p.ws + WS_TAB);
    const float* x = p.x; const float* w = p.w_in;
    constexpr int NCT = (DIN + 63) / 64;
    const int ntiles = (T / 128) * NCT;
    const int tid = threadIdx.x;
    for (int it = bid; it < ntiles; it += nb) {
        const int rt = it / NCT, ct = it % NCT, row0 = rt * 128, col0 = ct * 64;
        naive_tile([&](int r, int k) { return x[(size_t)r * DM + k]; },
                   [&](int k, int vc) { return vc < DIN ? w[(size_t)k * DIN + vcol_to_orig(vc)] : 0.f; },
                   row0, col0, DM, As, Bs, Ct);
        if (col0 >= NV) {
            for (int e = tid; e < 128 * 8; e += 512) { const int r = e >> 3, c = e & 7; gates[(size_t)(row0 + r) * 8 + c] = Ct[r * 65 + c] + p.gate_bias[c]; }
        } else if (col0 >= PC_AQ && col0 < PC_AV) {
            for (int e = tid; e < 128 * 32; e += 512) {
                const int r = e >> 5, d = e & 31; const int pos = (row0 + r) & (SEQ - 1);
                const float2 cs = tab[pos * 32 + d]; const float x1 = Ct[r * 65 + d], x2 = Ct[r * 65 + d + 32];
                bf16_t* o = proj + (size_t)(row0 + r) * NV + col0;
                o[rope_pos(d)] = f2bf(x1 * cs.x - x2 * cs.y); o[rope_pos(d + 32)] = f2bf(x1 * cs.y + x2 * cs.x);
            }
        } else {
            for (int e = tid; e < 128 * 64; e += 512) { const int r = e >> 6, c = e & 63; proj[(size_t)(row0 + r) * NV + col0 + c] = f2bf(Ct[r * 65 + c]); }
        }
        __syncthreads();
    }
}

__device__ void ph_mlstm_naive(const P& p, unsigned char* lds, int bid, int nb) {
    constexpr int TB = 16;
    float* qs = (float*)lds;
    float* ks = qs + TB * 128;
    float* vs = ks + TB * 128;
    float* hs = vs + TB * 128;
    float* gi = hs + TB * 128;
    float* gl = gi + TB;
    const bf16_t* proj = (const bf16_t*)(p.ws + WS_PROJ);
    const float* gates = (const float*)(p.ws + WS_GATES);
    bf16_t* mix = (bf16_t*)(p.ws + WS_MIX);
    const int tid = threadIdx.x, lane = tid & 63, wv = tid >> 6;
    const int e = tid >> 2, dq = tid & 3;
    for (int it = bid; it < BATCH * MLH; it += nb) {
        const int b = it / MLH, h = it % MLH;
        float C[32], n[32];
#pragma unroll
        for (int j = 0; j < 32; ++j) { C[j] = 0.f; n[j] = 0.f; }
        float m = 0.f;
        for (int t0 = 0; t0 < SEQ; t0 += TB) {
            for (int idx = tid; idx < TB * 256; idx += 512) {
                const int tok = idx >> 8, c = idx & 255; const int t = t0 + tok;
                const int ch = (c < 128) ? (h * 128 + c) : (512 + h * 128 + (c - 128));
                float a = p.conv_b[ch];
#pragma unroll
                for (int j = 0; j < 4; ++j) { const int tt = t - 3 + j; if (tt >= 0) a += p.conv_w[j * 1024 + ch] * bf2f(proj[(size_t)(b * SEQ + tt) * NV + ch]); }
                a = silu_f(a);
                if (c < 128) qs[tok * 128 + c] = a; else ks[tok * 128 + (c - 128)] = a * 0.08838834764831845f;
            }
            for (int idx = tid; idx < TB * 128; idx += 512) { const int tok = idx >> 7, c = idx & 127; vs[idx] = bf2f(proj[(size_t)(b * SEQ + t0 + tok) * NV + PC_MV + h * 128 + c]); }
            if (tid < TB) { const float* g = gates + (size_t)(b * SEQ + t0 + tid) * 8; gi[tid] = g[h]; gl[tid] = logsigmoid_f(g[4 + h]); }
            __syncthreads();
            for (int tok = 0; tok < TB; ++tok) {
                const float iv = gi[tok], lf = gl[tok];
                const float mn = fmaxf(lf + m, iv), fd = expf(lf + m - mn), iw = expf(iv - mn);
                const float ve = vs[tok * 128 + e] * iw;
                float nump = 0.f, denp = 0.f;
#pragma unroll
                for (int j = 0; j < 32; ++j) {
                    const float kk = ks[tok * 128 + dq * 32 + j], qq = qs[tok * 128 + dq * 32 + j];
                    C[j] = fd * C[j] + ve * kk; n[j] = fd * n[j] + iw * kk;
                    nump += C[j] * qq; denp += n[j] * qq;
                }
                nump += __shfl_xor(nump, 1); nump += __shfl_xor(nump, 2);
                denp += __shfl_xor(denp, 1); denp += __shfl_xor(denp, 2);
                if (dq == 0) hs[tok * 128 + e] = nump / fmaxf(fabsf(denp), expf(-mn));
                m = mn;
            }
            __syncthreads();
            for (int tk = wv * 2; tk < wv * 2 + 2; ++tk) {
                const float h0 = hs[tk * 128 + lane], h1 = hs[tk * 128 + 64 + lane];
                const float mu = wave_sum(h0 + h1) * (1.f / 128.f);
                const float d0 = h0 - mu, d1 = h1 - mu;
                const float var = wave_sum(d0 * d0 + d1 * d1) * (1.f / 128.f);
                const float rs = 1.f / sqrtf(var + LN_EPS);
                const size_t row = (size_t)(b * SEQ + t0 + tk);
                const float o0 = bf2f(proj[row * NV + PC_MO + h * 128 + lane]), o1 = bf2f(proj[row * NV + PC_MO + h * 128 + 64 + lane]);
                mix[row * DM + h * 128 + lane] = f2bf(sigmoid_f(o0) * d0 * rs * p.norm_w[h * 128 + lane]);
                mix[row * DM + h * 128 + 64 + lane] = f2bf(sigmoid_f(o1) * d1 * rs * p.norm_w[h * 128 + 64 + lane]);
            }
            __syncthreads();
        }
    }
}

__device__ void ph_swa_naive(const P& p, unsigned char* lds, int bid, int nb) {
    const int tid = threadIdx.x, lane = tid & 63, wv = tid >> 6;
    float* qsh = (float*)lds + wv * 192;
    float* psh = qsh + 64;
    const bf16_t* proj = (const bf16_t*)(p.ws + WS_PROJ);
    bf16_t* mix = (bf16_t*)(p.ws + WS_MIX);
    const long nitems = (long)T * AQH;
    for (long it = (long)bid * 8 + wv; it < nitems; it += (long)nb * 8) {
        const int hq = (int)(it & 7); const int row = (int)(it >> 3); const int s = row & (SEQ - 1); const int kvh = hq >> 2;
        qsh[lane] = bf2f(proj[(size_t)row * NV + PC_AQ + hq * 64 + lane]);
        __builtin_amdgcn_wave_barrier();
        float sc[2]; bool val[2];
#pragma unroll
        for (int u = 0; u < 2; ++u) {
            const int kidx = lane + 64 * u; const int kpos = s - 127 + kidx; val[u] = kpos >= 0;
            float a = 0.f;
            if (val[u]) { const bf16_t* kr = proj + (size_t)(row - 127 + kidx) * NV + PC_AK + kvh * 64;
                for (int d = 0; d < 64; ++d) a += qsh[d] * bf2f(kr[d]); }
            sc[u] = val[u] ? a * 0.125f : -INFINITY;
        }
        const float sink = p.sinks[hq];
        const float mx = fmaxf(wave_max(fmaxf(sc[0], sc[1])), sink);
        const float p0 = val[0] ? expf(sc[0] - mx) : 0.f, p1 = val[1] ? expf(sc[1] - mx) : 0.f;
        const float den = wave_sum(p0 + p1) + expf(sink - mx);
        psh[lane] = p0; psh[lane + 64] = p1;
        __builtin_amdgcn_wave_barrier();
        float o = 0.f;
        for (int kidx = 0; kidx < 128; ++kidx) { const int kpos = s - 127 + kidx; if (kpos >= 0) o += psh[kidx] * bf2f(proj[(size_t)(row - 127 + kidx) * NV + PC_AV + kvh * 64 + lane]); }
        mix[(size_t)row * DM + 512 + hq * 64 + lane] = f2bf(o / den);
        __builtin_amdgcn_wave_barrier();
    }
}

__device__ void ph_outproj_naive(const P& p, unsigned char* lds, int bid, int nb) {
    float* As = (float*)lds; float* Bs = As + 16 * 132; float* Ct = Bs + 16 * 64;
    const bf16_t* mix = (const bf16_t*)(p.ws + WS_MIX);
    float* y = (float*)(p.ws + WS_X1F);
    const float* w = p.w_out;
    const int ntiles = (T / 128) * (DM / 64);
    const int tid = threadIdx.x;
    for (int it = bid; it < ntiles; it += nb) {
        const int rt = it / (DM / 64), ct = it % (DM / 64), row0 = rt * 128, col0 = ct * 64;
        naive_tile([&](int r, int k) { return bf2f(mix[(size_t)r * DM + k]); },
                   [&](int k, int c) { return w[(size_t)k * DM + c]; }, row0, col0, DM, As, Bs, Ct);
        for (int e = tid; e < 128 * 64; e += 512) { const int r = e >> 6, c = e & 63; y[(size_t)(row0 + r) * DM + col0 + c] = Ct[r * 65 + c]; }
        __syncthreads();
    }
}

__device__ void ph_ln1_naive(const P& p, int bid, int nb) {
    const int tid = threadIdx.x, lane = tid & 63, wv = tid >> 6;
    float* x1 = (float*)(p.ws + WS_X1F); bf16_t* x1b = (bf16_t*)(p.ws + WS_X1B);
    for (int row = bid * 8 + wv; row < T; row += nb * 8) {
        float v[16]; float s = 0.f;
#pragma unroll
        for (int i = 0; i < 16; ++i) { const int c = i * 64 + lane; v[i] = ALPHA * p.x[(size_t)row * DM + c] + x1[(size_t)row * DM + c]; s += v[i]; }
        const float mu = wave_sum(s) * (1.f / DM); float q = 0.f;
#pragma unroll
        for (int i = 0; i < 16; ++i) { v[i] -= mu; q += v[i] * v[i]; }
        const float rs = 1.f / sqrtf(wave_sum(q) * (1.f / DM) + LN_EPS);
#pragma unroll
        for (int i = 0; i < 16; ++i) { const int c = i * 64 + lane; const float o = v[i] * rs * p.ln1_w[c] + p.ln1_b[c]; x1[(size_t)row * DM + c] = o; x1b[(size_t)row * DM + c] = f2bf(o); }
    }
}

__device__ void ph_route_naive(const P& p, int bid, int nb) {
    const int tid = threadIdx.x, lane = tid & 63, wv = tid >> 6;
    const float* x1 = (const float*)(p.ws + WS_X1F);
    int* rt_e = (int*)(p.ws + WS_RT); float* rt_w = (float*)(p.ws + WS_RT + 512 * 1024);
    for (int row = bid * 8 + wv; row < T; row += nb * 8) {
        float lg[36];
#pragma unroll
        for (int j = 0; j < 36; ++j) lg[j] = 0.f;
        for (int i = 0; i < 16; ++i) {
            const int d = i * 64 + lane; const float xv = x1[(size_t)row * DM + d];
#pragma unroll
            for (int j = 0; j < 4; ++j) lg[j] += xv * p.w_gr[d * 4 + j];
#pragma unroll
            for (int j = 0; j < 32; ++j) lg[4 + j] += xv * p.w_er[d * 32 + j];
        }
#pragma unroll
        for (int j = 0; j < 36; ++j) lg[j] = wave_sum(lg[j]);
        if (lane == 0) {
            float g[4]; int gi = 0;
#pragma unroll
            for (int j = 0; j < 4; ++j) g[j] = lg[j] + p.b_gr[j];
            float gm = g[0];
#pragma unroll
            for (int j = 1; j < 4; ++j) if (g[j] > gm) { gm = g[j]; gi = j; }
            float gs = 0.f;
#pragma unroll
            for (int j = 0; j < 4; ++j) gs += expf(g[j] - gm);
            const float gp = 1.f / gs;
            float ev[8];
#pragma unroll
            for (int j = 0; j < 8; ++j) { float a = 0.f;
#pragma unroll
                for (int q = 0; q < 4; ++q) a = (q == gi) ? (lg[4 + q * 8 + j] + p.b_er[q * 8 + j]) : a;
                ev[j] = a; }
            int i0 = 0; float v0 = ev[0];
#pragma unroll
            for (int j = 1; j < 8; ++j) if (ev[j] > v0) { v0 = ev[j]; i0 = j; }
            int i1 = -1; float v1 = -INFINITY;
#pragma unroll
            for (int j = 0; j < 8; ++j) if (j != i0 && ev[j] > v1) { v1 = ev[j]; i1 = j; }
            const float e1 = expf(v1 - v0); const float w0 = gp / (1.f + e1), w1 = gp * e1 / (1.f + e1);
            rt_e[row * 2] = gi * 8 + i0; rt_e[row * 2 + 1] = gi * 8 + i1; rt_w[row * 2] = w0; rt_w[row * 2 + 1] = w1;
        }
    }
}

__device__ void ph_moe_naive(const P& p, unsigned char* lds, int bid, int nb) {
    float* xs = (float*)lds;
    float* gu = xs + 1024;
    float* hs = gu + 512;
    float* red = hs + 512;
    const int tid = threadIdx.x, lane = tid & 63, wv = tid >> 6;
    const float* x1 = (const float*)(p.ws + WS_X1F); const bf16_t* x1b = (const bf16_t*)(p.ws + WS_X1B);
    const int* rt_e = (const int*)(p.ws + WS_RT); const float* rt_w = (const float*)(p.ws + WS_RT + 512 * 1024);
    for (int row = bid; row < T; row += nb) {
        xs[tid] = bf2f(x1b[(size_t)row * DM + tid]); xs[tid + 512] = bf2f(x1b[(size_t)row * DM + tid + 512]);
        __syncthreads();
        for (int k = 0; k < 2; ++k) {
            const int e = rt_e[row * 2 + k]; const float wk = rt_w[row * 2 + k];
            const float* W = (tid < 256 ? p.w_eg : p.w_eu) + (size_t)e * DM * DEXP + (tid & 255);
            float a = 0.f;
            for (int d = 0; d < DM; ++d) a += xs[d] * W[(size_t)d * DEXP];
            gu[tid] = a;
            __syncthreads();
            if (tid < 256) hs[k * 256 + tid] = silu_f(gu[tid]) * gu[256 + tid] * wk;
            __syncthreads();
        }
        float acc[2] = {0.f, 0.f};
        for (int k = 0; k < 2; ++k) {
            const int e = rt_e[row * 2 + k]; const float* W = p.w_ed + (size_t)e * DEXP * DM;
            for (int j = 0; j < DEXP; ++j) { const float hv = hs[k * 256 + j]; acc[0] += hv * W[(size_t)j * DM + tid]; acc[1] += hv * W[(size_t)j * DM + tid + 512]; }
        }
        float v0 = ALPHA * x1[(size_t)row * DM + tid] + acc[0], v1 = ALPHA * x1[(size_t)row * DM + tid + 512] + acc[1];
        float s = wave_sum(v0 + v1); if (lane == 0) red[wv] = s; __syncthreads();
        float mu = 0.f;
#pragma unroll
        for (int i = 0; i < 8; ++i) mu += red[i];
        mu *= (1.f / DM); v0 -= mu; v1 -= mu;
        float q = wave_sum(v0 * v0 + v1 * v1); if (lane == 0) red[8 + wv] = q; __syncthreads();
        float var = 0.f;
#pragma unroll
        for (int i = 0; i < 8; ++i) var += red[8 + i];
        const float rs = 1.f / sqrtf(var * (1.f / DM) + LN_EPS);
        p.out[(size_t)row * DM + tid] = v0 * rs * p.ln2_w[tid] + p.ln2_b[tid];
        p.out[(size_t)row * DM + tid + 512] = v1 * rs * p.ln2_w[tid + 512] + p.ln2_b[tid + 512];
        __syncthreads();
    }
}

namespace pg8 {
#define PG8_LAS __attribute__((address_space(3)))
typedef short bf16x8 __attribute__((ext_vector_type(8)));
typedef float f32x4 __attribute__((ext_vector_type(4)));
typedef unsigned u32x4 __attribute__((ext_vector_type(4)));
typedef unsigned u32x2 __attribute__((ext_vector_type(2)));
constexpr int BM = 256, BK = 64, HALF = 128, HTB = HALF * BK * 2, STAGE_BYTES = 8 * HTB, NXCD = 8, WGM = 8;

__host__ __device__ __forceinline__ int lds_byte(int r, int c) { const int st = (r >> 4) * 2 + (c >> 5), rr = r & 15, cc = c & 31, ob = rr * 64 + cc * 2; return st * 1024 + (ob ^ (((ob >> 9) & 1) << 5)); }
__host__ __device__ __forceinline__ void stage_rc(int b, int& R, int& C) { const int st = b / 1024, sb = b % 1024, swz = sb ^ (((sb >> 9) & 1) << 5); R = (st >> 1) * 16 + swz / 64; C = (st & 1) * 32 + (swz % 64) / 2; }
__host__ __device__ __forceinline__ int perm32(int rho) { const int n = rho >> 4, i = rho & 15; return 8 * (i >> 2) + 4 * n + (i & 3); }

struct Unit { int pm, pn, e, mt; };

__device__ __forceinline__ unsigned cvt_pk_bf16(float lo, float hi) { unsigned r; asm volatile("v_cvt_pk_bf16_f32 %0, %1, %2" : "=v"(r) : "v"(lo), "v"(hi)); return r; }

struct StaticOrder {
    int nM, nN, nwg, G, c;
    __device__ void init(int M, int N, int G_, int c_) { nM = M / BM; nN = N / BM; nwg = nM * nN; G = G_; c = c_; }
    __device__ bool next(int i, Unit& u) const {
        const long L = (long)i * G + c; if (L >= nwg) return false;
        int wgid = (int)L; { const int q = nwg / NXCD, r = nwg % NXCD, xcd = wgid % NXCD, off = wgid / NXCD; wgid = (xcd < r ? xcd * (q + 1) : r * (q + 1) + (xcd - r) * q) + off; }
        const int nig = WGM * nN, gid = wgid / nig, fm = gid * WGM, gsz = (nM - fm) < WGM ? (nM - fm) : WGM;
        u.pm = fm + ((wgid % nig) % gsz); u.pn = (wgid % nig) / gsz; u.e = 0; u.mt = 0; return true;
    }
};

template <class Epi, class Prob, class Sched>
__device__ __forceinline__ void gemm_phase(PG8_LAS unsigned char* lds, const Prob& G, const Sched& S, const Epi& E) {
    const int tid = threadIdx.x, wid = __builtin_amdgcn_readfirstlane(tid >> 6), lane = tid & 63, wr = wid >> 2, wc = wid & 3, fr = lane & 15, fq = lane >> 4;
    const int K = G.K, nt = K / BK;
    unsigned voffB[2];
    { int Rr0, Cc0, Rr1, Cc1; stage_rc(tid * 16, Rr0, Cc0); stage_rc(tid * 16 + 8192, Rr1, Cc1);
      const int Rb0 = Epi::PERM ? ((Rr0 & ~31) + perm32(Rr0 & 31)) : Rr0, Rb1 = Epi::PERM ? ((Rr1 & ~31) + perm32(Rr1 & 31)) : Rr1;
      voffB[0] = (unsigned)(Rb0 * K + Cc0) * 2u; voffB[1] = (unsigned)(Rb1 * K + Cc1) * 2u; }
    const size_t kstep = (size_t)(BK * 2);
    const size_t hstep = (size_t)HALF * K * 2;
    const unsigned ldsw = (unsigned)wid * 1024u;
    const int aoff = lds_byte(wr * 64 + fr, fq * 8), boff = lds_byte(wc * 32 + fr, fq * 8);
    const char* const Abase = (const char*)G.A;
#define PG8_SA(b, h) (((b) * 2 + (h)) * HTB)
#define PG8_SB(b, h) ((4 + (b) * 2 + (h)) * HTB)
#define PG8_GLDS(gp, ldsoff) __builtin_amdgcn_global_load_lds((const unsigned*)(gp), (PG8_LAS unsigned*)(lds + (ldsoff)), 16, 0, 0)
#define PG8_STAGE_B(bufoff, gbase) do { PG8_GLDS((const char*)(gbase) + voffB[0], (bufoff) + ldsw); PG8_GLDS((const char*)(gbase) + voffB[1], (bufoff) + ldsw + 8192); } while (0)
#define PG8_STAGE_A(bufoff, kb, o0, o1) do { PG8_GLDS(Abase + (kb) + (o0), (bufoff) + ldsw); PG8_GLDS(Abase + (kb) + (o1), (bufoff) + ldsw + 8192); } while (0)
#define PG8_AOFFS(u, o00, o01, o10, o11) do { int t2_ = tid; asm volatile("" : "+v"(t2_)); int Rr0, Cc0, Rr1, Cc1; stage_rc(t2_ * 16, Rr0, Cc0); stage_rc(t2_ * 16 + 8192, Rr1, Cc1); \
        o00 = (unsigned)(((size_t)G.a_row(u, Rr0) * K + Cc0) * 2u); o01 = (unsigned)(((size_t)G.a_row(u, Rr1) * K + Cc1) * 2u); \
        o10 = (unsigned)(((size_t)G.a_row(u, 128 + Rr0) * K + Cc0) * 2u); o11 = (unsigned)(((size_t)G.a_row(u, 128 + Rr1) * K + Cc1) * 2u); } while (0)
#define PG8_LDA(dst, b, h) do { _Pragma("unroll") for (int m = 0; m < 4; ++m) _Pragma("unroll") for (int k = 0; k < 2; ++k) dst[m][k] = *(const PG8_LAS bf16x8*)(lds + PG8_SA(b, h) + aoff + m * 2048 + k * 1024); } while (0)
#define PG8_LDB(dst, b, h) do { _Pragma("unroll") for (int n = 0; n < 2; ++n) _Pragma("unroll") for (int k = 0; k < 2; ++k) dst[n][k] = *(const PG8_LAS bf16x8*)(lds + PG8_SB(b, h) + boff + n * 2048 + k * 1024); } while (0)
#define PG8_MMA(ai, bj, At, Bt) do { __builtin_amdgcn_s_setprio(1); _Pragma("unroll") for (int m = 0; m < 4; ++m) _Pragma("unroll") for (int n = 0; n < 2; ++n) _Pragma("unroll") for (int k = 0; k < 2; ++k) \
        acc[ai][bj][m][n] = __builtin_amdgcn_mfma_f32_16x16x32_bf16(Bt[n][k], At[m][k], acc[ai][bj][m][n], 0, 0, 0); __builtin_amdgcn_s_setprio(0); } while (0)
#define PG8_WAIT_V(n) asm volatile("s_waitcnt vmcnt(" #n ")" ::: "memory")
#define PG8_WAIT_L(n) asm volatile("s_waitcnt lgkmcnt(" #n ")" ::: "memory")
#define PG8_BAR __builtin_amdgcn_s_barrier()
#define PG8_SCHED __builtin_amdgcn_sched_barrier(0)
    Unit cur, nxt; int ui = 0;
    if (!S.next(0, cur)) return;
    f32x4 acc[2][2][4][2];
#pragma unroll
    for (int a = 0; a < 2; ++a)
#pragma unroll
        for (int b = 0; b < 2; ++b)
#pragma unroll
            for (int m = 0; m < 4; ++m)
#pragma unroll
                for (int n = 0; n < 2; ++n) acc[a][b][m][n] = (f32x4){0.f, 0.f, 0.f, 0.f};
    bf16x8 At[4][2], B0[2][2], B1[2][2];
    unsigned c00, c01, c10, c11;
    PG8_AOFFS(cur, c00, c01, c10, c11);
    const char* cB = G.b_tile(cur);
    PG8_STAGE_B(PG8_SB(0, 0), cB); PG8_STAGE_B(PG8_SB(0, 1), cB + hstep); PG8_STAGE_A(PG8_SA(0, 0), 0, c00, c01); PG8_STAGE_A(PG8_SA(0, 1), 0, c10, c11);
    if (wr == 1) PG8_BAR;
    PG8_WAIT_V(2); PG8_BAR;
    PG8_STAGE_B(PG8_SB(1, 0), cB + kstep); PG8_STAGE_A(PG8_SA(1, 0), kstep, c00, c01); PG8_STAGE_B(PG8_SB(1, 1), cB + hstep + kstep);
    PG8_WAIT_V(6); PG8_BAR;
    for (;;) {
        const bool has_next = S.next(ui + 1, nxt);
        const char* nB = has_next ? G.b_tile(nxt) : cB;
        for (int t = 0; t < nt; t += 2) {
            const bool last = (t == nt - 2);
            const size_t ka1 = (size_t)(t + 1) * kstep;
            const size_t ka2 = last ? 0 : (size_t)(t + 2) * kstep, ka3 = ka2 + kstep;
            const char* b2 = last ? nB : cB + (size_t)(t + 2) * kstep; const char* b3 = b2 + kstep;
            PG8_LDB(B0, 0, 0); PG8_LDB(B1, 0, 1); PG8_SCHED; PG8_LDA(At, 0, 0); PG8_STAGE_A(PG8_SA(1, 1), ka1, c10, c11);
            if (last && has_next) { PG8_AOFFS(nxt, c00, c01, c10, c11); }
            PG8_WAIT_V(8); PG8_WAIT_L(0); PG8_BAR; PG8_MMA(0, 0, At, B0); PG8_MMA(0, 1, At, B1); PG8_BAR; PG8_SCHED;
            PG8_LDA(At, 0, 1); PG8_STAGE_B(PG8_SB(0, 0), b2); PG8_STAGE_B(PG8_SB(0, 1), b2 + hstep); PG8_STAGE_A(PG8_SA(0, 0), ka2, c00, c01);
            PG8_WAIT_V(8); PG8_WAIT_L(0); PG8_BAR; PG8_MMA(1, 0, At, B0); PG8_MMA(1, 1, At, B1); PG8_BAR; PG8_SCHED;
            PG8_LDB(B0, 1, 0); PG8_LDB(B1, 1, 1); PG8_SCHED; PG8_LDA(At, 1, 0); PG8_STAGE_A(PG8_SA(0, 1), ka2, c10, c11);
            PG8_WAIT_V(8); PG8_WAIT_L(0); PG8_BAR; PG8_MMA(0, 0, At, B0); PG8_MMA(0, 1, At, B1); PG8_BAR; PG8_SCHED;
            PG8_LDA(At, 1, 1); PG8_STAGE_B(PG8_SB(1, 0), b3); PG8_STAGE_B(PG8_SB(1, 1), b3 + hstep); PG8_STAGE_A(PG8_SA(1, 0), ka3, c00, c01);
            PG8_WAIT_V(8); PG8_WAIT_L(0); PG8_BAR; PG8_MMA(1, 0, At, B0); PG8_MMA(1, 1, At, B1); PG8_BAR; PG8_SCHED;
        }
        if (wr == 0) PG8_BAR;
        E(acc, cur, wr, wc, fr, fq);
        if (!has_next) break;
#pragma unroll
        for (int a = 0; a < 2; ++a)
#pragma unroll
            for (int b = 0; b < 2; ++b)
#pragma unroll
                for (int m = 0; m < 4; ++m)
#pragma unroll
                    for (int n = 0; n < 2; ++n) acc[a][b][m][n] = (f32x4){0.f, 0.f, 0.f, 0.f};
        cur = nxt; cB = nB; ++ui;
        if (wr == 1) PG8_BAR;
    }
    PG8_WAIT_V(0);
    PG8_BAR;
#undef PG8_SA
#undef PG8_SB
#undef PG8_GLDS
#undef PG8_STAGE_A
#undef PG8_STAGE_B
#undef PG8_AOFFS
#undef PG8_LDA
#undef PG8_LDB
#undef PG8_MMA
#undef PG8_WAIT_V
#undef PG8_WAIT_L
#undef PG8_BAR
#undef PG8_SCHED
}
}
#define LAS __attribute__((address_space(3)))
typedef unsigned v4u __attribute__((ext_vector_type(4)));
typedef float v4f __attribute__((ext_vector_type(4)));
#define LDS_WAIT() asm volatile("s_waitcnt lgkmcnt(0)" ::: "memory")
__device__ __forceinline__ unsigned pk2(float lo, float hi) { return (unsigned)f2bf(lo) | ((unsigned)f2bf(hi) << 16); }

constexpr int CW_GCNT = 64;

template <class SrcCol, class DstRow>
__device__ __forceinline__ void transpose_item(const float* W, int ldw, int K, bf16_t* WT, int k0, int n0, SrcCol sc, DstRow dr, LAS float* scr, int lane) {
    const int scol = sc(n0 + (lane & 31));
#pragma unroll 8
    for (int i = 0; i < 32; ++i) { const int kk = 2 * i + (lane >> 5); scr[kk * 33 + (lane & 31)] = W[(size_t)(k0 + kk) * ldw + scol]; }
    LDS_WAIT(); asm volatile("" ::: "memory");
    const int c = lane & 7;
#pragma unroll
    for (int j = 0; j < 4; ++j) { const int n = (lane >> 3) + 8 * j; const LAS float* s = scr + (8 * c) * 33 + n;
        v4u o; o.x = pk2(s[0 * 33], s[1 * 33]); o.y = pk2(s[2 * 33], s[3 * 33]); o.z = pk2(s[4 * 33], s[5 * 33]); o.w = pk2(s[6 * 33], s[7 * 33]);
        *(v4u*)(WT + (size_t)dr(n0 + n) * K + k0 + 8 * c) = o; }
    LDS_WAIT(); asm volatile("" ::: "memory");
}

__device__ __forceinline__ void ph_prologue(const P& p, unsigned char* lds_g, int bid, int nb) {
    const int tid = threadIdx.x, lane = tid & 63, wv = __builtin_amdgcn_readfirstlane(tid >> 6);
    LAS unsigned char* lds = (LAS unsigned char*)lds_g;
    if (bid == 0 && tid < 64) ((unsigned*)(p.ws + WS_CTL))[CW_GCNT + tid] = 0u;
    ph_tab(p, bid, nb);
    {
        bf16_t* Wr = (bf16_t*)(p.ws + WS_WR);
        for (int i = bid * 512 + tid; i < 48 * DM; i += nb * 512) { const int j = i >> 10, d = i & 1023;
            const float w = j < 4 ? p.w_gr[d * 4 + j] : (j < 36 ? p.w_er[d * 32 + (j - 4)] : 0.f); Wr[i] = f2bf(w); }
    }
    LAS float* wg = (LAS float*)(lds + 8 * 8448);
    for (int i = tid; i < 8 * 1024; i += 512) { const int d = i >> 3, c = i & 7; wg[c * 1024 + d] = p.w_in[(size_t)d * DIN + 2048 + c]; }
    __syncthreads();
    {
        bf16_t* xb = (bf16_t*)(p.ws + WS_MIX); float* gates = (float*)(p.ws + WS_GATES);
        for (int row = bid * 8 + wv; row < T; row += nb * 8) {
            const v4f* xr = (const v4f*)(p.x + (size_t)row * DM) + lane;
            v4f v[4];
#pragma unroll
            for (int j = 0; j < 4; ++j) v[j] = xr[64 * j];
            unsigned long long* o8 = (unsigned long long*)(xb + (size_t)row * DM) + lane;
#pragma unroll
            for (int j = 0; j < 4; ++j) o8[64 * j] = (unsigned long long)pk2(v[j].x, v[j].y) | ((unsigned long long)pk2(v[j].z, v[j].w) << 32);
            float g[8];
#pragma unroll
            for (int c = 0; c < 8; ++c) { float a = 0.f;
#pragma unroll
                for (int j = 0; j < 4; ++j) { const v4f w = *(const LAS v4f*)(wg + c * 1024 + 256 * j + 4 * lane); a += v[j].x * w.x + v[j].y * w.y + v[j].z * w.z + v[j].w * w.w; }
                g[c] = wave_sum(a); }
            float gv = g[0];
#pragma unroll
            for (int c = 1; c < 8; ++c) gv = (lane == c) ? g[c] : gv;
            if (lane < 8) gates[(size_t)row * 8 + lane] = gv + p.gate_bias[lane];
        }
    }
    {
        LAS float* scr = (LAS float*)(lds + wv * 8448);
        const int gw = bid * 8 + wv, NGW = nb * 8;
        bf16_t* Win = (bf16_t*)(p.ws + WS_WIN); bf16_t* Wout = (bf16_t*)(p.ws + WS_WOUT); bf16_t* Wgu = (bf16_t*)(p.ws + WS_WGU); bf16_t* Wd = (bf16_t*)(p.ws + WS_WD);
        constexpr int I_IN = 16 * (NV / 32), I_OUT = 16 * 32, I_G = NEXP * 16 * 8, I_D = NEXP * 4 * 32;
        constexpr int NITEMS = I_IN + I_OUT + 2 * I_G + I_D;
        for (int it = gw; it < NITEMS; it += NGW) {
            int r = it;
            if (r < I_IN) { const int kb = r / (NV / 32), nbk = r % (NV / 32);
                transpose_item(p.w_in, DIN, DM, Win, kb * 64, nbk * 32, [](int v) { return vcol_to_orig(v); },
                               [](int v) { return (v >= PC_AQ && v < PC_AV) ? ((v & ~63) + rope_pos(v & 63)) : v; }, scr, lane); continue; }
            r -= I_IN;
            if (r < I_OUT) { const int kb = r / 32, nbk = r % 32;
                transpose_item(p.w_out, DM, DM, Wout, kb * 64, nbk * 32, [](int v) { return v; }, [](int v) { return v; }, scr, lane); continue; }
            r -= I_OUT;
            if (r < 2 * I_G) { const int up = r >= I_G; if (up) r -= I_G; const int e = r / 128, q = r % 128, kb = q / 8, nbk = q % 8;
                transpose_item((up ? p.w_eu : p.w_eg) + (size_t)e * DM * DEXP, DEXP, DM, Wgu + (size_t)e * 512 * DM, kb * 64, nbk * 32, [](int v) { return v; },
                               [up](int j) { return 8 * (j >> 2) + 4 * up + (j & 3); }, scr, lane); continue; }
            r -= 2 * I_G;
            { const int e = r / 128, q = r % 128, kb = q / 32, nbk = q % 32;
                transpose_item(p.w_ed + (size_t)e * DEXP * DM, DM, DEXP, Wd + (size_t)e * DM * DEXP, kb * 64, nbk * 32, [](int v) { return v; }, [](int v) { return v; }, scr, lane); }
        }
    }
}

struct ProbPlain {
    const bf16_t* A; const bf16_t* Bt; int K;
    __device__ __forceinline__ int a_row(const pg8::Unit& u, int r) const { return u.pm * 256 + r; }
    __device__ __forceinline__ const char* b_tile(const pg8::Unit& u) const { return (const char*)(Bt + (size_t)u.pn * 256 * K); }
};
struct EpiInProj {
    static constexpr bool PERM = true;
    bf16_t* proj; const float* tab;
    __device__ __forceinline__ void operator()(const pg8::f32x4 (&acc)[2][2][4][2], const pg8::Unit& u, int wr, int wc, int fr, int fq) const {
        const int row0 = u.pm * 256 + wr * 64 + fr, colt = u.pn * 256 + wc * 32 + 8 * fq;
        const int g = 4 * (wc & 1) + fq;
#pragma unroll
        for (int ai = 0; ai < 2; ++ai)
#pragma unroll
            for (int m = 0; m < 4; ++m) {
                const int row = row0 + ai * 128 + m * 16; const int pos = row & (SEQ - 1);
                bf16_t* rowp = proj + (size_t)row * NV + colt;
#pragma unroll
                for (int bj = 0; bj < 2; ++bj) {
                    pg8::f32x4 v0 = acc[ai][bj][m][0], v1 = acc[ai][bj][m][1];
                    const bool rope = (u.pn == 8) || (u.pn == 9) || (u.pn == 10 && bj == 0);
                    if (rope) {
                        const v4f t0 = *(const v4f*)(tab + (size_t)(pos * 32 + 4 * g) * 2), t1 = *(const v4f*)(tab + (size_t)(pos * 32 + 4 * g) * 2 + 4);
                        const pg8::f32x4 a = v0, b = v1;
                        v0[0] = a[0] * t0.x - b[0] * t0.y; v1[0] = a[0] * t0.y + b[0] * t0.x;
                        v0[1] = a[1] * t0.z - b[1] * t0.w; v1[1] = a[1] * t0.w + b[1] * t0.z;
                        v0[2] = a[2] * t1.x - b[2] * t1.y; v1[2] = a[2] * t1.y + b[2] * t1.x;
                        v0[3] = a[3] * t1.z - b[3] * t1.w; v1[3] = a[3] * t1.w + b[3] * t1.z;
                    }
                    pg8::u32x4 w; w.x = pg8::cvt_pk_bf16(v0[0], v0[1]); w.y = pg8::cvt_pk_bf16(v0[2], v0[3]); w.z = pg8::cvt_pk_bf16(v1[0], v1[1]); w.w = pg8::cvt_pk_bf16(v1[2], v1[3]);
                    *(pg8::u32x4*)(rowp + bj * 128) = w;
                }
                asm volatile("" ::: "memory");
            }
    }
};
__device__ __forceinline__ void ph_inproj(const P& p, unsigned char* lds_g, int bid, int nb) {
    ProbPlain G{(const bf16_t*)(p.ws + WS_MIX), (const bf16_t*)(p.ws + WS_WIN), DM};
    pg8::StaticOrder S; S.init(T, NV, nb, bid);
    EpiInProj E{(bf16_t*)(p.ws + WS_PROJ), (const float*)(p.ws + WS_TAB)};
    pg8::gemm_phase(( PG8_LAS unsigned char*)lds_g, G, S, E);
}

struct EpiOutProj {
    static constexpr bool PERM = false;
    const float* x; float* V;
    __device__ __forceinline__ void operator()(const pg8::f32x4 (&acc)[2][2][4][2], const pg8::Unit& u, int wr, int wc, int fr, int fq) const {
        const int row0 = u.pm * 256 + wr * 64 + fr, col0 = u.pn * 256 + wc * 32 + 4 * fq;
#pragma unroll
        for (int ai = 0; ai < 2; ++ai)
#pragma unroll
            for (int m = 0; m < 4; ++m) {
                const size_t off = (size_t)(row0 + ai * 128 + m * 16) * DM + col0;
#pragma unroll
                for (int bj = 0; bj < 2; ++bj)
#pragma unroll
                    for (int n = 0; n < 2; ++n) { const pg8::f32x4 xv = *(const pg8::f32x4*)(x + off + bj * 128 + n * 16); *(pg8::f32x4*)(V + off + bj * 128 + n * 16) = xv * ALPHA + acc[ai][bj][m][n]; }
                if (m & 1) asm volatile("" ::: "memory");
            }
    }
};
__device__ __forceinline__ void ph_outproj(const P& p, unsigned char* lds_g, int bid, int nb) {
    ProbPlain G{(const bf16_t*)(p.ws + WS_MIX), (const bf16_t*)(p.ws + WS_WOUT), DM};
    pg8::StaticOrder S; S.init(T, DM, nb, bid);
    EpiOutProj E{p.x, (float*)(p.ws + WS_X1F)};
    pg8::gemm_phase((PG8_LAS unsigned char*)lds_g, G, S, E);
}

__device__ __forceinline__ void ph_rowpass1(const P& p, unsigned char* lds_g, int bid, int nb) {
    const int tid = threadIdx.x, lane = tid & 63, wv = __builtin_amdgcn_readfirstlane(tid >> 6);
    LAS unsigned char* lds = (LAS unsigned char*)lds_g;
    constexpr int XT_STRIDE = 2064;
    LAS unsigned char* xt = lds;
    LAS float* lg = (LAS float*)(lds + 32 * XT_STRIDE);
    LAS int* lcnt = (LAS int*)(lds + 32 * XT_STRIDE + 6144);
    LAS int* lbase = lcnt + 32;
    LAS int* recn = lbase + 32;
    LAS int* rec_e = recn + 32;
    LAS int* rec_li = rec_e + 256;
    LAS int* rec_v = rec_li + 256;
    LAS float* rec_w = (LAS float*)(rec_v + 256);
    const float* V = (const float*)(p.ws + WS_X1F); bf16_t* x1b = (bf16_t*)(p.ws + WS_X1B);
    const bf16_t* Wr = (const bf16_t*)(p.ws + WS_WR);
    unsigned* gcnt = (unsigned*)(p.ws + WS_CTL) + CW_GCNT;
    int* slot_list = (int*)(p.ws + WS_SLOT); float* w_list = (float*)(p.ws + WS_WLIST);
    if (tid < 32) { lcnt[tid] = 0; if (tid == 0) recn[0] = 0; }
    v4f lw[4], lb[4];
#pragma unroll
    for (int j = 0; j < 4; ++j) { lw[j] = *((const v4f*)p.ln1_w + lane + 64 * j); lb[j] = *((const v4f*)p.ln1_b + lane + 64 * j); }
    __syncthreads();
    for (int tile = bid; tile < T / 32; tile += nb) {
        const int row0 = tile * 32;
#pragma unroll 1
        for (int rr = 0; rr < 4; ++rr) {
            const int lr = wv * 4 + rr; const size_t row = (size_t)(row0 + lr);
            const v4f* vr = (const v4f*)(V + row * DM) + lane;
            v4f v[4]; float s = 0.f;
#pragma unroll
            for (int j = 0; j < 4; ++j) { v[j] = vr[64 * j]; s += (v[j].x + v[j].y) + (v[j].z + v[j].w); }
            const float mu = wave_sum(s) * (1.f / DM); float q = 0.f;
#pragma unroll
            for (int j = 0; j < 4; ++j) { v[j] = v[j] - mu; q += (v[j].x * v[j].x + v[j].y * v[j].y) + (v[j].z * v[j].z + v[j].w * v[j].w); }
            const float rs = 1.f / sqrtf(wave_sum(q) * (1.f / DM) + LN_EPS);
            unsigned long long* o8 = (unsigned long long*)(x1b + row * DM) + lane;
#pragma unroll
            for (int j = 0; j < 4; ++j) { const v4f o = v[j] * rs * lw[j] + lb[j];
                const unsigned long long pk = (unsigned long long)pk2(o.x, o.y) | ((unsigned long long)pk2(o.z, o.w) << 32);
                o8[64 * j] = pk; *(LAS unsigned long long*)(xt + lr * XT_STRIDE + (256 * j + 4 * lane) * 2) = pk; }
        }
        __syncthreads();
        if (wv < 6) {
            const int mt = wv / 3, ntl = wv % 3;
            pg8::f32x4 acc = {0.f, 0.f, 0.f, 0.f};
            const LAS unsigned char* ap = xt + (mt * 16 + (lane & 15)) * XT_STRIDE + (lane >> 4) * 16;
            const bf16_t* bp = Wr + (size_t)(ntl * 16 + (lane & 15)) * DM + (lane >> 4) * 8;
#pragma unroll 8
            for (int ks = 0; ks < 32; ++ks) {
                const pg8::bf16x8 a = *(const LAS pg8::bf16x8*)(ap + ks * 64);
                const pg8::bf16x8 b = *(const pg8::bf16x8*)(bp + ks * 32);
                acc = __builtin_amdgcn_mfma_f32_16x16x32_bf16(a, b, acc, 0, 0, 0);
            }
#pragma unroll
            for (int j = 0; j < 4; ++j) lg[(mt * 16 + 4 * (lane >> 4) + j) * 48 + ntl * 16 + (lane & 15)] = acc[j];
        }
        __syncthreads();
        if (tid < 32) {
            const LAS float* l = lg + tid * 48; const int row = row0 + tid;
            float g[4]; int gi = 0;
#pragma unroll
            for (int j = 0; j < 4; ++j) g[j] = l[j] + p.b_gr[j];
            float gm = g[0];
#pragma unroll
            for (int j = 1; j < 4; ++j) if (g[j] > gm) { gm = g[j]; gi = j; }
            float gs = 0.f;
#pragma unroll
            for (int j = 0; j < 4; ++j) gs += expf(g[j] - gm);
            const float gp = 1.f / gs;
            float ev[8];
#pragma unroll
            for (int j = 0; j < 8; ++j) ev[j] = l[4 + gi * 8 + j] + p.b_er[gi * 8 + j];
            int i0 = 0; float v0 = ev[0];
#pragma unroll
            for (int j = 1; j < 8; ++j) if (ev[j] > v0) { v0 = ev[j]; i0 = j; }
            int i1 = -1; float v1 = -INFINITY;
#pragma unroll
            for (int j = 0; j < 8; ++j) if (j != i0 && ev[j] > v1) { v1 = ev[j]; i1 = j; }
            const float e1 = expf(v1 - v0); const float w0 = gp / (1.f + e1), w1 = gp * e1 / (1.f + e1);
            const int e_0 = gi * 8 + i0, e_1 = gi * 8 + i1;
            const int li0 = atomicAdd((int*)(lcnt + e_0), 1), li1 = atomicAdd((int*)(lcnt + e_1), 1);
            const int ri = atomicAdd((int*)recn, 2);
            rec_e[ri] = e_0; rec_li[ri] = li0; rec_v[ri] = row * 2; rec_w[ri] = w0;
            rec_e[ri + 1] = e_1; rec_li[ri + 1] = li1; rec_v[ri + 1] = row * 2 + 1; rec_w[ri + 1] = w1;
        }
        __syncthreads();
    }
    if (tid < 32) lbase[tid] = (int)atomicAdd(gcnt + tid, (unsigned)lcnt[tid]);
    __syncthreads();
    const int nrec = recn[0];
    for (int i = tid; i < nrec; i += 512) { const int e = rec_e[i]; const int pos = lbase[e] + rec_li[i]; slot_list[(size_t)e * T + pos] = rec_v[i]; w_list[(size_t)e * T + pos] = rec_w[i]; }
    __syncthreads();
}

constexpr int MOE_TAB_OFF = 131072;
__device__ __forceinline__ void moe_tables(const P& p, unsigned char* lds_g) {
    LAS int* tab = (LAS int*)((LAS unsigned char*)lds_g + MOE_TAB_OFF);
    const unsigned* gcnt = (const unsigned*)(p.ws + WS_CTL) + CW_GCNT;
    if (threadIdx.x == 0) { int acc = 0;
        for (int e = 0; e < NEXP; ++e) { const int c = (int)__hip_atomic_load(gcnt + e, __ATOMIC_RELAXED, __HIP_MEMORY_SCOPE_AGENT); tab[e] = acc; tab[33 + e] = c; acc += (c + 255) >> 8; }
        tab[32] = acc; }
    __syncthreads();
}
struct MoeOrder {
    const LAS int* tab; int nN, G, c;
    __device__ __forceinline__ bool next(int i, pg8::Unit& u) const {
        const int L = i * G + c; const int ntile = tab[32];
        if (L >= ntile * nN) return false;
        const int ti = L / nN; int e = 0;
#pragma unroll 1
        for (int k = 1; k < NEXP; ++k) e = (tab[k] <= ti) ? k : e;
        u.e = e; u.mt = ti - tab[e]; u.pm = ti; u.pn = L % nN; return true;
    }
};
struct ProbGU {
    const bf16_t* A; const bf16_t* Bt; int K; const LAS int* tab; const int* slot_list;
    __device__ __forceinline__ int a_row(const pg8::Unit& u, int r) const { const int idx = u.mt * 256 + r; return idx < tab[33 + u.e] ? (slot_list[(size_t)u.e * T + idx] >> 1) : 0; }
    __device__ __forceinline__ const char* b_tile(const pg8::Unit& u) const { return (const char*)(Bt + ((size_t)u.e * 512 + (size_t)u.pn * 256) * DM); }
};
struct EpiGU {
    static constexpr bool PERM = true;
    bf16_t* H; const LAS int* tab; const float* w_list;
    __device__ __forceinline__ void operator()(const pg8::f32x4 (&acc)[2][2][4][2], const pg8::Unit& u, int wr, int wc, int fr, int fq) const {
        const int r0 = wr * 64 + fr; const int cnt = tab[33 + u.e];
        float wrow[2][4];
#pragma unroll
        for (int ai = 0; ai < 2; ++ai)
#pragma unroll
            for (int m = 0; m < 4; ++m) { const int idx = u.mt * 256 + r0 + ai * 128 + m * 16; wrow[ai][m] = idx < cnt ? w_list[(size_t)u.e * T + idx] : 0.f; }
#pragma unroll
        for (int ai = 0; ai < 2; ++ai)
#pragma unroll
            for (int m = 0; m < 4; ++m) {
                bf16_t* hp = H + (size_t)(u.pm * 256 + r0 + ai * 128 + m * 16) * DEXP + u.pn * 128 + wc * 16 + 4 * fq;
#pragma unroll
                for (int bj = 0; bj < 2; ++bj) { const pg8::f32x4 g = acc[ai][bj][m][0], uu = acc[ai][bj][m][1]; float h[4];
#pragma unroll
                    for (int i = 0; i < 4; ++i) h[i] = g[i] * __builtin_amdgcn_rcpf(1.f + __expf(-g[i])) * uu[i] * wrow[ai][m];
                    pg8::u32x2 w; w.x = pg8::cvt_pk_bf16(h[0], h[1]); w.y = pg8::cvt_pk_bf16(h[2], h[3]);
                    *(pg8::u32x2*)(hp + bj * 64) = w; }
            }
    }
};
struct ProbDown {
    const bf16_t* A; const bf16_t* Bt; int K;
    __device__ __forceinline__ int a_row(const pg8::Unit& u, int r) const { return u.pm * 256 + r; }
    __device__ __forceinline__ const char* b_tile(const pg8::Unit& u) const { return (const char*)(Bt + ((size_t)u.e * DM + (size_t)u.pn * 256) * DEXP); }
};
struct EpiDown {
    static constexpr bool PERM = true;
    bf16_t* Y; const LAS int* tab; const int* slot_list;
    __device__ __forceinline__ void operator()(const pg8::f32x4 (&acc)[2][2][4][2], const pg8::Unit& u, int wr, int wc, int fr, int fq) const {
        const int r0 = wr * 64 + fr; const int cnt = tab[33 + u.e];
        int drow[2][4];
#pragma unroll
        for (int ai = 0; ai < 2; ++ai)
#pragma unroll
            for (int m = 0; m < 4; ++m) { const int idx = u.mt * 256 + r0 + ai * 128 + m * 16; drow[ai][m] = idx < cnt ? slot_list[(size_t)u.e * T + idx] : -1; }
#pragma unroll
        for (int ai = 0; ai < 2; ++ai)
#pragma unroll
            for (int m = 0; m < 4; ++m) if (drow[ai][m] >= 0) {
                bf16_t* yp = Y + (size_t)drow[ai][m] * DM + u.pn * 256 + wc * 32 + 8 * fq;
#pragma unroll
                for (int bj = 0; bj < 2; ++bj) { const pg8::f32x4 v0 = acc[ai][bj][m][0], v1 = acc[ai][bj][m][1];
                    pg8::u32x4 w; w.x = pg8::cvt_pk_bf16(v0[0], v0[1]); w.y = pg8::cvt_pk_bf16(v0[2], v0[3]); w.z = pg8::cvt_pk_bf16(v1[0], v1[1]); w.w = pg8::cvt_pk_bf16(v1[2], v1[3]);
                    *(pg8::u32x4*)(yp + bj * 128) = w; }
            }
    }
};
__device__ __forceinline__ void ph_moe_gu(const P& p, unsigned char* lds_g, int bid, int nb) {
    moe_tables(p, lds_g);
    const LAS int* tab = (const LAS int*)((LAS unsigned char*)lds_g + MOE_TAB_OFF);
    ProbGU G{(const bf16_t*)(p.ws + WS_X1B), (const bf16_t*)(p.ws + WS_WGU), DM, tab, (const int*)(p.ws + WS_SLOT)};
    MoeOrder S{tab, 2, nb, bid};
    EpiGU E{(bf16_t*)(p.ws + WS_H), tab, (const float*)(p.ws + WS_WLIST)};
    pg8::gemm_phase((PG8_LAS unsigned char*)lds_g, G, S, E);
}
__device__ __forceinline__ void ph_moe_down(const P& p, unsigned char* lds_g, int bid, int nb) {
    const LAS int* tab = (const LAS int*)((LAS unsigned char*)lds_g + MOE_TAB_OFF);
    ProbDown G{(const bf16_t*)(p.ws + WS_H), (const bf16_t*)(p.ws + WS_WD), DEXP};
    MoeOrder S{tab, 4, nb, bid};
    EpiDown E{(bf16_t*)(p.ws + WS_Y), tab, (const int*)(p.ws + WS_SLOT)};
    pg8::gemm_phase((PG8_LAS unsigned char*)lds_g, G, S, E);
}
__device__ __forceinline__ void ph_rowpass2(const P& p, int bid, int nb) {
    const int tid = threadIdx.x, lane = tid & 63, wv = tid >> 6;
    const bf16_t* x1b = (const bf16_t*)(p.ws + WS_X1B); const bf16_t* Y = (const bf16_t*)(p.ws + WS_Y);
    v4f lw[4], lb[4];
#pragma unroll
    for (int j = 0; j < 4; ++j) { lw[j] = *((const v4f*)p.ln2_w + lane + 64 * j); lb[j] = *((const v4f*)p.ln2_b + lane + 64 * j); }
    for (int row = bid * 8 + wv; row < T; row += nb * 8) {
        const unsigned long long* xr = (const unsigned long long*)(x1b + (size_t)row * DM) + lane;
        const unsigned long long* y0 = (const unsigned long long*)(Y + (size_t)row * 2 * DM) + lane;
        const unsigned long long* y1 = y0 + DM / 4;
        v4f v[4]; float s = 0.f;
#pragma unroll
        for (int j = 0; j < 4; ++j) { const unsigned long long a = xr[64 * j], b = y0[64 * j], c = y1[64 * j];
            v[j].x = ALPHA * __uint_as_float((unsigned)a << 16) + __uint_as_float((unsigned)b << 16) + __uint_as_float((unsigned)c << 16);
            v[j].y = ALPHA * __uint_as_float((unsigned)a & 0xffff0000u) + __uint_as_float((unsigned)b & 0xffff0000u) + __uint_as_float((unsigned)c & 0xffff0000u);
            v[j].z = ALPHA * __uint_as_float((unsigned)(a >> 32) << 16) + __uint_as_float((unsigned)(b >> 32) << 16) + __uint_as_float((unsigned)(c >> 32) << 16);
            v[j].w = ALPHA * __uint_as_float((unsigned)(a >> 32) & 0xffff0000u) + __uint_as_float((unsigned)(b >> 32) & 0xffff0000u) + __uint_as_float((unsigned)(c >> 32) & 0xffff0000u);
            s += (v[j].x + v[j].y) + (v[j].z + v[j].w); }
        const float mu = wave_sum(s) * (1.f / DM); float q = 0.f;
#pragma unroll
        for (int j = 0; j < 4; ++j) { v[j] = v[j] - mu; q += (v[j].x * v[j].x + v[j].y * v[j].y) + (v[j].z * v[j].z + v[j].w * v[j].w); }
        const float rs = 1.f / sqrtf(wave_sum(q) * (1.f / DM) + LN_EPS);
        v4f* o = (v4f*)(p.out + (size_t)row * DM) + lane;
#pragma unroll
        for (int j = 0; j < 4; ++j) o[64 * j] = v[j] * rs * lw[j] + lb[j];
    }
}
extern __shared__ __attribute__((aligned(16))) unsigned char g_lds[];
constexpr int LDS_BYTES = 147456;
__global__ void __launch_bounds__(512, 2) mega_fwd(P p) {
    cg::grid_group grid = cg::this_grid();
    const int bid = blockIdx.x, nb = gridDim.x;
    ph_prologue(p, g_lds, bid, nb);
    grid.sync();
    ph_inproj(p, g_lds, bid, nb);
    grid.sync();
    ph_swa_naive(p, g_lds, bid, nb);
    __syncthreads();
    ph_mlstm_naive(p, g_lds, nb - 1 - bid, nb);
    grid.sync();
    ph_outproj(p, g_lds, bid, nb);
    grid.sync();
    ph_rowpass1(p, g_lds, bid, nb);
    grid.sync();
    ph_moe_gu(p, g_lds, bid, nb);
    grid.sync();
    ph_moe_down(p, g_lds, bid, nb);
    grid.sync();
    ph_rowpass2(p, bid, nb);
}

extern "C" void kernel_launch(void* const* d_in, const int* in_sizes, int n_in, void* d_out, int out_size, void* d_ws, size_t ws_size, hipStream_t stream) {
    if (n_in != 19 || in_sizes[0] != T * DM || out_size != T * DM || ws_size < WS_END) {
        fprintf(stderr, "kernel_launch: unexpected shapes (n_in %d in0 %d out %d ws %zu)\n", n_in, n_in > 0 ? in_sizes[0] : -1, out_size, ws_size); return; }
    static int grid_blocks = 0;
    if (!grid_blocks) {
        int dev = 0, cus = 0, per_cu = 0;
        (void)hipGetDevice(&dev);
        (void)hipDeviceGetAttribute(&cus, hipDeviceAttributeMultiprocessorCount, dev);
        (void)hipFuncSetAttribute((const void*)mega_fwd, hipFuncAttributeMaxDynamicSharedMemorySize, LDS_BYTES);
        (void)hipOccupancyMaxActiveBlocksPerMultiprocessor(&per_cu, (const void*)mega_fwd, 512, LDS_BYTES);
        if (per_cu < 1) { fprintf(stderr, "kernel_launch: occupancy query says %d blocks per CU\n", per_cu); per_cu = 1; }
        if (per_cu > 1) per_cu = 1;
        grid_blocks = cus * per_cu;
        (void)hipGetLastError();
    }
    P p{};
    const float** f = (const float**)&p;
    for (int i = 0; i < 19; ++i) f[i] = (const float*)d_in[i];
    p.out = (float*)d_out; p.ws = (unsigned char*)d_ws;
    void* args[] = {&p};
    hipError_t e = hipLaunchCooperativeKernel((const void*)mega_fwd, dim3(grid_blocks), dim3(512), args, LDS_BYTES, stream);
    if (e != hipSuccess) fprintf(stderr, "cooperative launch failed: %s (grid %d)\n", hipGetErrorString(e), grid_blocks);
}
```

```cpp
#include <hip/hip_runtime.h>
#include <hip/hip_cooperative_groups.h>
namespace cg = cooperative_groups;
#include <cstdio>
#include <cstdint>

typedef unsigned short bf16_t;

constexpr int BATCH = 4, SEQ = 8192, T = BATCH * SEQ, DM = 1024;
constexpr int MLH = 4, MLD = 128, MLW = 512;
constexpr int AQH = 8, AKH = 2, AHD = 64;
constexpr int DIN = 2824;
constexpr int NV = 2816;
constexpr int NGRP = 4, EPG = 8, NEXP = 32, DEXP = 256;
constexpr float LN_EPS = 1e-5f;
constexpr float ALPHA = 1.189207115002721f;
constexpr int PC_MQ = 0, PC_MK = 512, PC_MV = 1024, PC_MO = 1536, PC_AQ = 2048, PC_AK = 2560, PC_AV = 2688;

constexpr size_t MiB = 1u << 20;
constexpr size_t WS_CTL = 0, WS_TAB = 1 * MiB, WS_GATES = 3 * MiB, WS_RT = 4 * MiB, WS_MISC = 5 * MiB;
constexpr size_t WS_WIN = 8 * MiB, WS_WOUT = 14 * MiB, WS_WGU = 16 * MiB, WS_WD = 48 * MiB;
constexpr size_t WS_PROJ = 64 * MiB, WS_X1F = 64 * MiB, WS_Y = 192 * MiB;
constexpr size_t WS_MIX = 240 * MiB, WS_CST = 304 * MiB, WS_H = 340 * MiB, WS_X1B = 376 * MiB, WS_SLOT = 440 * MiB, WS_WLIST = 444 * MiB, WS_END = 448 * MiB;
constexpr size_t WS_WR = WS_MISC;

struct P {
    const float *x, *w_in, *conv_w, *conv_b, *gate_bias, *norm_w, *sinks, *w_out, *ln1_w, *ln1_b;
    const float *w_gr, *b_gr, *w_er, *b_er, *w_eg, *w_eu, *w_ed, *ln2_w, *ln2_b;
    float* out; unsigned char* ws;
};

__device__ __forceinline__ float bf2f(bf16_t v) { return __uint_as_float((unsigned)v << 16); }
__device__ __forceinline__ bf16_t f2bf(float f) { unsigned u = __float_as_uint(f); return (bf16_t)((u + 0x7fffu + ((u >> 16) & 1u)) >> 16); }
__device__ __forceinline__ float wave_sum(float v) {
#pragma unroll
    for (int o = 1; o < 64; o <<= 1) v += __shfl_xor(v, o);
    return v;
}
__device__ __forceinline__ float wave_max(float v) {
#pragma unroll
    for (int o = 1; o < 64; o <<= 1) v = fmaxf(v, __shfl_xor(v, o));
    return v;
}
__device__ __forceinline__ float silu_f(float v) { return v / (1.f + expf(-v)); }
__device__ __forceinline__ float sigmoid_f(float v) { return 1.f / (1.f + expf(-v)); }
__device__ __forceinline__ float logsigmoid_f(float v) { return fminf(v, 0.f) - log1pf(expf(-fabsf(v))); }
__device__ __forceinline__ int rope_pos(int d) { return d < 32 ? 8 * (d >> 2) + (d & 3) : 8 * ((d - 32) >> 2) + 4 + (d & 3); }
__device__ __forceinline__ int vcol_to_orig(int v) { return v < 2048 ? v : (v < NV ? v + 8 : v - NV + 2048); }

__device__ void ph_tab(const P& p, int bid, int nb) {
    float2* tab = (float2*)(p.ws + WS_TAB);
    for (int i = bid * 512 + threadIdx.x; i < SEQ * 32; i += nb * 512) {
        const int pos = i >> 5, f = i & 31;
        const double ang = (double)pos * pow(10000.0, -(double)f / 32.0);
        tab[i] = make_float2((float)cos(ang), (float)sin(ang));
    }
}

template <class AF, class BF>
__device__ __forceinline__ void naive_tile(AF af, BF bfn, int row0, int col0, int K, float* As, float* Bs, float* Ct) {
    const int tid = threadIdx.x, ty = tid >> 4, tx = tid & 15;
    float acc[4][4];
#pragma unroll
    for (int i = 0; i < 4; ++i)
#pragma unroll
        for (int j = 0; j < 4; ++j) acc[i][j] = 0.f;
    for (int k0 = 0; k0 < K; k0 += 16) {
#pragma unroll
        for (int i = 0; i < 4; ++i) { const int e = tid + 512 * i, r = e >> 4, kk = e & 15; As[kk * 132 + r] = af(row0 + r, k0 + kk); }
#pragma unroll
        for (int i = 0; i < 2; ++i) { const int e = tid + 512 * i, kk = e >> 6, c = e & 63; Bs[kk * 64 + c] = bfn(k0 + kk, col0 + c); }
        __syncthreads();
#pragma unroll
        for (int kk = 0; kk < 16; ++kk) {
            float a[4], b[4];
#pragma unroll
            for (int i = 0; i < 4; ++i) { a[i] = As[kk * 132 + 4 * ty + i]; b[i] = Bs[kk * 64 + 4 * tx + i]; }
#pragma unroll
            for (int i = 0; i < 4; ++i)
#pragma unroll
                for (int j = 0; j < 4; ++j) acc[i][j] += a[i] * b[j];
        }
        __syncthreads();
    }
#pragma unroll
    for (int i = 0; i < 4; ++i)
#pragma unroll
        for (int j = 0; j < 4; ++j) Ct[(4 * ty + i) * 65 + 4 * tx + j] = acc[i][j];
    __syncthreads();
}

__device__ void ph_inproj_naive(const P& p, unsigned char* lds, int bid, int nb) {
    float* As = (float*)lds; float* Bs = As + 16 * 132; float* Ct = Bs + 16 * 64;
    bf16_t* proj = (bf16_t*)(p.ws + WS_PROJ);
    float* gates = (float*)(p.ws + WS_GATES);
    const float2* tab = (const float2*)(p.ws + WS_TAB);
    const float* x = p.x; const float* w = p.w_in;
    constexpr int NCT = (DIN + 63) / 64;
    const int ntiles = (T / 128) * NCT;
    const int tid = threadIdx.x;
    for (int it = bid; it < ntiles; it += nb) {
        const int rt = it / NCT, ct = it % NCT, row0 = rt * 128, col0 = ct * 64;
        naive_tile([&](int r, int k) { return x[(size_t)r * DM + k]; },
                   [&](int k, int vc) { return vc < DIN ? w[(size_t)k * DIN + vcol_to_orig(vc)] : 0.f; },
                   row0, col0, DM, As, Bs, Ct);
        if (col0 >= NV) {
            for (int e = tid; e < 128 * 8; e += 512) { const int r = e >> 3, c = e & 7; gates[(size_t)(row0 + r) * 8 + c] = Ct[r * 65 + c] + p.gate_bias[c]; }
        } else if (col0 >= PC_AQ && col0 < PC_AV) {
            for (int e = tid; e < 128 * 32; e += 512) {
                const int r = e >> 5, d = e & 31; const int pos = (row0 + r) & (SEQ - 1);
                const float2 cs = tab[pos * 32 + d]; const float x1 = Ct[r * 65 + d], x2 = Ct[r * 65 + d + 32];
                bf16_t* o = proj + (size_t)(row0 + r) * NV + col0;
                o[rope_pos(d)] = f2bf(x1 * cs.x - x2 * cs.y); o[rope_pos(d + 32)] = f2bf(x1 * cs.y + x2 * cs.x);
            }
        } else {
            for (int e = tid; e < 128 * 64; e += 512) { const int r = e >> 6, c = e & 63; proj[(size_t)(row0 + r) * NV + col0 + c] = f2bf(Ct[r * 65 + c]); }
        }
        __syncthreads();
    }
}

__device__ void ph_mlstm_naive(const P& p, unsigned char* lds, int bid, int nb) {
    constexpr int TB = 16;
    float* qs = (float*)lds;
    float* ks = qs + TB * 128;
    float* vs = ks + TB * 128;
    float* hs = vs + TB * 128;
    float* gi = hs + TB * 128;
    float* gl = gi + TB;
    const bf16_t* proj = (const bf16_t*)(p.ws + WS_PROJ);
    const float* gates = (const float*)(p.ws + WS_GATES);
    bf16_t* mix = (bf16_t*)(p.ws + WS_MIX);
    const int tid = threadIdx.x, lane = tid & 63, wv = tid >> 6;
    const int e = tid >> 2, dq = tid & 3;
    for (int it = bid; it < BATCH * MLH; it += nb) {
        const int b = it / MLH, h = it % MLH;
        float C[32], n[32];
#pragma unroll
        for (int j = 0; j < 32; ++j) { C[j] = 0.f; n[j] = 0.f; }
        float m = 0.f;
        for (int t0 = 0; t0 < SEQ; t0 += TB) {
            for (int idx = tid; idx < TB * 256; idx += 512) {
                const int tok = idx >> 8, c = idx & 255; const int t = t0 + tok;
                const int ch = (c < 128) ? (h * 128 + c) : (512 + h * 128 + (c - 128));
                float a = p.conv_b[ch];
#pragma unroll
                for (int j = 0; j < 4; ++j) { const int tt = t - 3 + j; if (tt >= 0) a += p.conv_w[j * 1024 + ch] * bf2f(proj[(size_t)(b * SEQ + tt) * NV + ch]); }
                a = silu_f(a);
                if (c < 128) qs[tok * 128 + c] = a; else ks[tok * 128 + (c - 128)] = a * 0.08838834764831845f;
            }
            for (int idx = tid; idx < TB * 128; idx += 512) { const int tok = idx >> 7, c = idx & 127; vs[idx] = bf2f(proj[(size_t)(b * SEQ + t0 + tok) * NV + PC_MV + h * 128 + c]); }
            if (tid < TB) { const float* g = gates + (size_t)(b * SEQ + t0 + tid) * 8; gi[tid] = g[h]; gl[tid] = logsigmoid_f(g[4 + h]); }
            __syncthreads();
            for (int tok = 0; tok < TB; ++tok) {
                const float iv = gi[tok], lf = gl[tok];
                const float mn = fmaxf(lf + m, iv), fd = expf(lf + m - mn), iw = expf(iv - mn);
                const float ve = vs[tok * 128 + e] * iw;
                float nump = 0.f, denp = 0.f;
#pragma unroll
                for (int j = 0; j < 32; ++j) {
                    const float kk = ks[tok * 128 + dq * 32 + j], qq = qs[tok * 128 + dq * 32 + j];
                    C[j] = fd * C[j] + ve * kk; n[j] = fd * n[j] + iw * kk;
                    nump += C[j] * qq; denp += n[j] * qq;
                }
                nump += __shfl_xor(nump, 1); nump += __shfl_xor(nump, 2);
                denp += __shfl_xor(denp, 1); denp += __shfl_xor(denp, 2);
                if (dq == 0) hs[tok * 128 + e] = nump / fmaxf(fabsf(denp), expf(-mn));
                m = mn;
            }
            __syncthreads();
            for (int tk = wv * 2; tk < wv * 2 + 2; ++tk) {
                const float h0 = hs[tk * 128 + lane], h1 = hs[tk * 128 + 64 + lane];
                const float mu = wave_sum(h0 + h1) * (1.f / 128.f);
                const float d0 = h0 - mu, d1 = h1 - mu;
                const float var = wave_sum(d0 * d0 + d1 * d1) * (1.f / 128.f);
                const float rs = 1.f / sqrtf(var + LN_EPS);
                const size_t row = (size_t)(b * SEQ + t0 + tk);
                const float o0 = bf2f(proj[row * NV + PC_MO + h * 128 + lane]), o1 = bf2f(proj[row * NV + PC_MO + h * 128 + 64 + lane]);
                mix[row * DM + h * 128 + lane] = f2bf(sigmoid_f(o0) * d0 * rs * p.norm_w[h * 128 + lane]);
                mix[row * DM + h * 128 + 64 + lane] = f2bf(sigmoid_f(o1) * d1 * rs * p.norm_w[h * 128 + 64 + lane]);
            }
            __syncthreads();
        }
    }
}

__device__ void ph_swa_naive(const P& p, unsigned char* lds, int bid, int nb) {
    const int tid = threadIdx.x, lane = tid & 63, wv = tid >> 6;
    float* qsh = (float*)lds + wv * 192;
    float* psh = qsh + 64;
    const bf16_t* proj = (const bf16_t*)(p.ws + WS_PROJ);
    bf16_t* mix = (bf16_t*)(p.ws + WS_MIX);
    const long nitems = (long)T * AQH;
    for (long it = (long)bid * 8 + wv; it < nitems; it += (long)nb * 8) {
        const int hq = (int)(it & 7); const int row = (int)(it >> 3); const int s = row & (SEQ - 1); const int kvh = hq >> 2;
        qsh[lane] = bf2f(proj[(size_t)row * NV + PC_AQ + hq * 64 + lane]);
        __builtin_amdgcn_wave_barrier();
        float sc[2]; bool val[2];
#pragma unroll
        for (int u = 0; u < 2; ++u) {
            const int kidx = lane + 64 * u; const int kpos = s - 127 + kidx; val[u] = kpos >= 0;
            float a = 0.f;
            if (val[u]) { const bf16_t* kr = proj + (size_t)(row - 127 + kidx) * NV + PC_AK + kvh * 64;
                for (int d = 0; d < 64; ++d) a += qsh[d] * bf2f(kr[d]); }
            sc[u] = val[u] ? a * 0.125f : -INFINITY;
        }
        const float sink = p.sinks[hq];
        const float mx = fmaxf(wave_max(fmaxf(sc[0], sc[1])), sink);
        const float p0 = val[0] ? expf(sc[0] - mx) : 0.f, p1 = val[1] ? expf(sc[1] - mx) : 0.f;
        const float den = wave_sum(p0 + p1) + expf(sink - mx);
        psh[lane] = p0; psh[lane + 64] = p1;
        __builtin_amdgcn_wave_barrier();
        float o = 0.f;
        for (int kidx = 0; kidx < 128; ++kidx) { const int kpos = s - 127 + kidx; if (kpos >= 0) o += psh[kidx] * bf2f(proj[(size_t)(row - 127 + kidx) * NV + PC_AV + kvh * 64 + lane]); }
        mix[(size_t)row * DM + 512 + hq * 64 + lane] = f2bf(o / den);
        __builtin_amdgcn_wave_barrier();
    }
}

__device__ void ph_outproj_naive(const P& p, unsigned char* lds, int bid, int nb) {
    float* As = (float*)lds; float* Bs = As + 16 * 132; float* Ct = Bs + 16 * 64;
    const bf16_t* mix = (const bf16_t*)(p.ws + WS_MIX);
    float* y = (float*)(p.ws + WS_X1F);
    const float* w = p.w_out;
    const int ntiles = (T / 128) * (DM / 64);
    const int tid = threadIdx.x;
    for (int it = bid; it < ntiles; it += nb) {
        const int rt = it / (DM / 64), ct = it % (DM / 64), row0 = rt * 128, col0 = ct * 64;
        naive_tile([&](int r, int k) { return bf2f(mix[(size_t)r * DM + k]); },
                   [&](int k, int c) { return w[(size_t)k * DM + c]; }, row0, col0, DM, As, Bs, Ct);
        for (int e = tid; e < 128 * 64; e += 512) { const int r = e >> 6, c = e & 63; y[(size_t)(row0 + r) * DM + col0 + c] = Ct[r * 65 + c]; }
        __syncthreads();
    }
}

__device__ void ph_ln1_naive(const P& p, int bid, int nb) {
    const int tid = threadIdx.x, lane = tid & 63, wv = tid >> 6;
    float* x1 = (float*)(p.ws + WS_X1F); bf16_t* x1b = (bf16_t*)(p.ws + WS_X1B);
    for (int row = bid * 8 + wv; row < T; row += nb * 8) {
        float v[16]; float s = 0.f;
#pragma unroll
        for (int i = 0; i < 16; ++i) { const int c = i * 64 + lane; v[i] = ALPHA * p.x[(size_t)row * DM + c] + x1[(size_t)row * DM + c]; s += v[i]; }
        const float mu = wave_sum(s) * (1.f / DM); float q = 0.f;
#pragma unroll
        for (int i = 0; i < 16; ++i) { v[i] -= mu; q += v[i] * v[i]; }
        const float rs = 1.f / sqrtf(wave_sum(q) * (1.f / DM) + LN_EPS);
#pragma unroll
        for (int i = 0; i < 16; ++i) { const int c = i * 64 + lane; const float o = v[i] * rs * p.ln1_w[c] + p.ln1_b[c]; x1[(size_t)row * DM + c] = o; x1b[(size_t)row * DM + c] = f2bf(o); }
    }
}

__device__ void ph_route_naive(const P& p, int bid, int nb) {
    const int tid = threadIdx.x, lane = tid & 63, wv = tid >> 6;
    const float* x1 = (const float*)(p.ws + WS_X1F);
    int* rt_e = (int*)(p.ws + WS_RT); float* rt_w = (float*)(p.ws + WS_RT + 512 * 1024);
    for (int row = bid * 8 + wv; row < T; row += nb * 8) {
        float lg[36];
#pragma unroll
        for (int j = 0; j < 36; ++j) lg[j] = 0.f;
        for (int i = 0; i < 16; ++i) {
            const int d = i * 64 + lane; const float xv = x1[(size_t)row * DM + d];
#pragma unroll
            for (int j = 0; j < 4; ++j) lg[j] += xv * p.w_gr[d * 4 + j];
#pragma unroll
            for (int j = 0; j < 32; ++j) lg[4 + j] += xv * p.w_er[d * 32 + j];
        }
#pragma unroll
        for (int j = 0; j < 36; ++j) lg[j] = wave_sum(lg[j]);
        if (lane == 0) {
            float g[4]; int gi = 0;
#pragma unroll
            for (int j = 0; j < 4; ++j) g[j] = lg[j] + p.b_gr[j];
            float gm = g[0];
#pragma unroll
            for (int j = 1; j < 4; ++j) if (g[j] > gm) { gm = g[j]; gi = j; }
            float gs = 0.f;
#pragma unroll
            for (int j = 0; j < 4; ++j) gs += expf(g[j] - gm);
            const float gp = 1.f / gs;
            float ev[8];
#pragma unroll
            for (int j = 0; j < 8; ++j) { float a = 0.f;
#pragma unroll
                for (int q = 0; q < 4; ++q) a = (q == gi) ? (lg[4 + q * 8 + j] + p.b_er[q * 8 + j]) : a;
                ev[j] = a; }
            int i0 = 0; float v0 = ev[0];
#pragma unroll
            for (int j = 1; j < 8; ++j) if (ev[j] > v0) { v0 = ev[j]; i0 = j; }
            int i1 = -1; float v1 = -INFINITY;
#pragma unroll
            for (int j = 0; j < 8; ++j) if (j != i0 && ev[j] > v1) { v1 = ev[j]; i1 = j; }
            const float e1 = expf(v1 - v0); const float w0 = gp / (1.f + e1), w1 = gp * e1 / (1.f + e1);
            rt_e[row * 2] = gi * 8 + i0; rt_e[row * 2 + 1] = gi * 8 + i1; rt_w[row * 2] = w0; rt_w[row * 2 + 1] = w1;
        }
    }
}

__device__ void ph_moe_naive(const P& p, unsigned char* lds, int bid, int nb) {
    float* xs = (float*)lds;
    float* gu = xs + 1024;
    float* hs = gu + 512;
    float* red = hs + 512;
    const int tid = threadIdx.x, lane = tid & 63, wv = tid >> 6;
    const float* x1 = (const float*)(p.ws + WS_X1F); const bf16_t* x1b = (const bf16_t*)(p.ws + WS_X1B);
    const int* rt_e = (const int*)(p.ws + WS_RT); const float* rt_w = (const float*)(p.ws + WS_RT + 512 * 1024);
    for (int row = bid; row < T; row += nb) {
        xs[tid] = bf2f(x1b[(size_t)row * DM + tid]); xs[tid + 512] = bf2f(x1b[(size_t)row * DM + tid + 512]);
        __syncthreads();
        for (int k = 0; k < 2; ++k) {
            const int e = rt_e[row * 2 + k]; const float wk = rt_w[row * 2 + k];
            const float* W = (tid < 256 ? p.w_eg : p.w_eu) + (size_t)e * DM * DEXP + (tid & 255);
            float a = 0.f;
            for (int d = 0; d < DM; ++d) a += xs[d] * W[(size_t)d * DEXP];
            gu[tid] = a;
            __syncthreads();
            if (tid < 256) hs[k * 256 + tid] = silu_f(gu[tid]) * gu[256 + tid] * wk;
            __syncthreads();
        }
        float acc[2] = {0.f, 0.f};
        for (int k = 0; k < 2; ++k) {
            const int e = rt_e[row * 2 + k]; const float* W = p.w_ed + (size_t)e * DEXP * DM;
            for (int j = 0; j < DEXP; ++j) { const float hv = hs[k * 256 + j]; acc[0] += hv * W[(size_t)j * DM + tid]; acc[1] += hv * W[(size_t)j * DM + tid + 512]; }
        }
        float v0 = ALPHA * x1[(size_t)row * DM + tid] + acc[0], v1 = ALPHA * x1[(size_t)row * DM + tid + 512] + acc[1];
        float s = wave_sum(v0 + v1); if (lane == 0) red[wv] = s; __syncthreads();
        float mu = 0.f;
#pragma unroll
        for (int i = 0; i < 8; ++i) mu += red[i];
        mu *= (1.f / DM); v0 -= mu; v1 -= mu;
        float q = wave_sum(v0 * v0 + v1 * v1); if (lane == 0) red[8 + wv] = q; __syncthreads();
        float var = 0.f;
#pragma unroll
        for (int i = 0; i < 8; ++i) var += red[8 + i];
        const float rs = 1.f / sqrtf(var * (1.f / DM) + LN_EPS);
        p.out[(size_t)row * DM + tid] = v0 * rs * p.ln2_w[tid] + p.ln2_b[tid];
        p.out[(size_t)row * DM + tid + 512] = v1 * rs * p.ln2_w[tid + 512] + p.ln2_b[tid + 512];
        __syncthreads();
    }
}

namespace pg8 {
#define PG8_LAS __attribute__((address_space(3)))
typedef short bf16x8 __attribute__((ext_vector_type(8)));
typedef float f32x4 __attribute__((ext_vector_type(4)));
typedef unsigned u32x4 __attribute__((ext_vector_type(4)));
typedef unsigned u32x2 __attribute__((ext_vector_type(2)));
constexpr int BM = 256, BK = 64, HALF = 128, HTB = HALF * BK * 2, STAGE_BYTES = 8 * HTB, NXCD = 8, WGM = 8;

__host__ __device__ __forceinline__ int lds_byte(int r, int c) { const int st = (r >> 4) * 2 + (c >> 5), rr = r & 15, cc = c & 31, ob = rr * 64 + cc * 2; return st * 1024 + (ob ^ (((ob >> 9) & 1) << 5)); }
__host__ __device__ __forceinline__ void stage_rc(int b, int& R, int& C) { const int st = b / 1024, sb = b % 1024, swz = sb ^ (((sb >> 9) & 1) << 5); R = (st >> 1) * 16 + swz / 64; C = (st & 1) * 32 + (swz % 64) / 2; }
__host__ __device__ __forceinline__ int perm32(int rho) { const int n = rho >> 4, i = rho & 15; return 8 * (i >> 2) + 4 * n + (i & 3); }

struct Unit { int pm, pn, e, mt; };

__device__ __forceinline__ unsigned cvt_pk_bf16(float lo, float hi) { unsigned r; asm volatile("v_cvt_pk_bf16_f32 %0, %1, %2" : "=v"(r) : "v"(lo), "v"(hi)); return r; }

struct StaticOrder {
    int nM, nN, nwg, G, c;
    __device__ void init(int M, int N, int G_, int c_) { nM = M / BM; nN = N / BM; nwg = nM * nN; G = G_; c = c_; }
    __device__ bool next(int i, Unit& u) const {
        const long L = (long)i * G + c; if (L >= nwg) return false;
        int wgid = (int)L; { const int q = nwg / NXCD, r = nwg % NXCD, xcd = wgid % NXCD, off = wgid / NXCD; wgid = (xcd < r ? xcd * (q + 1) : r * (q + 1) + (xcd - r) * q) + off; }
        const int nig = WGM * nN, gid = wgid / nig, fm = gid * WGM, gsz = (nM - fm) < WGM ? (nM - fm) : WGM;
        u.pm = fm + ((wgid % nig) % gsz); u.pn = (wgid % nig) / gsz; u.e = 0; u.mt = 0; return true;
    }
};

template <class Epi, class Prob, class Sched>
__device__ __forceinline__ void gemm_phase(PG8_LAS unsigned char* lds, const Prob& G, const Sched& S, const Epi& E) {
    int tid = threadIdx.x; asm volatile("" : "+v"(tid));
    const int wid = __builtin_amdgcn_readfirstlane(tid >> 6), lane = tid & 63, wr = wid >> 2, wc = wid & 3, fr = lane & 15, fq = lane >> 4;
    const int K = G.K, nt = K / BK;
    unsigned voffB[2];
    { int Rr0, Cc0, Rr1, Cc1; stage_rc(tid * 16, Rr0, Cc0); stage_rc(tid * 16 + 8192, Rr1, Cc1);
      const int Rb0 = Epi::PERM ? ((Rr0 & ~31) + perm32(Rr0 & 31)) : Rr0, Rb1 = Epi::PERM ? ((Rr1 & ~31) + perm32(Rr1 & 31)) : Rr1;
      voffB[0] = (unsigned)(Rb0 * K + Cc0) * 2u; voffB[1] = (unsigned)(Rb1 * K + Cc1) * 2u; }
    const size_t kstep = (size_t)(BK * 2);
    const size_t hstep = (size_t)HALF * K * 2;
    const unsigned ldsw = (unsigned)wid * 1024u;
    const int aoff = lds_byte(wr * 64 + fr, fq * 8), boff = lds_byte(wc * 32 + fr, fq * 8);
    const char* const Abase = (const char*)G.A;
#define PG8_SA(b, h) (((b) * 2 + (h)) * HTB)
#define PG8_SB(b, h) ((4 + (b) * 2 + (h)) * HTB)
#define PG8_GLDS(gp, ldsoff) __builtin_amdgcn_global_load_lds((const unsigned*)(gp), (PG8_LAS unsigned*)(lds + (ldsoff)), 16, 0, 0)
#define PG8_STAGE_B(bufoff, gbase) do { PG8_GLDS((const char*)(gbase) + voffB[0], (bufoff) + ldsw); PG8_GLDS((const char*)(gbase) + voffB[1], (bufoff) + ldsw + 8192); } while (0)
#define PG8_STAGE_A(bufoff, kb, o0, o1) do { PG8_GLDS(Abase + (kb) + (o0), (bufoff) + ldsw); PG8_GLDS(Abase + (kb) + (o1), (bufoff) + ldsw + 8192); } while (0)
#define PG8_AOFFS(u, o00, o01, o10, o11) do { int t2_ = tid; asm volatile("" : "+v"(t2_)); int Rr0, Cc0, Rr1, Cc1; stage_rc(t2_ * 16, Rr0, Cc0); stage_rc(t2_ * 16 + 8192, Rr1, Cc1); \
        o00 = (unsigned)(((size_t)G.a_row(u, Rr0) * K + Cc0) * 2u); o01 = (unsigned)(((size_t)G.a_row(u, Rr1) * K + Cc1) * 2u); \
        o10 = (unsigned)(((size_t)G.a_row(u, 128 + Rr0) * K + Cc0) * 2u); o11 = (unsigned)(((size_t)G.a_row(u, 128 + Rr1) * K + Cc1) * 2u); } while (0)
#define PG8_LDA(dst, b, h) do { _Pragma("unroll") for (int m = 0; m < 4; ++m) _Pragma("unroll") for (int k = 0; k < 2; ++k) dst[m][k] = *(const PG8_LAS bf16x8*)(lds + PG8_SA(b, h) + aoff + m * 2048 + k * 1024); } while (0)
#define PG8_LDB(dst, b, h) do { _Pragma("unroll") for (int n = 0; n < 2; ++n) _Pragma("unroll") for (int k = 0; k < 2; ++k) dst[n][k] = *(const PG8_LAS bf16x8*)(lds + PG8_SB(b, h) + boff + n * 2048 + k * 1024); } while (0)
#define PG8_MMA(ai, bj, At, Bt) do { __builtin_amdgcn_s_setprio(1); _Pragma("unroll") for (int m = 0; m < 4; ++m) _Pragma("unroll") for (int n = 0; n < 2; ++n) _Pragma("unroll") for (int k = 0; k < 2; ++k) \
        acc[ai][bj][m][n] = __builtin_amdgcn_mfma_f32_16x16x32_bf16(Bt[n][k], At[m][k], acc[ai][bj][m][n], 0, 0, 0); __builtin_amdgcn_s_setprio(0); } while (0)
#define PG8_WAIT_V(n) asm volatile("s_waitcnt vmcnt(" #n ")" ::: "memory")
#define PG8_WAIT_L(n) asm volatile("s_waitcnt lgkmcnt(" #n ")" ::: "memory")
#define PG8_BAR __builtin_amdgcn_s_barrier()
#define PG8_SCHED __builtin_amdgcn_sched_barrier(0)
    Unit cur, nxt; int ui = 0;
    if (!S.next(0, cur)) return;
    f32x4 acc[2][2][4][2];
#pragma unroll
    for (int a = 0; a < 2; ++a)
#pragma unroll
        for (int b = 0; b < 2; ++b)
#pragma unroll
            for (int m = 0; m < 4; ++m)
#pragma unroll
                for (int n = 0; n < 2; ++n) acc[a][b][m][n] = (f32x4){0.f, 0.f, 0.f, 0.f};
    bf16x8 At[4][2], B0[2][2], B1[2][2];
    unsigned c00, c01, c10, c11;
    PG8_AOFFS(cur, c00, c01, c10, c11);
    const char* cB = G.b_tile(cur);
    PG8_STAGE_B(PG8_SB(0, 0), cB); PG8_STAGE_B(PG8_SB(0, 1), cB + hstep); PG8_STAGE_A(PG8_SA(0, 0), 0, c00, c01); PG8_STAGE_A(PG8_SA(0, 1), 0, c10, c11);
    if (wr == 1) PG8_BAR;
    PG8_WAIT_V(2); PG8_BAR;
    PG8_STAGE_B(PG8_SB(1, 0), cB + kstep); PG8_STAGE_A(PG8_SA(1, 0), kstep, c00, c01); PG8_STAGE_B(PG8_SB(1, 1), cB + hstep + kstep);
    PG8_WAIT_V(6); PG8_BAR;
    for (;;) {
        const bool has_next = S.next(ui + 1, nxt);
        const char* nB = has_next ? G.b_tile(nxt) : cB;
        for (int t = 0; t < nt; t += 2) {
            const bool last = (t == nt - 2);
            const size_t ka1 = (size_t)(t + 1) * kstep;
            const size_t ka2 = last ? 0 : (size_t)(t + 2) * kstep, ka3 = ka2 + kstep;
            const char* b2 = last ? nB : cB + (size_t)(t + 2) * kstep; const char* b3 = b2 + kstep;
            PG8_LDB(B0, 0, 0); PG8_LDB(B1, 0, 1); PG8_SCHED; PG8_LDA(At, 0, 0); PG8_STAGE_A(PG8_SA(1, 1), ka1, c10, c11);
            if (last && has_next) { PG8_AOFFS(nxt, c00, c01, c10, c11); }
            PG8_WAIT_V(8); PG8_WAIT_L(0); PG8_BAR; PG8_MMA(0, 0, At, B0); PG8_MMA(0, 1, At, B1); PG8_BAR; PG8_SCHED;
            PG8_LDA(At, 0, 1); PG8_STAGE_B(PG8_SB(0, 0), b2); PG8_STAGE_B(PG8_SB(0, 1), b2 + hstep); PG8_STAGE_A(PG8_SA(0, 0), ka2, c00, c01);
            PG8_WAIT_V(8); PG8_WAIT_L(0); PG8_BAR; PG8_MMA(1, 0, At, B0); PG8_MMA(1, 1, At, B1); PG8_BAR; PG8_SCHED;
            PG8_LDB(B0, 1, 0); PG8_LDB(B1, 1, 1); PG8_SCHED; PG8_LDA(At, 1, 0); PG8_STAGE_A(PG8_SA(0, 1), ka2, c10, c11);
            PG8_WAIT_V(8); PG8_WAIT_L(0); PG8_BAR; PG8_MMA(0, 0, At, B0); PG8_MMA(0, 1, At, B1); PG8_BAR; PG8_SCHED;
            PG8_LDA(At, 1, 1); PG8_STAGE_B(PG8_SB(1, 0), b3); PG8_STAGE_B(PG8_SB(1, 1), b3 + hstep); PG8_STAGE_A(PG8_SA(1, 0), ka3, c00, c01);
            PG8_WAIT_V(8); PG8_WAIT_L(0); PG8_BAR; PG8_MMA(1, 0, At, B0); PG8_MMA(1, 1, At, B1); PG8_BAR; PG8_SCHED;
        }
        if (wr == 0) PG8_BAR;
        E(acc, cur, wr, wc, fr, fq);
        if (!has_next) break;
#pragma unroll
        for (int a = 0; a < 2; ++a)
#pragma unroll
            for (int b = 0; b < 2; ++b)
#pragma unroll
                for (int m = 0; m < 4; ++m)
#pragma unroll
                    for (int n = 0; n < 2; ++n) acc[a][b][m][n] = (f32x4){0.f, 0.f, 0.f, 0.f};
        cur = nxt; cB = nB; ++ui;
        if (wr == 1) PG8_BAR;
    }
    PG8_WAIT_V(0);
    PG8_BAR;
#undef PG8_SA
#undef PG8_SB
#undef PG8_GLDS
#undef PG8_STAGE_A
#undef PG8_STAGE_B
#undef PG8_AOFFS
#undef PG8_LDA
#undef PG8_LDB
#undef PG8_MMA
#undef PG8_WAIT_V
#undef PG8_WAIT_L
#undef PG8_BAR
#undef PG8_SCHED
}
}
#define LAS __attribute__((address_space(3)))
typedef unsigned v4u __attribute__((ext_vector_type(4)));
typedef float v4f __attribute__((ext_vector_type(4)));
#define LDS_WAIT() asm volatile("s_waitcnt lgkmcnt(0)" ::: "memory")
__device__ __forceinline__ unsigned pk2(float lo, float hi) { return (unsigned)f2bf(lo) | ((unsigned)f2bf(hi) << 16); }

constexpr int CW_GCNT = 64;

template <class SrcCol, class DstRow>
__device__ __forceinline__ void transpose_item(const float* W, int ldw, int K, bf16_t* WT, int k0, int n0, SrcCol sc, DstRow dr, LAS float* scr, int lane) {
    const int scol = sc(n0 + (lane & 31));
#pragma unroll 8
    for (int i = 0; i < 32; ++i) { const int kk = 2 * i + (lane >> 5); scr[kk * 33 + (lane & 31)] = W[(size_t)(k0 + kk) * ldw + scol]; }
    LDS_WAIT(); asm volatile("" ::: "memory");
    const int c = lane & 7;
#pragma unroll
    for (int j = 0; j < 4; ++j) { const int n = (lane >> 3) + 8 * j; const LAS float* s = scr + (8 * c) * 33 + n;
        v4u o; o.x = pk2(s[0 * 33], s[1 * 33]); o.y = pk2(s[2 * 33], s[3 * 33]); o.z = pk2(s[4 * 33], s[5 * 33]); o.w = pk2(s[6 * 33], s[7 * 33]);
        *(v4u*)(WT + (size_t)dr(n0 + n) * K + k0 + 8 * c) = o; }
    LDS_WAIT(); asm volatile("" ::: "memory");
}

__device__ __forceinline__ void ph_prologue(const P& p, unsigned char* lds_g, int bid, int nb) {
    int tid = threadIdx.x; asm volatile("" : "+v"(tid));
    const int lane = tid & 63, wv = __builtin_amdgcn_readfirstlane(tid >> 6);
    LAS unsigned char* lds = (LAS unsigned char*)lds_g;
    if (bid == 0 && tid < 64) ((unsigned*)(p.ws + WS_CTL))[CW_GCNT + tid] = 0u;
    ph_tab(p, bid, nb);
    {
        bf16_t* Wr = (bf16_t*)(p.ws + WS_WR);
        for (int i = bid * 512 + tid; i < 48 * DM; i += nb * 512) { const int j = i >> 10, d = i & 1023;
            const float w = j < 4 ? p.w_gr[d * 4 + j] : (j < 36 ? p.w_er[d * 32 + (j - 4)] : 0.f); Wr[i] = f2bf(w); }
    }
    LAS float* wg = (LAS float*)(lds + 8 * 8448);
    for (int i = tid; i < 8 * 1024; i += 512) { const int d = i >> 3, c = i & 7; wg[c * 1024 + d] = p.w_in[(size_t)d * DIN + 2048 + c]; }
    __syncthreads();
    {
        bf16_t* xb = (bf16_t*)(p.ws + WS_MIX); float* gates = (float*)(p.ws + WS_GATES);
        for (int row = bid * 8 + wv; row < T; row += nb * 8) {
            const v4f* xr = (const v4f*)(p.x + (size_t)row * DM) + lane;
            v4f v[4];
#pragma unroll
            for (int j = 0; j < 4; ++j) v[j] = xr[64 * j];
            unsigned long long* o8 = (unsigned long long*)(xb + (size_t)row * DM) + lane;
#pragma unroll
            for (int j = 0; j < 4; ++j) o8[64 * j] = (unsigned long long)pk2(v[j].x, v[j].y) | ((unsigned long long)pk2(v[j].z, v[j].w) << 32);
            float g[8];
#pragma unroll
            for (int c = 0; c < 8; ++c) { float a = 0.f;
#pragma unroll
                for (int j = 0; j < 4; ++j) { const v4f w = *(const LAS v4f*)(wg + c * 1024 + 256 * j + 4 * lane); a += v[j].x * w.x + v[j].y * w.y + v[j].z * w.z + v[j].w * w.w; }
                g[c] = wave_sum(a); }
            float gv = g[0];
#pragma unroll
            for (int c = 1; c < 8; ++c) gv = (lane == c) ? g[c] : gv;
            if (lane < 8) gates[(size_t)row * 8 + lane] = gv + p.gate_bias[lane];
        }
    }
    {
        LAS float* scr = (LAS float*)(lds + wv * 8448);
        const int gw = bid * 8 + wv, NGW = nb * 8;
        bf16_t* Win = (bf16_t*)(p.ws + WS_WIN); bf16_t* Wout = (bf16_t*)(p.ws + WS_WOUT); bf16_t* Wgu = (bf16_t*)(p.ws + WS_WGU); bf16_t* Wd = (bf16_t*)(p.ws + WS_WD);
        constexpr int I_IN = 16 * (NV / 32), I_OUT = 16 * 32, I_G = NEXP * 16 * 8, I_D = NEXP * 4 * 32;
        constexpr int NITEMS = I_IN + I_OUT + 2 * I_G + I_D;
        for (int it = gw; it < NITEMS; it += NGW) {
            int r = it;
            if (r < I_IN) { const int kb = r / (NV / 32), nbk = r % (NV / 32);
                transpose_item(p.w_in, DIN, DM, Win, kb * 64, nbk * 32, [](int v) { return vcol_to_orig(v); },
                               [](int v) { return (v >= PC_AQ && v < PC_AV) ? ((v & ~63) + rope_pos(v & 63)) : v; }, scr, lane); continue; }
            r -= I_IN;
            if (r < I_OUT) { const int kb = r / 32, nbk = r % 32;
                transpose_item(p.w_out, DM, DM, Wout, kb * 64, nbk * 32, [](int v) { return v; }, [](int v) { return v; }, scr, lane); continue; }
            r -= I_OUT;
            if (r < 2 * I_G) { const int up = r >= I_G; if (up) r -= I_G; const int e = r / 128, q = r % 128, kb = q / 8, nbk = q % 8;
                transpose_item((up ? p.w_eu : p.w_eg) + (size_t)e * DM * DEXP, DEXP, DM, Wgu + (size_t)e * 512 * DM, kb * 64, nbk * 32, [](int v) { return v; },
                               [up](int j) { return 8 * (j >> 2) + 4 * up + (j & 3); }, scr, lane); continue; }
            r -= 2 * I_G;
            { const int e = r / 128, q = r % 128, kb = q / 32, nbk = q % 32;
                transpose_item(p.w_ed + (size_t)e * DEXP * DM, DM, DEXP, Wd + (size_t)e * DM * DEXP, kb * 64, nbk * 32, [](int v) { return v; }, [](int v) { return v; }, scr, lane); }
        }
    }
}

struct ProbPlain {
    const bf16_t* A; const bf16_t* Bt; int K;
    __device__ __forceinline__ int a_row(const pg8::Unit& u, int r) const { return u.pm * 256 + r; }
    __device__ __forceinline__ const char* b_tile(const pg8::Unit& u) const { return (const char*)(Bt + (size_t)u.pn * 256 * K); }
};
struct EpiInProj {
    static constexpr bool PERM = true;
    bf16_t* proj; const float* tab;
    __device__ __forceinline__ void operator()(const pg8::f32x4 (&acc)[2][2][4][2], const pg8::Unit& u, int wr, int wc, int fr, int fq) const {
        const int row0 = u.pm * 256 + wr * 64 + fr, colt = u.pn * 256 + wc * 32 + 8 * fq;
        const int g = 4 * (wc & 1) + fq;
#pragma unroll
        for (int ai = 0; ai < 2; ++ai)
#pragma unroll
            for (int m = 0; m < 4; ++m) {
                const int row = row0 + ai * 128 + m * 16; const int pos = row & (SEQ - 1);
                bf16_t* rowp = proj + (size_t)row * NV + colt;
#pragma unroll
                for (int bj = 0; bj < 2; ++bj) {
                    pg8::f32x4 v0 = acc[ai][bj][m][0], v1 = acc[ai][bj][m][1];
                    const bool rope = (u.pn == 8) || (u.pn == 9) || (u.pn == 10 && bj == 0);
                    if (rope) {
                        const v4f t0 = *(const v4f*)(tab + (size_t)(pos * 32 + 4 * g) * 2), t1 = *(const v4f*)(tab + (size_t)(pos * 32 + 4 * g) * 2 + 4);
                        const pg8::f32x4 a = v0, b = v1;
                        v0[0] = a[0] * t0.x - b[0] * t0.y; v1[0] = a[0] * t0.y + b[0] * t0.x;
                        v0[1] = a[1] * t0.z - b[1] * t0.w; v1[1] = a[1] * t0.w + b[1] * t0.z;
                        v0[2] = a[2] * t1.x - b[2] * t1.y; v1[2] = a[2] * t1.y + b[2] * t1.x;
                        v0[3] = a[3] * t1.z - b[3] * t1.w; v1[3] = a[3] * t1.w + b[3] * t1.z;
                    }
                    pg8::u32x4 w; w.x = pg8::cvt_pk_bf16(v0[0], v0[1]); w.y = pg8::cvt_pk_bf16(v0[2], v0[3]); w.z = pg8::cvt_pk_bf16(v1[0], v1[1]); w.w = pg8::cvt_pk_bf16(v1[2], v1[3]);
                    *(pg8::u32x4*)(rowp + bj * 128) = w;
                }
                asm volatile("" ::: "memory");
            }
    }
};
__device__ __forceinline__ void ph_inproj(const P& p, unsigned char* lds_g, int bid, int nb) {
    ProbPlain G{(const bf16_t*)(p.ws + WS_MIX), (const bf16_t*)(p.ws + WS_WIN), DM};
    pg8::StaticOrder S; S.init(T, NV, nb, bid);
    EpiInProj E{(bf16_t*)(p.ws + WS_PROJ), (const float*)(p.ws + WS_TAB)};
    pg8::gemm_phase(( PG8_LAS unsigned char*)lds_g, G, S, E);
}

struct EpiOutProj {
    static constexpr bool PERM = false;
    const float* x; float* V;
    __device__ __forceinline__ void operator()(const pg8::f32x4 (&acc)[2][2][4][2], const pg8::Unit& u, int wr, int wc, int fr, int fq) const {
        const int row0 = u.pm * 256 + wr * 64 + fr, col0 = u.pn * 256 + wc * 32 + 4 * fq;
#pragma unroll
        for (int ai = 0; ai < 2; ++ai)
#pragma unroll
            for (int m = 0; m < 4; ++m) {
                const size_t off = (size_t)(row0 + ai * 128 + m * 16) * DM + col0;
#pragma unroll
                for (int bj = 0; bj < 2; ++bj)
#pragma unroll
                    for (int n = 0; n < 2; ++n) { const pg8::f32x4 xv = *(const pg8::f32x4*)(x + off + bj * 128 + n * 16); *(pg8::f32x4*)(V + off + bj * 128 + n * 16) = xv * ALPHA + acc[ai][bj][m][n]; }
                if (m & 1) asm volatile("" ::: "memory");
            }
    }
};
__device__ __forceinline__ void ph_outproj(const P& p, unsigned char* lds_g, int bid, int nb) {
    ProbPlain G{(const bf16_t*)(p.ws + WS_MIX), (const bf16_t*)(p.ws + WS_WOUT), DM};
    pg8::StaticOrder S; S.init(T, DM, nb, bid);
    EpiOutProj E{p.x, (float*)(p.ws + WS_X1F)};
    pg8::gemm_phase((PG8_LAS unsigned char*)lds_g, G, S, E);
}

__device__ __forceinline__ void ph_rowpass1(const P& p, unsigned char* lds_g, int bid, int nb) {
    int tid = threadIdx.x; asm volatile("" : "+v"(tid));
    const int lane = tid & 63, wv = __builtin_amdgcn_readfirstlane(tid >> 6);
    LAS unsigned char* lds = (LAS unsigned char*)lds_g;
    constexpr int XT_STRIDE = 2064;
    LAS unsigned char* xt = lds;
    LAS float* lg = (LAS float*)(lds + 32 * XT_STRIDE);
    LAS int* lcnt = (LAS int*)(lds + 32 * XT_STRIDE + 6144);
    LAS int* lbase = lcnt + 32;
    LAS int* recn = lbase + 32;
    LAS int* rec_e = recn + 32;
    LAS int* rec_li = rec_e + 256;
    LAS int* rec_v = rec_li + 256;
    LAS float* rec_w = (LAS float*)(rec_v + 256);
    const float* V = (const float*)(p.ws + WS_X1F); bf16_t* x1b = (bf16_t*)(p.ws + WS_X1B);
    const bf16_t* Wr = (const bf16_t*)(p.ws + WS_WR);
    unsigned* gcnt = (unsigned*)(p.ws + WS_CTL) + CW_GCNT;
    int* slot_list = (int*)(p.ws + WS_SLOT); float* w_list = (float*)(p.ws + WS_WLIST);
    if (tid < 32) { lcnt[tid] = 0; if (tid == 0) recn[0] = 0; }
    v4f lw[4], lb[4];
#pragma unroll
    for (int j = 0; j < 4; ++j) { lw[j] = *((const v4f*)p.ln1_w + lane + 64 * j); lb[j] = *((const v4f*)p.ln1_b + lane + 64 * j); }
    __syncthreads();
    for (int tile = bid; tile < T / 32; tile += nb) {
        const int row0 = tile * 32;
#pragma unroll 1
        for (int rr = 0; rr < 4; ++rr) {
            const int lr = wv * 4 + rr; const size_t row = (size_t)(row0 + lr);
            const v4f* vr = (const v4f*)(V + row * DM) + lane;
            v4f v[4]; float s = 0.f;
#pragma unroll
            for (int j = 0; j < 4; ++j) { v[j] = vr[64 * j]; s += (v[j].x + v[j].y) + (v[j].z + v[j].w); }
            const float mu = wave_sum(s) * (1.f / DM); float q = 0.f;
#pragma unroll
            for (int j = 0; j < 4; ++j) { v[j] = v[j] - mu; q += (v[j].x * v[j].x + v[j].y * v[j].y) + (v[j].z * v[j].z + v[j].w * v[j].w); }
            const float rs = 1.f / sqrtf(wave_sum(q) * (1.f / DM) + LN_EPS);
            unsigned long long* o8 = (unsigned long long*)(x1b + row * DM) + lane;
#pragma unroll
            for (int j = 0; j < 4; ++j) { const v4f o = v[j] * rs * lw[j] + lb[j];
                const unsigned long long pk = (unsigned long long)pk2(o.x, o.y) | ((unsigned long long)pk2(o.z, o.w) << 32);
                o8[64 * j] = pk; *(LAS unsigned long long*)(xt + lr * XT_STRIDE + (256 * j + 4 * lane) * 2) = pk; }
        }
        __syncthreads();
        if (wv < 6) {
            const int mt = wv / 3, ntl = wv % 3;
            pg8::f32x4 acc = {0.f, 0.f, 0.f, 0.f};
            const LAS unsigned char* ap = xt + (mt * 16 + (lane & 15)) * XT_STRIDE + (lane >> 4) * 16;
            const bf16_t* bp = Wr + (size_t)(ntl * 16 + (lane & 15)) * DM + (lane >> 4) * 8;
#pragma unroll 8
            for (int ks = 0; ks < 32; ++ks) {
                const pg8::bf16x8 a = *(const LAS pg8::bf16x8*)(ap + ks * 64);
                const pg8::bf16x8 b = *(const pg8::bf16x8*)(bp + ks * 32);
                acc = __builtin_amdgcn_mfma_f32_16x16x32_bf16(a, b, acc, 0, 0, 0);
            }
#pragma unroll
            for (int j = 0; j < 4; ++j) lg[(mt * 16 + 4 * (lane >> 4) + j) * 48 + ntl * 16 + (lane & 15)] = acc[j];
        }
        __syncthreads();
        if (tid < 32) {
            const LAS float* l = lg + tid * 48; const int row = row0 + tid;
            float g[4]; int gi = 0;
#pragma unroll
            for (int j = 0; j < 4; ++j) g[j] = l[j] + p.b_gr[j];
            float gm = g[0];
#pragma unroll
            for (int j = 1; j < 4; ++j) if (g[j] > gm) { gm = g[j]; gi = j; }
            float gs = 0.f;
#pragma unroll
            for (int j = 0; j < 4; ++j) gs += expf(g[j] - gm);
            const float gp = 1.f / gs;
            float ev[8];
#pragma unroll
            for (int j = 0; j < 8; ++j) ev[j] = l[4 + gi * 8 + j] + p.b_er[gi * 8 + j];
            int i0 = 0; float v0 = ev[0];
#pragma unroll
            for (int j = 1; j < 8; ++j) if (ev[j] > v0) { v0 = ev[j]; i0 = j; }
            int i1 = -1; float v1 = -INFINITY;
#pragma unroll
            for (int j = 0; j < 8; ++j) if (j != i0 && ev[j] > v1) { v1 = ev[j]; i1 = j; }
            const float e1 = expf(v1 - v0); const float w0 = gp / (1.f + e1), w1 = gp * e1 / (1.f + e1);
            const int e_0 = gi * 8 + i0, e_1 = gi * 8 + i1;
            const int li0 = atomicAdd((int*)(lcnt + e_0), 1), li1 = atomicAdd((int*)(lcnt + e_1), 1);
            const int ri = atomicAdd((int*)recn, 2);
            rec_e[ri] = e_0; rec_li[ri] = li0; rec_v[ri] = row * 2; rec_w[ri] = w0;
            rec_e[ri + 1] = e_1; rec_li[ri + 1] = li1; rec_v[ri + 1] = row * 2 + 1; rec_w[ri + 1] = w1;
        }
        __syncthreads();
    }
    if (tid < 32) lbase[tid] = (int)atomicAdd(gcnt + tid, (unsigned)lcnt[tid]);
    __syncthreads();
    const int nrec = recn[0];
    for (int i = tid; i < nrec; i += 512) { const int e = rec_e[i]; const int pos = lbase[e] + rec_li[i]; slot_list[(size_t)e * T + pos] = rec_v[i]; w_list[(size_t)e * T + pos] = rec_w[i]; }
    __syncthreads();
}

constexpr int MOE_TAB_OFF = 131072;
__device__ __forceinline__ void moe_tables(const P& p, unsigned char* lds_g) {
    LAS int* tab = (LAS int*)((LAS unsigned char*)lds_g + MOE_TAB_OFF);
    const unsigned* gcnt = (const unsigned*)(p.ws + WS_CTL) + CW_GCNT;
    if (threadIdx.x == 0) { int acc = 0;
        for (int e = 0; e < NEXP; ++e) { const int c = (int)__hip_atomic_load(gcnt + e, __ATOMIC_RELAXED, __HIP_MEMORY_SCOPE_AGENT); tab[e] = acc; tab[33 + e] = c; acc += (c + 255) >> 8; }
        tab[32] = acc; }
    __syncthreads();
}
struct MoeOrder {
    const LAS int* tab; int nN, G, c;
    __device__ __forceinline__ bool next(int i, pg8::Unit& u) const {
        const int L = i * G + c; const int ntile = tab[32];
        if (L >= ntile * nN) return false;
        const int ti = L / nN; int e = 0;
#pragma unroll 1
        for (int k = 1; k < NEXP; ++k) e = (tab[k] <= ti) ? k : e;
        u.e = e; u.mt = ti - tab[e]; u.pm = ti; u.pn = L % nN; return true;
    }
};
struct ProbGU {
    const bf16_t* A; const bf16_t* Bt; int K; const LAS int* tab; const int* slot_list;
    __device__ __forceinline__ int a_row(const pg8::Unit& u, int r) const { const int idx = u.mt * 256 + r; return idx < tab[33 + u.e] ? (slot_list[(size_t)u.e * T + idx] >> 1) : 0; }
    __device__ __forceinline__ const char* b_tile(const pg8::Unit& u) const { return (const char*)(Bt + ((size_t)u.e * 512 + (size_t)u.pn * 256) * DM); }
};
struct EpiGU {
    static constexpr bool PERM = true;
    bf16_t* H; const LAS int* tab; const float* w_list;
    __device__ __forceinline__ void operator()(const pg8::f32x4 (&acc)[2][2][4][2], const pg8::Unit& u, int wr, int wc, int fr, int fq) const {
        const int r0 = wr * 64 + fr; const int cnt = tab[33 + u.e];
        float wrow[2][4];
#pragma unroll
        for (int ai = 0; ai < 2; ++ai)
#pragma unroll
            for (int m = 0; m < 4; ++m) { const int idx = u.mt * 256 + r0 + ai * 128 + m * 16; wrow[ai][m] = idx < cnt ? w_list[(size_t)u.e * T + idx] : 0.f; }
#pragma unroll
        for (int ai = 0; ai < 2; ++ai)
#pragma unroll
            for (int m = 0; m < 4; ++m) {
                bf16_t* hp = H + (size_t)(u.pm * 256 + r0 + ai * 128 + m * 16) * DEXP + u.pn * 128 + wc * 16 + 4 * fq;
#pragma unroll
                for (int bj = 0; bj < 2; ++bj) { const pg8::f32x4 g = acc[ai][bj][m][0], uu = acc[ai][bj][m][1]; float h[4];
#pragma unroll
                    for (int i = 0; i < 4; ++i) h[i] = g[i] * __builtin_amdgcn_rcpf(1.f + __expf(-g[i])) * uu[i] * wrow[ai][m];
                    pg8::u32x2 w; w.x = pg8::cvt_pk_bf16(h[0], h[1]); w.y = pg8::cvt_pk_bf16(h[2], h[3]);
                    *(pg8::u32x2*)(hp + bj * 64) = w; }
            }
    }
};
struct ProbDown {
    const bf16_t* A; const bf16_t* Bt; int K;
    __device__ __forceinline__ int a_row(const pg8::Unit& u, int r) const { return u.pm * 256 + r; }
    __device__ __forceinline__ const char* b_tile(const pg8::Unit& u) const { return (const char*)(Bt + ((size_t)u.e * DM + (size_t)u.pn * 256) * DEXP); }
};
struct EpiDown {
    static constexpr bool PERM = true;
    bf16_t* Y; const LAS int* tab; const int* slot_list;
    __device__ __forceinline__ void operator()(const pg8::f32x4 (&acc)[2][2][4][2], const pg8::Unit& u, int wr, int wc, int fr, int fq) const {
        const int r0 = wr * 64 + fr; const int cnt = tab[33 + u.e];
        int drow[2][4];
#pragma unroll
        for (int ai = 0; ai < 2; ++ai)
#pragma unroll
            for (int m = 0; m < 4; ++m) { const int idx = u.mt * 256 + r0 + ai * 128 + m * 16; drow[ai][m] = idx < cnt ? slot_list[(size_t)u.e * T + idx] : -1; }
#pragma unroll
        for (int ai = 0; ai < 2; ++ai)
#pragma unroll
            for (int m = 0; m < 4; ++m) if (drow[ai][m] >= 0) {
                bf16_t* yp = Y + (size_t)drow[ai][m] * DM + u.pn * 256 + wc * 32 + 8 * fq;
#pragma unroll
                for (int bj = 0; bj < 2; ++bj) { const pg8::f32x4 v0 = acc[ai][bj][m][0], v1 = acc[ai][bj][m][1];
                    pg8::u32x4 w; w.x = pg8::cvt_pk_bf16(v0[0], v0[1]); w.y = pg8::cvt_pk_bf16(v0[2], v0[3]); w.z = pg8::cvt_pk_bf16(v1[0], v1[1]); w.w = pg8::cvt_pk_bf16(v1[2], v1[3]);
                    *(pg8::u32x4*)(yp + bj * 128) = w; }
            }
    }
};
__device__ __forceinline__ void ph_moe_gu(const P& p, unsigned char* lds_g, int bid, int nb) {
    moe_tables(p, lds_g);
    const LAS int* tab = (const LAS int*)((LAS unsigned char*)lds_g + MOE_TAB_OFF);
    ProbGU G{(const bf16_t*)(p.ws + WS_X1B), (const bf16_t*)(p.ws + WS_WGU), DM, tab, (const int*)(p.ws + WS_SLOT)};
    MoeOrder S{tab, 2, nb, bid};
    EpiGU E{(bf16_t*)(p.ws + WS_H), tab, (const float*)(p.ws + WS_WLIST)};
    pg8::gemm_phase((PG8_LAS unsigned char*)lds_g, G, S, E);
}
__device__ __forceinline__ void ph_moe_down(const P& p, unsigned char* lds_g, int bid, int nb) {
    const LAS int* tab = (const LAS int*)((LAS unsigned char*)lds_g + MOE_TAB_OFF);
    ProbDown G{(const bf16_t*)(p.ws + WS_H), (const bf16_t*)(p.ws + WS_WD), DEXP};
    MoeOrder S{tab, 4, nb, bid};
    EpiDown E{(bf16_t*)(p.ws + WS_Y), tab, (const int*)(p.ws + WS_SLOT)};
    pg8::gemm_phase((PG8_LAS unsigned char*)lds_g, G, S, E);
}
__device__ __forceinline__ void ph_rowpass2(const P& p, int bid, int nb) {
    const int tid = threadIdx.x, lane = tid & 63, wv = tid >> 6;
    const bf16_t* x1b = (const bf16_t*)(p.ws + WS_X1B); const bf16_t* Y = (const bf16_t*)(p.ws + WS_Y);
    v4f lw[4], lb[4];
#pragma unroll
    for (int j = 0; j < 4; ++j) { lw[j] = *((const v4f*)p.ln2_w + lane + 64 * j); lb[j] = *((const v4f*)p.ln2_b + lane + 64 * j); }
    for (int row = bid * 8 + wv; row < T; row += nb * 8) {
        const unsigned long long* xr = (const unsigned long long*)(x1b + (size_t)row * DM) + lane;
        const unsigned long long* y0 = (const unsigned long long*)(Y + (size_t)row * 2 * DM) + lane;
        const unsigned long long* y1 = y0 + DM / 4;
        v4f v[4]; float s = 0.f;
#pragma unroll
        for (int j = 0; j < 4; ++j) { const unsigned long long a = xr[64 * j], b = y0[64 * j], c = y1[64 * j];
            v[j].x = ALPHA * __uint_as_float((unsigned)a << 16) + __uint_as_float((unsigned)b << 16) + __uint_as_float((unsigned)c << 16);
            v[j].y = ALPHA * __uint_as_float((unsigned)a & 0xffff0000u) + __uint_as_float((unsigned)b & 0xffff0000u) + __uint_as_float((unsigned)c & 0xffff0000u);
            v[j].z = ALPHA * __uint_as_float((unsigned)(a >> 32) << 16) + __uint_as_float((unsigned)(b >> 32) << 16) + __uint_as_float((unsigned)(c >> 32) << 16);
            v[j].w = ALPHA * __uint_as_float((unsigned)(a >> 32) & 0xffff0000u) + __uint_as_float((unsigned)(b >> 32) & 0xffff0000u) + __uint_as_float((unsigned)(c >> 32) & 0xffff0000u);
            s += (v[j].x + v[j].y) + (v[j].z + v[j].w); }
        const float mu = wave_sum(s) * (1.f / DM); float q = 0.f;
#pragma unroll
        for (int j = 0; j < 4; ++j) { v[j] = v[j] - mu; q += (v[j].x * v[j].x + v[j].y * v[j].y) + (v[j].z * v[j].z + v[j].w * v[j].w); }
        const float rs = 1.f / sqrtf(wave_sum(q) * (1.f / DM) + LN_EPS);
        v4f* o = (v4f*)(p.out + (size_t)row * DM) + lane;
#pragma unroll
        for (int j = 0; j < 4; ++j) o[64 * j] = v[j] * rs * lw[j] + lb[j];
    }
}

typedef float f32x16 __attribute__((ext_vector_type(16)));
typedef unsigned u32x2_t __attribute__((ext_vector_type(2)));
__device__ __forceinline__ void ph_swa(const P& p, unsigned char* lds_g, int bid, int nb) {
    int tid = threadIdx.x; asm volatile("" : "+v"(tid));
    const int lane = tid & 63, wv = __builtin_amdgcn_readfirstlane(tid >> 6);
    const int g = wv & 3, hf = wv >> 2, r32 = lane & 31, hi = lane >> 5;
    LAS unsigned char* Ks = (LAS unsigned char*)lds_g;
    LAS unsigned char* Vt = Ks + 256 * 144;
    const bf16_t* proj = (const bf16_t*)(p.ws + WS_PROJ); bf16_t* mix = (bf16_t*)(p.ws + WS_MIX);
    constexpr float LOG2E = 1.4426950408889634f, SC = 0.125f * LOG2E;
    for (int unit = bid; unit < BATCH * AKH * (SEQ / 128); unit += nb) {
        const int b = unit / (AKH * 64), rem = unit % (AKH * 64), kvh = rem / 64, blk = rem % 64, q0 = blk * 128;
#pragma unroll
        for (int i = 0; i < 4; ++i) {
            const int c = tid + 512 * i, wl = c >> 3, ch = c & 7, pos = q0 - 128 + wl;
            v4u kv = {0u, 0u, 0u, 0u}, vv = {0u, 0u, 0u, 0u};
            if (pos >= 0) { const bf16_t* rp = proj + (size_t)(b * SEQ + pos) * NV + kvh * 64 + ch * 8; kv = *(const v4u*)(rp + PC_AK); vv = *(const v4u*)(rp + PC_AV); }
            *(LAS v4u*)(Ks + wl * 144 + ch * 16) = kv;
#pragma unroll
            for (int j = 0; j < 8; ++j) *(LAS unsigned short*)(Vt + (ch * 8 + j) * 520 + wl * 2) = (unsigned short)(vv[j >> 1] >> (16 * (j & 1)));
        }
        __syncthreads();
        const int hq = kvh * 4 + g; const float sink2 = p.sinks[hq] * LOG2E;
#pragma unroll 1
        for (int i = 0; i < 2; ++i) {
            const size_t row = (size_t)(b * SEQ + q0 + 64 * hf + 32 * i + r32);
            pg8::bf16x8 qf[4];
#pragma unroll
            for (int ks = 0; ks < 4; ++ks) qf[ks] = *(const pg8::bf16x8*)(proj + row * NV + PC_AQ + hq * 64 + 16 * ks + 8 * hi);
            const int t0 = 2 * hf + i;
            f32x16 sacc[5];
#pragma unroll
            for (int kt = 0; kt < 5; ++kt) {
                f32x16 acc = {0.f, 0.f, 0.f, 0.f, 0.f, 0.f, 0.f, 0.f, 0.f, 0.f, 0.f, 0.f, 0.f, 0.f, 0.f, 0.f};
                const LAS unsigned char* kp = Ks + (32 * (t0 + kt) + r32) * 144 + 16 * hi;
#pragma unroll
                for (int ks = 0; ks < 4; ++ks) acc = __builtin_amdgcn_mfma_f32_32x32x16_bf16(*(const LAS pg8::bf16x8*)(kp + 32 * ks), qf[ks], acc, 0, 0, 0);
                sacc[kt] = acc;
            }
            float m2 = sink2;
#pragma unroll
            for (int kt = 0; kt < 5; ++kt) {
                const bool tvalid = (blk > 0) || (t0 + kt >= 4);
#pragma unroll
                for (int r = 0; r < 16; ++r) {
                    const int kc = (r & 3) + 8 * (r >> 2) + 4 * hi;
                    bool ok = tvalid;
                    if (kt == 0) ok = ok && (kc > r32);
                    if (kt == 4) ok = ok && (kc <= r32);
                    const float s = ok ? sacc[kt][r] * SC : -INFINITY;
                    sacc[kt][r] = s; m2 = fmaxf(m2, s);
                }
            }
            m2 = fmaxf(m2, __shfl_xor(m2, 32));
            float l = 0.f;
#pragma unroll
            for (int kt = 0; kt < 5; ++kt)
#pragma unroll
                for (int r = 0; r < 16; ++r) { const float e = __builtin_amdgcn_exp2f(sacc[kt][r] - m2); sacc[kt][r] = e; l += e; }
            l += __shfl_xor(l, 32); l += __builtin_amdgcn_exp2f(sink2 - m2);
            f32x16 o[2];
            o[0] = (f32x16){0.f, 0.f, 0.f, 0.f, 0.f, 0.f, 0.f, 0.f, 0.f, 0.f, 0.f, 0.f, 0.f, 0.f, 0.f, 0.f}; o[1] = o[0];
#pragma unroll
            for (int kt = 0; kt < 5; ++kt)
#pragma unroll
                for (int s2 = 0; s2 < 2; ++s2) {
                    v4u pw; pw.x = pg8::cvt_pk_bf16(sacc[kt][8 * s2 + 0], sacc[kt][8 * s2 + 1]); pw.y = pg8::cvt_pk_bf16(sacc[kt][8 * s2 + 2], sacc[kt][8 * s2 + 3]);
                    pw.z = pg8::cvt_pk_bf16(sacc[kt][8 * s2 + 4], sacc[kt][8 * s2 + 5]); pw.w = pg8::cvt_pk_bf16(sacc[kt][8 * s2 + 6], sacc[kt][8 * s2 + 7]);
                    const pg8::bf16x8 pf = __builtin_bit_cast(pg8::bf16x8, pw);
#pragma unroll
                    for (int dt = 0; dt < 2; ++dt) {
                        const LAS unsigned char* vp = Vt + (32 * dt + r32) * 520 + (32 * (t0 + kt) + 16 * s2 + 4 * hi) * 2;
                        const u32x2_t c1 = *(const LAS u32x2_t*)vp, c2 = *(const LAS u32x2_t*)(vp + 16);
                        v4u vw; vw.x = c1.x; vw.y = c1.y; vw.z = c2.x; vw.w = c2.y;
                        o[dt] = __builtin_amdgcn_mfma_f32_32x32x16_bf16(__builtin_bit_cast(pg8::bf16x8, vw), pf, o[dt], 0, 0, 0);
                    }
                }
            const float inv = 1.f / l;
            bf16_t* op = mix + row * DM + 512 + hq * 64 + 4 * hi;
#pragma unroll
            for (int dt = 0; dt < 2; ++dt)
#pragma unroll
                for (int r4 = 0; r4 < 4; ++r4) {
                    u32x2_t w; w.x = pg8::cvt_pk_bf16(o[dt][4 * r4] * inv, o[dt][4 * r4 + 1] * inv); w.y = pg8::cvt_pk_bf16(o[dt][4 * r4 + 2] * inv, o[dt][4 * r4 + 3] * inv);
                    *(u32x2_t*)(op + 32 * dt + 8 * r4) = w;
                }
        }
        __syncthreads();
    }
}

constexpr size_t WS_QKC = WS_X1B;
constexpr size_t WS_DC = WS_H;
constexpr size_t WS_DN = 336 * MiB, WS_NST = WS_DN + 512 * 1024, WS_SCAL = WS_NST + 512 * 1024;
constexpr int KT_STRIDE = 272;

__device__ __forceinline__ float scan_add64(float v, int lane) {
#pragma unroll
    for (int o = 1; o < 64; o <<= 1) { const float t = __shfl_up(v, o); v = (lane >= o) ? v + t : v; }
    return v;
}
__device__ __forceinline__ float scan_max64(float v, int lane) {
#pragma unroll
    for (int o = 1; o < 64; o <<= 1) { const float t = __shfl_up(v, o); v = (lane >= o) ? fmaxf(v, t) : v; }
    return v;
}
__device__ __forceinline__ void gate_scan(const float* gates, size_t row0, int h, int lane, float& b0, float& b1, float& a0, float& a1) {
    const float* g0 = gates + (row0 + 2 * lane) * 8; const float* g1 = g0 + 8;
    const float i0 = g0[h], i1 = g1[h], lf0 = logsigmoid_f(g0[4 + h]), lf1 = logsigmoid_f(g1[4 + h]);
    const float pair = lf0 + lf1, incl = scan_add64(pair, lane), excl = incl - pair;
    b0 = excl + lf0; b1 = incl; a0 = i0 - b0; a1 = i1 - b1;
}
template <int WHICH>
__device__ __forceinline__ void conv_stage(const P& p, const bf16_t* proj, bf16_t* qkc, LAS unsigned char* Kt, int b, int h, int chunk, int cc, int tg) {
    const int colb = WHICH * 512 + h * 128 + cc * 8;
    float w[4][8], bias[8];
#pragma unroll
    for (int j = 0; j < 4; ++j) { const v4f w0 = *(const v4f*)(p.conv_w + j * 1024 + colb), w1 = *(const v4f*)(p.conv_w + j * 1024 + colb + 4);
        w[j][0] = w0.x; w[j][1] = w0.y; w[j][2] = w0.z; w[j][3] = w0.w; w[j][4] = w1.x; w[j][5] = w1.y; w[j][6] = w1.z; w[j][7] = w1.w; }
    { const v4f b0 = *(const v4f*)(p.conv_b + colb), b1 = *(const v4f*)(p.conv_b + colb + 4);
      bias[0] = b0.x; bias[1] = b0.y; bias[2] = b0.z; bias[3] = b0.w; bias[4] = b1.x; bias[5] = b1.y; bias[6] = b1.z; bias[7] = b1.w; }
    v4u u[7];
#pragma unroll
    for (int rr = 0; rr < 7; ++rr) { const int t = chunk * 128 + 4 * tg - 3 + rr;
        u[rr] = (v4u){0u, 0u, 0u, 0u};
        if (t >= 0) u[rr] = *(const v4u*)(proj + (size_t)(b * SEQ + t) * NV + colb); }
#pragma unroll
    for (int tt = 0; tt < 4; ++tt) {
        float o[8];
#pragma unroll
        for (int c = 0; c < 8; ++c) o[c] = bias[c];
#pragma unroll
        for (int j = 0; j < 4; ++j)
#pragma unroll
            for (int c = 0; c < 8; ++c) { const unsigned wd = u[tt + j][c >> 1]; const float uv = __uint_as_float((c & 1) ? (wd & 0xffff0000u) : (wd << 16)); o[c] += w[j][c] * uv; }
#pragma unroll
        for (int c = 0; c < 8; ++c) { o[c] = silu_f(o[c]); if (WHICH) o[c] *= 0.08838834764831845f; }
        v4u pk; pk.x = pk2(o[0], o[1]); pk.y = pk2(o[2], o[3]); pk.z = pk2(o[4], o[5]); pk.w = pk2(o[6], o[7]);
        const int tok = 4 * tg + tt;
        *(v4u*)(qkc + (size_t)(b * SEQ + chunk * 128 + tok) * DM + colb) = pk;
        if (WHICH) {
#pragma unroll
            for (int c = 0; c < 8; ++c) *(LAS unsigned short*)(Kt + (cc * 8 + c) * KT_STRIDE + tok * 2) = (unsigned short)(pk[c >> 1] >> (16 * (c & 1)));
        }
    }
}

__device__ __forceinline__ void ph_mlstm_a1(const P& p, unsigned char* lds_g, int bid, int nb) {
    int tid = threadIdx.x; asm volatile("" : "+v"(tid));
    const int lane = tid & 63, wv = __builtin_amdgcn_readfirstlane(tid >> 6), r32 = lane & 31, hi = lane >> 5;
    LAS unsigned char* Kt = (LAS unsigned char*)lds_g;
    LAS unsigned char* Vt = Kt + 128 * KT_STRIDE;
    LAS float* wsh = (LAS float*)(Vt + 128 * KT_STRIDE);
    const bf16_t* proj = (const bf16_t*)(p.ws + WS_PROJ); const float* gates = (const float*)(p.ws + WS_GATES);
    bf16_t* qkc = (bf16_t*)(p.ws + WS_QKC); bf16_t* dC = (bf16_t*)(p.ws + WS_DC);
    float* dn = (float*)(p.ws + WS_DN); float* scal = (float*)(p.ws + WS_SCAL);
    for (int item = bid; item < BATCH * MLH * 64; item += nb) {
        const int bh = item >> 6, chunk = item & 63, b = bh >> 2, h = bh & 3; const size_t row0 = (size_t)b * SEQ + chunk * 128;
        if (wv == 0) {
            float b0, b1, a0, a1; gate_scan(gates, row0, h, lane, b0, b1, a0, a1);
            const float amax = wave_max(fmaxf(a0, a1)); const float blast = __shfl(b1, 63);
            wsh[2 * lane] = expf(a0 - amax); wsh[2 * lane + 1] = expf(a1 - amax);
            if (lane == 0) { scal[bh * 64 + chunk] = blast + amax; scal[1024 + bh * 64 + chunk] = blast; }
        }
        conv_stage<0>(p, proj, qkc, Kt, b, h, chunk, tid & 15, tid >> 4);
        conv_stage<1>(p, proj, qkc, Kt, b, h, chunk, tid & 15, tid >> 4);
        __syncthreads();
#pragma unroll
        for (int i = 0; i < 4; ++i) { const int idx = tid + 512 * i, s = idx >> 4, ec = idx & 15;
            const v4u vv = *(const v4u*)(proj + (row0 + s) * NV + PC_MV + h * 128 + ec * 8); const float ws = wsh[s];
#pragma unroll
            for (int j = 0; j < 8; ++j) { const unsigned wd = vv[j >> 1]; const float v = __uint_as_float((j & 1) ? (wd & 0xffff0000u) : (wd << 16)) * ws;
                *(LAS unsigned short*)(Vt + (ec * 8 + j) * KT_STRIDE + s * 2) = f2bf(v); } }
        __syncthreads();
        {
            const int et = wv >> 1;
            f32x16 acc[2];
            acc[0] = (f32x16){0.f, 0.f, 0.f, 0.f, 0.f, 0.f, 0.f, 0.f, 0.f, 0.f, 0.f, 0.f, 0.f, 0.f, 0.f, 0.f}; acc[1] = acc[0];
            const LAS unsigned char* ap = Vt + (32 * et + r32) * KT_STRIDE + 16 * hi;
#pragma unroll
            for (int ks = 0; ks < 8; ++ks) { const pg8::bf16x8 a = *(const LAS pg8::bf16x8*)(ap + 32 * ks);
#pragma unroll
                for (int j = 0; j < 2; ++j) { const int dt = 2 * (wv & 1) + j;
                    const pg8::bf16x8 bb = *(const LAS pg8::bf16x8*)(Kt + (32 * dt + r32) * KT_STRIDE + 16 * hi + 32 * ks);
                    acc[j] = __builtin_amdgcn_mfma_f32_32x32x16_bf16(a, bb, acc[j], 0, 0, 0); } }
            bf16_t* out = dC + ((size_t)item * 128) * 128;
#pragma unroll
            for (int j = 0; j < 2; ++j) { const int dt = 2 * (wv & 1) + j;
#pragma unroll
                for (int r = 0; r < 16; ++r) { const int e = 32 * et + (r & 3) + 8 * (r >> 2) + 4 * hi; out[(size_t)e * 128 + 32 * dt + r32] = f2bf(acc[j][r]); } }
        }
        if (tid < 128) {
            float a = 0.f; const LAS unsigned char* kp = Kt + tid * KT_STRIDE;
            for (int s8 = 0; s8 < 16; ++s8) { const v4u kk = *(const LAS v4u*)(kp + s8 * 16);
#pragma unroll
                for (int j = 0; j < 8; ++j) { const unsigned wd = kk[j >> 1]; a += __uint_as_float((j & 1) ? (wd & 0xffff0000u) : (wd << 16)) * wsh[s8 * 8 + j]; } }
            dn[(size_t)item * 128 + tid] = a;
        }
        __syncthreads();
    }
}

__device__ __forceinline__ void ph_mlstm_a2(const P& p, unsigned char* lds_g, int bid, int nb) {
    const int tid = threadIdx.x;
    LAS float* dec = (LAS float*)lds_g; LAS float* gg = dec + 64;
    const bf16_t* dC = (const bf16_t*)(p.ws + WS_DC); bf16_t* Cst = (bf16_t*)(p.ws + WS_CST);
    const float* dn = (const float*)(p.ws + WS_DN); float* nst = (float*)(p.ws + WS_NST); float* scal = (float*)(p.ws + WS_SCAL);
    for (int it = bid; it < 256; it += nb) {
        const int bh = it >> 4, part = it & 15;
        if (tid == 0) { float m = 0.f;
            for (int k = 0; k < 64; ++k) { const float al = scal[bh * 64 + k], bl = scal[1024 + bh * 64 + k]; const float mn = fmaxf(bl + m, al);
                dec[k] = expf(bl + m - mn); gg[k] = expf(al - mn); if (part == 0) scal[2048 + bh * 64 + k] = m; m = mn; } }
        __syncthreads();
        {
            const size_t eoff = (size_t)part * 1024 + 2 * tid;
            const unsigned* src = (const unsigned*)(dC + (size_t)bh * 64 * 16384 + eoff); unsigned* dst = (unsigned*)(Cst + (size_t)bh * 64 * 16384 + eoff);
            float c0 = 0.f, c1 = 0.f;
#pragma unroll 8
            for (int k = 0; k < 64; ++k) { const unsigned d = src[(size_t)k * 8192];
                dst[(size_t)k * 8192] = pk2(c0, c1);
                c0 = dec[k] * c0 + gg[k] * __uint_as_float(d << 16); c1 = dec[k] * c1 + gg[k] * __uint_as_float(d & 0xffff0000u); }
        }
        if (part == 0 && tid < 128) { float n = 0.f;
            for (int k = 0; k < 64; ++k) { nst[((size_t)bh * 64 + k) * 128 + tid] = n; n = dec[k] * n + gg[k] * dn[((size_t)bh * 64 + k) * 128 + tid]; } }
        __syncthreads();
    }
}

__device__ __forceinline__ void ph_mlstm_b(const P& p, unsigned char* lds_g, int bid, int nb) {
    int tid = threadIdx.x; asm volatile("" : "+v"(tid));
    const int lane = tid & 63, wv = __builtin_amdgcn_readfirstlane(tid >> 6), r32 = lane & 31, hi = lane >> 5;
    LAS unsigned char* Ks = (LAS unsigned char*)lds_g;
    LAS unsigned char* Vt = Ks + 128 * KT_STRIDE;
    LAS float* a2s = (LAS float*)(Vt + 128 * KT_STRIDE);
    LAS float* M2s = a2s + 128;
    LAS float* wis = M2s + 128;
    LAS float* ems = wis + 128;
    LAS float* red = ems + 128;
    const bf16_t* proj = (const bf16_t*)(p.ws + WS_PROJ); const float* gates = (const float*)(p.ws + WS_GATES);
    const bf16_t* qkc = (const bf16_t*)(p.ws + WS_QKC); const bf16_t* Cst = (const bf16_t*)(p.ws + WS_CST);
    const float* nst = (const float*)(p.ws + WS_NST); const float* scal = (const float*)(p.ws + WS_SCAL);
    bf16_t* mix = (bf16_t*)(p.ws + WS_MIX);
    constexpr float LOG2E = 1.4426950408889634f;
    const int lt = wv >> 1, eh = wv & 1;
    for (int item = bid; item < BATCH * MLH * 64; item += nb) {
        const int bh = item >> 6, chunk = item & 63, b = bh >> 2, h = bh & 3; const size_t row0 = (size_t)b * SEQ + chunk * 128;
        const float mk = scal[2048 + bh * 64 + chunk];
        if (wv == 0) {
            float b0, b1, a0, a1; gate_scan(gates, row0, h, lane, b0, b1, a0, a1);
            const float incl = scan_max64(fmaxf(a0, a1), lane); float excl = __shfl_up(incl, 1); if (lane == 0) excl = -INFINITY;
            const float M0 = fmaxf(mk, fmaxf(excl, a0)), M1 = fmaxf(mk, incl);
            a2s[2 * lane] = a0 * LOG2E; a2s[2 * lane + 1] = a1 * LOG2E; M2s[2 * lane] = M0 * LOG2E; M2s[2 * lane + 1] = M1 * LOG2E;
            wis[2 * lane] = expf(mk - M0); wis[2 * lane + 1] = expf(mk - M1); ems[2 * lane] = expf(-b0 - M0); ems[2 * lane + 1] = expf(-b1 - M1);
        }
#pragma unroll
        for (int i = 0; i < 4; ++i) { const int idx = tid + 512 * i, s = idx >> 4, ch = idx & 15;
            *(LAS v4u*)(Ks + s * KT_STRIDE + ch * 16) = *(const v4u*)(qkc + (row0 + s) * DM + 512 + h * 128 + ch * 8);
            const v4u vv = *(const v4u*)(proj + (row0 + s) * NV + PC_MV + h * 128 + ch * 8);
#pragma unroll
            for (int j = 0; j < 8; ++j) *(LAS unsigned short*)(Vt + (ch * 8 + j) * KT_STRIDE + s * 2) = (unsigned short)(vv[j >> 1] >> (16 * (j & 1))); }
        __syncthreads();
        const int l = 32 * lt + r32; const size_t row = row0 + l;
        pg8::bf16x8 qf[8];
#pragma unroll
        for (int ks = 0; ks < 8; ++ks) qf[ks] = *(const pg8::bf16x8*)(qkc + row * DM + h * 128 + 16 * ks + 8 * hi);
        const float M2 = M2s[l], wint = wis[l], emr = ems[l];
        f32x16 acc[2];
        acc[0] = (f32x16){0.f, 0.f, 0.f, 0.f, 0.f, 0.f, 0.f, 0.f, 0.f, 0.f, 0.f, 0.f, 0.f, 0.f, 0.f, 0.f}; acc[1] = acc[0];
        float dq = 0.f;
        {
            const bf16_t* Cb = Cst + (size_t)item * 16384; const float* nb_ = nst + (size_t)item * 128;
#pragma unroll
            for (int ks = 0; ks < 8; ++ks) {
#pragma unroll
                for (int j = 0; j < 2; ++j) { const int e = 32 * (2 * eh + j) + r32;
                    const pg8::bf16x8 cf = *(const pg8::bf16x8*)(Cb + (size_t)e * 128 + 16 * ks + 8 * hi);
                    acc[j] = __builtin_amdgcn_mfma_f32_32x32x16_bf16(cf, qf[ks], acc[j], 0, 0, 0); }
                const v4f n0 = *(const v4f*)(nb_ + 16 * ks + 8 * hi), n1 = *(const v4f*)(nb_ + 16 * ks + 8 * hi + 4);
                const v4u qw = __builtin_bit_cast(v4u, qf[ks]);
                dq += n0.x * __uint_as_float(qw.x << 16) + n0.y * __uint_as_float(qw.x & 0xffff0000u) + n0.z * __uint_as_float(qw.y << 16) + n0.w * __uint_as_float(qw.y & 0xffff0000u)
                    + n1.x * __uint_as_float(qw.z << 16) + n1.y * __uint_as_float(qw.z & 0xffff0000u) + n1.z * __uint_as_float(qw.w << 16) + n1.w * __uint_as_float(qw.w & 0xffff0000u);
            }
            dq += __shfl_xor(dq, 32);
#pragma unroll
            for (int j = 0; j < 2; ++j)
#pragma unroll
                for (int r = 0; r < 16; ++r) acc[j][r] *= wint;
        }
        float ssum = 0.f;
#pragma unroll 1
        for (int st = 0; st <= lt; ++st) {
            f32x16 sa = {0.f, 0.f, 0.f, 0.f, 0.f, 0.f, 0.f, 0.f, 0.f, 0.f, 0.f, 0.f, 0.f, 0.f, 0.f, 0.f};
            const LAS unsigned char* kp = Ks + (32 * st + r32) * KT_STRIDE + 16 * hi;
#pragma unroll
            for (int ks = 0; ks < 8; ++ks) sa = __builtin_amdgcn_mfma_f32_32x32x16_bf16(*(const LAS pg8::bf16x8*)(kp + 32 * ks), qf[ks], sa, 0, 0, 0);
#pragma unroll
            for (int r4 = 0; r4 < 4; ++r4) { const v4f av = *(const LAS v4f*)(a2s + 32 * st + 8 * r4 + 4 * hi);
#pragma unroll
                for (int q = 0; q < 4; ++q) { const int s = 32 * st + 8 * r4 + 4 * hi + q;
                    const float wgt = (s <= l) ? __builtin_amdgcn_exp2f(av[q] - M2) : 0.f; const float sw = sa[4 * r4 + q] * wgt; sa[4 * r4 + q] = sw; ssum += sw; } }
#pragma unroll
            for (int s2 = 0; s2 < 2; ++s2) {
                v4u pw; pw.x = pg8::cvt_pk_bf16(sa[8 * s2 + 0], sa[8 * s2 + 1]); pw.y = pg8::cvt_pk_bf16(sa[8 * s2 + 2], sa[8 * s2 + 3]);
                pw.z = pg8::cvt_pk_bf16(sa[8 * s2 + 4], sa[8 * s2 + 5]); pw.w = pg8::cvt_pk_bf16(sa[8 * s2 + 6], sa[8 * s2 + 7]);
                const pg8::bf16x8 pf = __builtin_bit_cast(pg8::bf16x8, pw);
#pragma unroll
                for (int j = 0; j < 2; ++j) {
                    const LAS unsigned char* vp = Vt + (32 * (2 * eh + j) + r32) * KT_STRIDE + (32 * st + 16 * s2 + 4 * hi) * 2;
                    const u32x2_t c1 = *(const LAS u32x2_t*)vp, c2 = *(const LAS u32x2_t*)(vp + 16);
                    v4u vw; vw.x = c1.x; vw.y = c1.y; vw.z = c2.x; vw.w = c2.y;
                    acc[j] = __builtin_amdgcn_mfma_f32_32x32x16_bf16(__builtin_bit_cast(pg8::bf16x8, vw), pf, acc[j], 0, 0, 0);
                }
            }
        }
        ssum += __shfl_xor(ssum, 32);
        const float den = wint * dq + ssum; const float inv = 1.f / fmaxf(fabsf(den), emr);
        float s1 = 0.f, s2q = 0.f;
#pragma unroll
        for (int j = 0; j < 2; ++j)
#pragma unroll
            for (int r = 0; r < 16; ++r) { const float hv = acc[j][r] * inv; acc[j][r] = hv; s1 += hv; s2q += hv * hv; }
        s1 += __shfl_xor(s1, 32); s2q += __shfl_xor(s2q, 32);
        if (hi == 0) { red[((lt * 2 + eh) * 32 + r32) * 2] = s1; red[((lt * 2 + eh) * 32 + r32) * 2 + 1] = s2q; }
        __syncthreads();
        {
            const float t1 = red[((lt * 2) * 32 + r32) * 2] + red[((lt * 2 + 1) * 32 + r32) * 2], t2 = red[((lt * 2) * 32 + r32) * 2 + 1] + red[((lt * 2 + 1) * 32 + r32) * 2 + 1];
            const float mu = t1 * (1.f / 128.f); const float var = fmaxf(t2 * (1.f / 128.f) - mu * mu, 0.f); const float rs = 1.f / sqrtf(var + LN_EPS);
#pragma unroll
            for (int j = 0; j < 2; ++j)
#pragma unroll
                for (int r4 = 0; r4 < 4; ++r4) { const int e0 = 32 * (2 * eh + j) + 8 * r4 + 4 * hi;
                    const u32x2_t ow = *(const u32x2_t*)(proj + row * NV + PC_MO + h * 128 + e0); const v4f nw = *(const v4f*)(p.norm_w + h * 128 + e0);
                    const float o0 = __uint_as_float(ow.x << 16), o1 = __uint_as_float(ow.x & 0xffff0000u), o2 = __uint_as_float(ow.y << 16), o3 = __uint_as_float(ow.y & 0xffff0000u);
                    const float y0 = sigmoid_f(o0) * (acc[j][4 * r4] - mu) * rs * nw.x, y1 = sigmoid_f(o1) * (acc[j][4 * r4 + 1] - mu) * rs * nw.y;
                    const float y2 = sigmoid_f(o2) * (acc[j][4 * r4 + 2] - mu) * rs * nw.z, y3 = sigmoid_f(o3) * (acc[j][4 * r4 + 3] - mu) * rs * nw.w;
                    u32x2_t w; w.x = pg8::cvt_pk_bf16(y0, y1); w.y = pg8::cvt_pk_bf16(y2, y3);
                    *(u32x2_t*)(mix + row * DM + h * 128 + e0) = w; }
        }
        __syncthreads();
    }
}
extern __shared__ __attribute__((aligned(16))) unsigned char g_lds[];
constexpr int LDS_BYTES = 147456;
__global__ void __launch_bounds__(512, 2) mega_fwd(P p) {
    cg::grid_group grid = cg::this_grid();
    const int bid = blockIdx.x, nb = gridDim.x;
    ph_prologue(p, g_lds, bid, nb);
    grid.sync();
    ph_inproj(p, g_lds, bid, nb);
    grid.sync();
    ph_swa(p, g_lds, bid, nb);
    __syncthreads();
    ph_mlstm_a1(p, g_lds, bid, nb);
    grid.sync();
    ph_mlstm_a2(p, g_lds, bid, nb);
    grid.sync();
    ph_mlstm_b(p, g_lds, bid, nb);
    grid.sync();
    ph_outproj(p, g_lds, bid, nb);
    grid.sync();
    ph_rowpass1(p, g_lds, bid, nb);
    grid.sync();
    ph_moe_gu(p, g_lds, bid, nb);
    grid.sync();
    ph_moe_down(p, g_lds, bid, nb);
    grid.sync();
    ph_rowpass2(p, bid, nb);
}

extern "C" void kernel_launch(void* const* d_in, const int* in_sizes, int n_in, void* d_out, int out_size, void* d_ws, size_t ws_size, hipStream_t stream) {
    if (n_in != 19 || in_sizes[0] != T * DM || out_size != T * DM || ws_size < WS_END) {
        fprintf(stderr, "kernel_launch: unexpected shapes (n_in %d in0 %d out %d ws %zu)\n", n_in, n_in > 0 ? in_sizes[0] : -1, out_size, ws_size); return; }
    static int grid_blocks = 0;
    if (!grid_blocks) {
        int dev = 0, cus = 0, per_cu = 0;
        (void)hipGetDevice(&dev);
        (void)hipDeviceGetAttribute(&cus, hipDeviceAttributeMultiprocessorCount, dev);
        (void)hipFuncSetAttribute((const void*)mega_fwd, hipFuncAttributeMaxDynamicSharedMemorySize, LDS_BYTES);
        (void)hipOccupancyMaxActiveBlocksPerMultiprocessor(&per_cu, (const void*)mega_fwd, 512, LDS_BYTES);
        if (per_cu < 1) { fprintf(stderr, "kernel_launch: occupancy query says %d blocks per CU\n", per_cu); per_cu = 1; }
        if (per_cu > 1) per_cu = 1;
        grid_blocks = cus * per_cu;
        (void)hipGetLastError();
    }
    P p{};
    const float** f = (const float**)&p;
    for (int i = 0; i < 19; ++i) f[i] = (const float*)d_in[i];
    p.out = (float*)d_out; p.ws = (unsigned char*)d_ws;
    void* args[] = {&p};
    hipError_t e = hipLaunchCooperativeKernel((const void*)mega_fwd, dim3(grid_blocks), dim3(512), args, LDS_BYTES, stream);
    if (e != hipSuccess) fprintf(stderr, "cooperative launch failed: %s (grid %d)\n", hipGetErrorString(e), grid_blocks);
}
```

```cpp
#include <hip/hip_runtime.h>
#include <hip/hip_cooperative_groups.h>
namespace cg = cooperative_groups;
#include <cstdio>
#include <cstdint>

typedef unsigned short bf16_t;

constexpr int BATCH = 4, SEQ = 8192, T = BATCH * SEQ, DM = 1024;
constexpr int MLH = 4, MLD = 128, MLW = 512;
constexpr int AQH = 8, AKH = 2, AHD = 64;
constexpr int DIN = 2824;
constexpr int NV = 2816;
constexpr int NGRP = 4, EPG = 8, NEXP = 32, DEXP = 256;
constexpr float LN_EPS = 1e-5f;
constexpr float ALPHA = 1.189207115002721f;
constexpr int PC_MQ = 0, PC_MK = 512, PC_MV = 1024, PC_MO = 1536, PC_AQ = 2048, PC_AK = 2560, PC_AV = 2688;

constexpr size_t MiB = 1u << 20;
constexpr size_t WS_CTL = 0, WS_TAB = 1 * MiB, WS_GATES = 3 * MiB, WS_RT = 4 * MiB, WS_MISC = 5 * MiB;
constexpr size_t WS_WIN = 8 * MiB, WS_WOUT = 14 * MiB, WS_WGU = 16 * MiB, WS_WD = 48 * MiB;
constexpr size_t WS_PROJ = 64 * MiB, WS_X1F = 64 * MiB, WS_Y = 192 * MiB;
constexpr size_t WS_MIX = 240 * MiB, WS_CST = 304 * MiB, WS_H = 340 * MiB, WS_X1B = 376 * MiB, WS_SLOT = 440 * MiB, WS_WLIST = 444 * MiB, WS_END = 448 * MiB;
constexpr size_t WS_WR = WS_MISC;

struct P {
    const float *x, *w_in, *conv_w, *conv_b, *gate_bias, *norm_w, *sinks, *w_out, *ln1_w, *ln1_b;
    const float *w_gr, *b_gr, *w_er, *b_er, *w_eg, *w_eu, *w_ed, *ln2_w, *ln2_b;
    float* out; unsigned char* ws;
};

__device__ __forceinline__ float bf2f(bf16_t v) { return __uint_as_float((unsigned)v << 16); }
__device__ __forceinline__ bf16_t f2bf(float f) { unsigned u = __float_as_uint(f); return (bf16_t)((u + 0x7fffu + ((u >> 16) & 1u)) >> 16); }
__device__ __forceinline__ float wave_sum(float v) {
#pragma unroll
    for (int o = 1; o < 64; o <<= 1) v += __shfl_xor(v, o);
    return v;
}
__device__ __forceinline__ float wave_max(float v) {
#pragma unroll
    for (int o = 1; o < 64; o <<= 1) v = fmaxf(v, __shfl_xor(v, o));
    return v;
}
__device__ __forceinline__ float silu_f(float v) { return v / (1.f + expf(-v)); }
__device__ __forceinline__ float sigmoid_f(float v) { return 1.f / (1.f + expf(-v)); }
__device__ __forceinline__ float logsigmoid_f(float v) { return fminf(v, 0.f) - log1pf(expf(-fabsf(v))); }
__device__ __forceinline__ int rope_pos(int d) { return d < 32 ? 8 * (d >> 2) + (d & 3) : 8 * ((d - 32) >> 2) + 4 + (d & 3); }
__device__ __forceinline__ int vcol_to_orig(int v) { return v < 2048 ? v : (v < NV ? v + 8 : v - NV + 2048); }

__device__ void ph_tab(const P& p, int bid, int nb) {
    float2* tab = (float2*)(p.ws + WS_TAB);
    for (int i = bid * 512 + threadIdx.x; i < SEQ * 32; i += nb * 512) {
        const int pos = i >> 5, f = i & 31;
        const double ang = (double)pos * pow(10000.0, -(double)f / 32.0);
        tab[i] = make_float2((float)cos(ang), (float)sin(ang));
    }
}

template <class AF, class BF>
__device__ __forceinline__ void naive_tile(AF af, BF bfn, int row0, int col0, int K, float* As, float* Bs, float* Ct) {
    const int tid = threadIdx.x, ty = tid >> 4, tx = tid & 15;
    float acc[4][4];
#pragma unroll
    for (int i = 0; i < 4; ++i)
#pragma unroll
        for (int j = 0; j < 4; ++j) acc[i][j] = 0.f;
    for (int k0 = 0; k0 < K; k0 += 16) {
#pragma unroll
        for (int i = 0; i < 4; ++i) { const int e = tid + 512 * i, r = e >> 4, kk = e & 15; As[kk * 132 + r] = af(row0 + r, k0 + kk); }
#pragma unroll
        for (int i = 0; i < 2; ++i) { const int e = tid + 512 * i, kk = e >> 6, c = e & 63; Bs[kk * 64 + c] = bfn(k0 + kk, col0 + c); }
        __syncthreads();
#pragma unroll
        for (int kk = 0; kk < 16; ++kk) {
            float a[4], b[4];
#pragma unroll
            for (int i = 0; i < 4; ++i) { a[i] = As[kk * 132 + 4 * ty + i]; b[i] = Bs[kk * 64 + 4 * tx + i]; }
#pragma unroll
            for (int i = 0; i < 4; ++i)
#pragma unroll
                for (int j = 0; j < 4; ++j) acc[i][j] += a[i] * b[j];
        }
        __syncthreads();
    }
#pragma unroll
    for (int i = 0; i < 4; ++i)
#pragma unroll
        for (int j = 0; j < 4; ++j) Ct[(4 * ty + i) * 65 + 4 * tx + j] = acc[i][j];
    __syncthreads();
}

__device__ void ph_inproj_naive(const P& p, unsigned char* lds, int bid, int nb) {
    float* As = (float*)lds; float* Bs = As + 16 * 132; float* Ct = Bs + 16 * 64;
    bf16_t* proj = (bf16_t*)(p.ws + WS_PROJ);
    float* gates = (float*)(p.ws + WS_GATES);
    const float2* tab = (const float2*)(p.ws + WS_TAB);
    const float* x = p.x; const float* w = p.w_in;
    constexpr int NCT = (DIN + 63) / 64;
    const int ntiles = (T / 128) * NCT;
    const int tid = threadIdx.x;
    for (int it = bid; it < ntiles; it += nb) {
        const int rt = it / NCT, ct = it % NCT, row0 = rt * 128, col0 = ct * 64;
        naive_tile([&](int r, int k) { return x[(size_t)r * DM + k]; },
                   [&](int k, int vc) { return vc < DIN ? w[(size_t)k * DIN + vcol_to_orig(vc)] : 0.f; },
                   row0, col0, DM, As, Bs, Ct);
        if (col0 >= NV) {
            for (int e = tid; e < 128 * 8; e += 512) { const int r = e >> 3, c = e & 7; gates[(size_t)(row0 + r) * 8 + c] = Ct[r * 65 + c] + p.gate_bias[c]; }
        } else if (col0 >= PC_AQ && col0 < PC_AV) {
            for (int e = tid; e < 128 * 32; e += 512) {
                const int r = e >> 5, d = e & 31; const int pos = (row0 + r) & (SEQ - 1);
                const float2 cs = tab[pos * 32 + d]; const float x1 = Ct[r * 65 + d], x2 = Ct[r * 65 + d + 32];
                bf16_t* o = proj + (size_t)(row0 + r) * NV + col0;
                o[rope_pos(d)] = f2bf(x1 * cs.x - x2 * cs.y); o[rope_pos(d + 32)] = f2bf(x1 * cs.y + x2 * cs.x);
            }
        } else {
            for (int e = tid; e < 128 * 64; e += 512) { const int r = e >> 6, c = e & 63; proj[(size_t)(row0 + r) * NV + col0 + c] = f2bf(Ct[r * 65 + c]); }
        }
        __syncthreads();
    }
}

__device__ void ph_mlstm_naive(const P& p, unsigned char* lds, int bid, int nb) {
    constexpr int TB = 16;
    float* qs = (float*)lds;
    float* ks = qs + TB * 128;
    float* vs = ks + TB * 128;
    float* hs = vs + TB * 128;
    float* gi = hs + TB * 128;
    float* gl = gi + TB;
    const bf16_t* proj = (const bf16_t*)(p.ws + WS_PROJ);
    const float* gates = (const float*)(p.ws + WS_GATES);
    bf16_t* mix = (bf16_t*)(p.ws + WS_MIX);
    const int tid = threadIdx.x, lane = tid & 63, wv = tid >> 6;
    const int e = tid >> 2, dq = tid & 3;
    for (int it = bid; it < BATCH * MLH; it += nb) {
        const int b = it / MLH, h = it % MLH;
        float C[32], n[32];
#pragma unroll
        for (int j = 0; j < 32; ++j) { C[j] = 0.f; n[j] = 0.f; }
        float m = 0.f;
        for (int t0 = 0; t0 < SEQ; t0 += TB) {
            for (int idx = tid; idx < TB * 256; idx += 512) {
                const int tok = idx >> 8, c = idx & 255; const int t = t0 + tok;
                const int ch = (c < 128) ? (h * 128 + c) : (512 + h * 128 + (c - 128));
                float a = p.conv_b[ch];
#pragma unroll
                for (int j = 0; j < 4; ++j) { const int tt = t - 3 + j; if (tt >= 0) a += p.conv_w[j * 1024 + ch] * bf2f(proj[(size_t)(b * SEQ + tt) * NV + ch]); }
                a = silu_f(a);
                if (c < 128) qs[tok * 128 + c] = a; else ks[tok * 128 + (c - 128)] = a * 0.08838834764831845f;
            }
            for (int idx = tid; idx < TB * 128; idx += 512) { const int tok = idx >> 7, c = idx & 127; vs[idx] = bf2f(proj[(size_t)(b * SEQ + t0 + tok) * NV + PC_MV + h * 128 + c]); }
            if (tid < TB) { const float* g = gates + (size_t)(b * SEQ + t0 + tid) * 8; gi[tid] = g[h]; gl[tid] = logsigmoid_f(g[4 + h]); }
            __syncthreads();
            for (int tok = 0; tok < TB; ++tok) {
                const float iv = gi[tok], lf = gl[tok];
                const float mn = fmaxf(lf + m, iv), fd = expf(lf + m - mn), iw = expf(iv - mn);
                const float ve = vs[tok * 128 + e] * iw;
                float nump = 0.f, denp = 0.f;
#pragma unroll
                for (int j = 0; j < 32; ++j) {
                    const float kk = ks[tok * 128 + dq * 32 + j], qq = qs[tok * 128 + dq * 32 + j];
                    C[j] = fd * C[j] + ve * kk; n[j] = fd * n[j] + iw * kk;
                    nump += C[j] * qq; denp += n[j] * qq;
                }
                nump += __shfl_xor(nump, 1); nump += __shfl_xor(nump, 2);
                denp += __shfl_xor(denp, 1); denp += __shfl_xor(denp, 2);
                if (dq == 0) hs[tok * 128 + e] = nump / fmaxf(fabsf(denp), expf(-mn));
                m = mn;
            }
            __syncthreads();
            for (int tk = wv * 2; tk < wv * 2 + 2; ++tk) {
                const float h0 = hs[tk * 128 + lane], h1 = hs[tk * 128 + 64 + lane];
                const float mu = wave_sum(h0 + h1) * (1.f / 128.f);
                const float d0 = h0 - mu, d1 = h1 - mu;
                const float var = wave_sum(d0 * d0 + d1 * d1) * (1.f / 128.f);
                const float rs = 1.f / sqrtf(var + LN_EPS);
                const size_t row = (size_t)(b * SEQ + t0 + tk);
                const float o0 = bf2f(proj[row * NV + PC_MO + h * 128 + lane]), o1 = bf2f(proj[row * NV + PC_MO + h * 128 + 64 + lane]);
                mix[row * DM + h * 128 + lane] = f2bf(sigmoid_f(o0) * d0 * rs * p.norm_w[h * 128 + lane]);
                mix[row * DM + h * 128 + 64 + lane] = f2bf(sigmoid_f(o1) * d1 * rs * p.norm_w[h * 128 + 64 + lane]);
            }
            __syncthreads();
        }
    }
}

__device__ void ph_swa_naive(const P& p, unsigned char* lds, int bid, int nb) {
    const int tid = threadIdx.x, lane = tid & 63, wv = tid >> 6;
    float* qsh = (float*)lds + wv * 192;
    float* psh = qsh + 64;
    const bf16_t* proj = (const bf16_t*)(p.ws + WS_PROJ);
    bf16_t* mix = (bf16_t*)(p.ws + WS_MIX);
    const long nitems = (long)T * AQH;
    for (long it = (long)bid * 8 + wv; it < nitems; it += (long)nb * 8) {
        const int hq = (int)(it & 7); const int row = (int)(it >> 3); const int s = row & (SEQ - 1); const int kvh = hq >> 2;
        qsh[lane] = bf2f(proj[(size_t)row * NV + PC_AQ + hq * 64 + lane]);
        __builtin_amdgcn_wave_barrier();
        float sc[2]; bool val[2];
#pragma unroll
        for (int u = 0; u < 2; ++u) {
            const int kidx = lane + 64 * u; const int kpos = s - 127 + kidx; val[u] = kpos >= 0;
            float a = 0.f;
            if (val[u]) { const bf16_t* kr = proj + (size_t)(row - 127 + kidx) * NV + PC_AK + kvh * 64;
                for (int d = 0; d < 64; ++d) a += qsh[d] * bf2f(kr[d]); }
            sc[u] = val[u] ? a * 0.125f : -INFINITY;
        }
        const float sink = p.sinks[hq];
        const float mx = fmaxf(wave_max(fmaxf(sc[0], sc[1])), sink);
        const float p0 = val[0] ? expf(sc[0] - mx) : 0.f, p1 = val[1] ? expf(sc[1] - mx) : 0.f;
        const float den = wave_sum(p0 + p1) + expf(sink - mx);
        psh[lane] = p0; psh[lane + 64] = p1;
        __builtin_amdgcn_wave_barrier();
        float o = 0.f;
        for (int kidx = 0; kidx < 128; ++kidx) { const int kpos = s - 127 + kidx; if (kpos >= 0) o += psh[kidx] * bf2f(proj[(size_t)(row - 127 + kidx) * NV + PC_AV + kvh * 64 + lane]); }
        mix[(size_t)row * DM + 512 + hq * 64 + lane] = f2bf(o / den);
        __builtin_amdgcn_wave_barrier();
    }
}

__device__ void ph_outproj_naive(const P& p, unsigned char* lds, int bid, int nb) {
    float* As = (float*)lds; float* Bs = As + 16 * 132; float* Ct = Bs + 16 * 64;
    const bf16_t* mix = (const bf16_t*)(p.ws + WS_MIX);
    float* y = (float*)(p.ws + WS_X1F);
    const float* w = p.w_out;
    const int ntiles = (T / 128) * (DM / 64);
    const int tid = threadIdx.x;
    for (int it = bid; it < ntiles; it += nb) {
        const int rt = it / (DM / 64), ct = it % (DM / 64), row0 = rt * 128, col0 = ct * 64;
        naive_tile([&](int r, int k) { return bf2f(mix[(size_t)r * DM + k]); },
                   [&](int k, int c) { return w[(size_t)k * DM + c]; }, row0, col0, DM, As, Bs, Ct);
        for (int e = tid; e < 128 * 64; e += 512) { const int r = e >> 6, c = e & 63; y[(size_t)(row0 + r) * DM + col0 + c] = Ct[r * 65 + c]; }
        __syncthreads();
    }
}

__device__ void ph_ln1_naive(const P& p, int bid, int nb) {
    const int tid = threadIdx.x, lane = tid & 63, wv = tid >> 6;
    float* x1 = (float*)(p.ws + WS_X1F); bf16_t* x1b = (bf16_t*)(p.ws + WS_X1B);
    for (int row = bid * 8 + wv; row < T; row += nb * 8) {
        float v[16]; float s = 0.f;
#pragma unroll
        for (int i = 0; i < 16; ++i) { const int c = i * 64 + lane; v[i] = ALPHA * p.x[(size_t)row * DM + c] + x1[(size_t)row * DM + c]; s += v[i]; }
        const float mu = wave_sum(s) * (1.f / DM); float q = 0.f;
#pragma unroll
        for (int i = 0; i < 16; ++i) { v[i] -= mu; q += v[i] * v[i]; }
        const float rs = 1.f / sqrtf(wave_sum(q) * (1.f / DM) + LN_EPS);
#pragma unroll
        for (int i = 0; i < 16; ++i) { const int c = i * 64 + lane; const float o = v[i] * rs * p.ln1_w[c] + p.ln1_b[c]; x1[(size_t)row * DM + c] = o; x1b[(size_t)row * DM + c] = f2bf(o); }
    }
}

__device__ void ph_route_naive(const P& p, int bid, int nb) {
    const int tid = threadIdx.x, lane = tid & 63, wv = tid >> 6;
    const float* x1 = (const float*)(p.ws + WS_X1F);
    int* rt_e = (int*)(p.ws + WS_RT); float* rt_w = (float*)(p.ws + WS_RT + 512 * 1024);
    for (int row = bid * 8 + wv; row < T; row += nb * 8) {
        float lg[36];
#pragma unroll
        for (int j = 0; j < 36; ++j) lg[j] = 0.f;
        for (int i = 0; i < 16; ++i) {
            const int d = i * 64 + lane; const float xv = x1[(size_t)row * DM + d];
#pragma unroll
            for (int j = 0; j < 4; ++j) lg[j] += xv * p.w_gr[d * 4 + j];
#pragma unroll
            for (int j = 0; j < 32; ++j) lg[4 + j] += xv * p.w_er[d * 32 + j];
        }
#pragma unroll
        for (int j = 0; j < 36; ++j) lg[j] = wave_sum(lg[j]);
        if (lane == 0) {
            float g[4]; int gi = 0;
#pragma unroll
            for (int j = 0; j < 4; ++j) g[j] = lg[j] + p.b_gr[j];
            float gm = g[0];
#pragma unroll
            for (int j = 1; j < 4; ++j) if (g[j] > gm) { gm = g[j]; gi = j; }
            float gs = 0.f;
#pragma unroll
            for (int j = 0; j < 4; ++j) gs += expf(g[j] - gm);
            const float gp = 1.f / gs;
            float ev[8];
#pragma unroll
            for (int j = 0; j < 8; ++j) { float a = 0.f;
#pragma unroll
                for (int q = 0; q < 4; ++q) a = (q == gi) ? (lg[4 + q * 8 + j] + p.b_er[q * 8 + j]) : a;
                ev[j] = a; }
            int i0 = 0; float v0 = ev[0];
#pragma unroll
            for (int j = 1; j < 8; ++j) if (ev[j] > v0) { v0 = ev[j]; i0 = j; }
            int i1 = -1; float v1 = -INFINITY;
#pragma unroll
            for (int j = 0; j < 8; ++j) if (j != i0 && ev[j] > v1) { v1 = ev[j]; i1 = j; }
            const float e1 = expf(v1 - v0); const float w0 = gp / (1.f + e1), w1 = gp * e1 / (1.f + e1);
            rt_e[row * 2] = gi * 8 + i0; rt_e[row * 2 + 1] = gi * 8 + i1; rt_w[row * 2] = w0; rt_w[row * 2 + 1] = w1;
        }
    }
}

__device__ void ph_moe_naive(const P& p, unsigned char* lds, int bid, int nb) {
    float* xs = (float*)lds;
    float* gu = xs + 1024;
    float* hs = gu + 512;
    float* red = hs + 512;
    const int tid = threadIdx.x, lane = tid & 63, wv = tid >> 6;
    const float* x1 = (const float*)(p.ws + WS_X1F); const bf16_t* x1b = (const bf16_t*)(p.ws + WS_X1B);
    const int* rt_e = (const int*)(p.ws + WS_RT); const float* rt_w = (const float*)(p.ws + WS_RT + 512 * 1024);
    for (int row = bid; row < T; row += nb) {
        xs[tid] = bf2f(x1b[(size_t)row * DM + tid]); xs[tid + 512] = bf2f(x1b[(size_t)row * DM + tid + 512]);
        __syncthreads();
        for (int k = 0; k < 2; ++k) {
            const int e = rt_e[row * 2 + k]; const float wk = rt_w[row * 2 + k];
            const float* W = (tid < 256 ? p.w_eg : p.w_eu) + (size_t)e * DM * DEXP + (tid & 255);
            float a = 0.f;
            for (int d = 0; d < DM; ++d) a += xs[d] * W[(size_t)d * DEXP];
            gu[tid] = a;
            __syncthreads();
            if (tid < 256) hs[k * 256 + tid] = silu_f(gu[tid]) * gu[256 + tid] * wk;
            __syncthreads();
        }
        float acc[2] = {0.f, 0.f};
        for (int k = 0; k < 2; ++k) {
            const int e = rt_e[row * 2 + k]; const float* W = p.w_ed + (size_t)e * DEXP * DM;
            for (int j = 0; j < DEXP; ++j) { const float hv = hs[k * 256 + j]; acc[0] += hv * W[(size_t)j * DM + tid]; acc[1] += hv * W[(size_t)j * DM + tid + 512]; }
        }
        float v0 = ALPHA * x1[(size_t)row * DM + tid] + acc[0], v1 = ALPHA * x1[(size_t)row * DM + tid + 512] + acc[1];
        float s = wave_sum(v0 + v1); if (lane == 0) red[wv] = s; __syncthreads();
        float mu = 0.f;
#pragma unroll
        for (int i = 0; i < 8; ++i) mu += red[i];
        mu *= (1.f / DM); v0 -= mu; v1 -= mu;
        float q = wave_sum(v0 * v0 + v1 * v1); if (lane == 0) red[8 + wv] = q; __syncthreads();
        float var = 0.f;
#pragma unroll
        for (int i = 0; i < 8; ++i) var += red[8 + i];
        const float rs = 1.f / sqrtf(var * (1.f / DM) + LN_EPS);
        p.out[(size_t)row * DM + tid] = v0 * rs * p.ln2_w[tid] + p.ln2_b[tid];
        p.out[(size_t)row * DM + tid + 512] = v1 * rs * p.ln2_w[tid + 512] + p.ln2_b[tid + 512];
        __syncthreads();
    }
}

namespace pg8 {
#define PG8_LAS __attribute__((address_space(3)))
typedef short bf16x8 __attribute__((ext_vector_type(8)));
typedef float f32x4 __attribute__((ext_vector_type(4)));
typedef unsigned u32x4 __attribute__((ext_vector_type(4)));
typedef unsigned u32x2 __attribute__((ext_vector_type(2)));
constexpr int BM = 256, BK = 64, HALF = 128, HTB = HALF * BK * 2, STAGE_BYTES = 8 * HTB, NXCD = 8, WGM = 8;

__host__ __device__ __forceinline__ int lds_byte(int r, int c) { const int st = (r >> 4) * 2 + (c >> 5), rr = r & 15, cc = c & 31, ob = rr * 64 + cc * 2; return st * 1024 + (ob ^ (((ob >> 9) & 1) << 5)); }
__host__ __device__ __forceinline__ void stage_rc(int b, int& R, int& C) { const int st = b / 1024, sb = b % 1024, swz = sb ^ (((sb >> 9) & 1) << 5); R = (st >> 1) * 16 + swz / 64; C = (st & 1) * 32 + (swz % 64) / 2; }
__host__ __device__ __forceinline__ int perm32(int rho) { const int n = rho >> 4, i = rho & 15; return 8 * (i >> 2) + 4 * n + (i & 3); }

struct Unit { int pm, pn, e, mt; };

__device__ __forceinline__ unsigned cvt_pk_bf16(float lo, float hi) { unsigned r; asm volatile("v_cvt_pk_bf16_f32 %0, %1, %2" : "=v"(r) : "v"(lo), "v"(hi)); return r; }

struct StaticOrder {
    int nM, nN, nwg, G, c;
    __device__ void init(int M, int N, int G_, int c_) { nM = M / BM; nN = N / BM; nwg = nM * nN; G = G_; c = c_; }
    __device__ bool next(int i, Unit& u) const {
        const long L = (long)i * G + c; if (L >= nwg) return false;
        int wgid = (int)L; { const int q = nwg / NXCD, r = nwg % NXCD, xcd = wgid % NXCD, off = wgid / NXCD; wgid = (xcd < r ? xcd * (q + 1) : r * (q + 1) + (xcd - r) * q) + off; }
        const int nig = WGM * nN, gid = wgid / nig, fm = gid * WGM, gsz = (nM - fm) < WGM ? (nM - fm) : WGM;
        u.pm = fm + ((wgid % nig) % gsz); u.pn = (wgid % nig) / gsz; u.e = 0; u.mt = 0; return true;
    }
};

template <class Epi, class Prob, class Sched>
__device__ __forceinline__ void gemm_phase(PG8_LAS unsigned char* lds, const Prob& G, const Sched& S, const Epi& E) {
    int tid = threadIdx.x; asm volatile("" : "+v"(tid));
    const int wid = __builtin_amdgcn_readfirstlane(tid >> 6), lane = tid & 63, wr = wid >> 2, wc = wid & 3, fr = lane & 15, fq = lane >> 4;
    const int K = G.K, nt = K / BK;
    unsigned voffB[2];
    { int Rr0, Cc0, Rr1, Cc1; stage_rc(tid * 16, Rr0, Cc0); stage_rc(tid * 16 + 8192, Rr1, Cc1);
      const int Rb0 = Epi::PERM ? ((Rr0 & ~31) + perm32(Rr0 & 31)) : Rr0, Rb1 = Epi::PERM ? ((Rr1 & ~31) + perm32(Rr1 & 31)) : Rr1;
      voffB[0] = (unsigned)(Rb0 * K + Cc0) * 2u; voffB[1] = (unsigned)(Rb1 * K + Cc1) * 2u; }
    const size_t kstep = (size_t)(BK * 2);
    const size_t hstep = (size_t)HALF * K * 2;
    const unsigned ldsw = (unsigned)wid * 1024u;
    const int aoff = lds_byte(wr * 64 + fr, fq * 8), boff = lds_byte(wc * 32 + fr, fq * 8);
    const char* const Abase = (const char*)G.A;
#define PG8_SA(b, h) (((b) * 2 + (h)) * HTB)
#define PG8_SB(b, h) ((4 + (b) * 2 + (h)) * HTB)
#define PG8_GLDS(gp, ldsoff) __builtin_amdgcn_global_load_lds((const unsigned*)(gp), (PG8_LAS unsigned*)(lds + (ldsoff)), 16, 0, 0)
#define PG8_STAGE_B(bufoff, gbase) do { PG8_GLDS((const char*)(gbase) + voffB[0], (bufoff) + ldsw); PG8_GLDS((const char*)(gbase) + voffB[1], (bufoff) + ldsw + 8192); } while (0)
#define PG8_STAGE_A(bufoff, kb, o0, o1) do { PG8_GLDS(Abase + (kb) + (o0), (bufoff) + ldsw); PG8_GLDS(Abase + (kb) + (o1), (bufoff) + ldsw + 8192); } while (0)
#define PG8_AOFFS(u, o00, o01, o10, o11) do { int t2_ = tid; asm volatile("" : "+v"(t2_)); int Rr0, Cc0, Rr1, Cc1; stage_rc(t2_ * 16, Rr0, Cc0); stage_rc(t2_ * 16 + 8192, Rr1, Cc1); \
        o00 = (unsigned)(((size_t)G.a_row(u, Rr0) * K + Cc0) * 2u); o01 = (unsigned)(((size_t)G.a_row(u, Rr1) * K + Cc1) * 2u); \
        o10 = (unsigned)(((size_t)G.a_row(u, 128 + Rr0) * K + Cc0) * 2u); o11 = (unsigned)(((size_t)G.a_row(u, 128 + Rr1) * K + Cc1) * 2u); } while (0)
#define PG8_LDA(dst, b, h) do { _Pragma("unroll") for (int m = 0; m < 4; ++m) _Pragma("unroll") for (int k = 0; k < 2; ++k) dst[m][k] = *(const PG8_LAS bf16x8*)(lds + PG8_SA(b, h) + aoff + m * 2048 + k * 1024); } while (0)
#define PG8_LDB(dst, b, h) do { _Pragma("unroll") for (int n = 0; n < 2; ++n) _Pragma("unroll") for (int k = 0; k < 2; ++k) dst[n][k] = *(const PG8_LAS bf16x8*)(lds + PG8_SB(b, h) + boff + n * 2048 + k * 1024); } while (0)
#define PG8_MMA(ai, bj, At, Bt) do { __builtin_amdgcn_s_setprio(1); _Pragma("unroll") for (int m = 0; m < 4; ++m) _Pragma("unroll") for (int n = 0; n < 2; ++n) _Pragma("unroll") for (int k = 0; k < 2; ++k) \
        acc[ai][bj][m][n] = __builtin_amdgcn_mfma_f32_16x16x32_bf16(Bt[n][k], At[m][k], acc[ai][bj][m][n], 0, 0, 0); __builtin_amdgcn_s_setprio(0); } while (0)
#define PG8_WAIT_V(n) asm volatile("s_waitcnt vmcnt(" #n ")" ::: "memory")
#define PG8_WAIT_L(n) asm volatile("s_waitcnt lgkmcnt(" #n ")" ::: "memory")
#define PG8_BAR __builtin_amdgcn_s_barrier()
#define PG8_SCHED __builtin_amdgcn_sched_barrier(0)
    Unit cur, nxt; int ui = 0;
    if (!S.next(0, cur)) return;
    f32x4 acc[2][2][4][2];
#pragma unroll
    for (int a = 0; a < 2; ++a)
#pragma unroll
        for (int b = 0; b < 2; ++b)
#pragma unroll
            for (int m = 0; m < 4; ++m)
#pragma unroll
                for (int n = 0; n < 2; ++n) acc[a][b][m][n] = (f32x4){0.f, 0.f, 0.f, 0.f};
    bf16x8 At[4][2], B0[2][2], B1[2][2];
    unsigned c00, c01, c10, c11;
    PG8_AOFFS(cur, c00, c01, c10, c11);
    const char* cB = G.b_tile(cur);
    PG8_STAGE_B(PG8_SB(0, 0), cB); PG8_STAGE_B(PG8_SB(0, 1), cB + hstep); PG8_STAGE_A(PG8_SA(0, 0), 0, c00, c01); PG8_STAGE_A(PG8_SA(0, 1), 0, c10, c11);
    if (wr == 1) PG8_BAR;
    PG8_WAIT_V(2); PG8_BAR;
    PG8_STAGE_B(PG8_SB(1, 0), cB + kstep); PG8_STAGE_A(PG8_SA(1, 0), kstep, c00, c01); PG8_STAGE_B(PG8_SB(1, 1), cB + hstep + kstep);
    PG8_WAIT_V(6); PG8_BAR;
    for (;;) {
        const bool has_next = S.next(ui + 1, nxt);
        const char* nB = has_next ? G.b_tile(nxt) : cB;
        for (int t = 0; t < nt; t += 2) {
            const bool last = (t == nt - 2);
            const size_t ka1 = (size_t)(t + 1) * kstep;
            const size_t ka2 = last ? 0 : (size_t)(t + 2) * kstep, ka3 = ka2 + kstep;
            const char* b2 = last ? nB : cB + (size_t)(t + 2) * kstep; const char* b3 = b2 + kstep;
            PG8_LDB(B0, 0, 0); PG8_LDB(B1, 0, 1); PG8_SCHED; PG8_LDA(At, 0, 0); PG8_STAGE_A(PG8_SA(1, 1), ka1, c10, c11);
            if (last && has_next) { PG8_AOFFS(nxt, c00, c01, c10, c11); }
            PG8_WAIT_V(8); PG8_WAIT_L(0); PG8_BAR; PG8_MMA(0, 0, At, B0); PG8_MMA(0, 1, At, B1); PG8_BAR; PG8_SCHED;
            PG8_LDA(At, 0, 1); PG8_STAGE_B(PG8_SB(0, 0), b2); PG8_STAGE_B(PG8_SB(0, 1), b2 + hstep); PG8_STAGE_A(PG8_SA(0, 0), ka2, c00, c01);
            PG8_WAIT_V(8); PG8_WAIT_L(0); PG8_BAR; PG8_MMA(1, 0, At, B0); PG8_MMA(1, 1, At, B1); PG8_BAR; PG8_SCHED;
            PG8_LDB(B0, 1, 0); PG8_LDB(B1, 1, 1); PG8_SCHED; PG8_LDA(At, 1, 0); PG8_STAGE_A(PG8_SA(0, 1), ka2, c10, c11);
            PG8_WAIT_V(8); PG8_WAIT_L(0); PG8_BAR; PG8_MMA(0, 0, At, B0); PG8_MMA(0, 1, At, B1); PG8_BAR; PG8_SCHED;
            PG8_LDA(At, 1, 1); PG8_STAGE_B(PG8_SB(1, 0), b3); PG8_STAGE_B(PG8_SB(1, 1), b3 + hstep); PG8_STAGE_A(PG8_SA(1, 0), ka3, c00, c01);
            PG8_WAIT_V(8); PG8_WAIT_L(0); PG8_BAR; PG8_MMA(1, 0, At, B0); PG8_MMA(1, 1, At, B1); PG8_BAR; PG8_SCHED;
        }
        if (wr == 0) PG8_BAR;
        E(acc, cur, wr, wc, fr, fq);
        if (!has_next) break;
#pragma unroll
        for (int a = 0; a < 2; ++a)
#pragma unroll
            for (int b = 0; b < 2; ++b)
#pragma unroll
                for (int m = 0; m < 4; ++m)
#pragma unroll
                    for (int n = 0; n < 2; ++n) acc[a][b][m][n] = (f32x4){0.f, 0.f, 0.f, 0.f};
        cur = nxt; cB = nB; ++ui;
        if (wr == 1) PG8_BAR;
    }
    PG8_WAIT_V(0);
    PG8_BAR;
#undef PG8_SA
#undef PG8_SB
#undef PG8_GLDS
#undef PG8_STAGE_A
#undef PG8_STAGE_B
#undef PG8_AOFFS
#undef PG8_LDA
#undef PG8_LDB
#undef PG8_MMA
#undef PG8_WAIT_V
#undef PG8_WAIT_L
#undef PG8_BAR
#undef PG8_SCHED
}
}
#define LAS __attribute__((address_space(3)))
typedef unsigned v4u __attribute__((ext_vector_type(4)));
typedef float v4f __attribute__((ext_vector_type(4)));
#define LDS_WAIT() asm volatile("s_waitcnt lgkmcnt(0)" ::: "memory")
__device__ __forceinline__ unsigned pk2(float lo, float hi) { return (unsigned)f2bf(lo) | ((unsigned)f2bf(hi) << 16); }

constexpr int CW_GCNT = 64;

template <class SrcCol, class DstRow>
__device__ __forceinline__ void transpose_item(const float* W, int ldw, int K, bf16_t* WT, int k0, int n0, SrcCol sc, DstRow dr, LAS float* scr, int lane) {
    const int scol = sc(n0 + (lane & 31));
#pragma unroll 8
    for (int i = 0; i < 32; ++i) { const int kk = 2 * i + (lane >> 5); scr[kk * 33 + (lane & 31)] = W[(size_t)(k0 + kk) * ldw + scol]; }
    LDS_WAIT(); asm volatile("" ::: "memory");
    const int c = lane & 7;
#pragma unroll
    for (int j = 0; j < 4; ++j) { const int n = (lane >> 3) + 8 * j; const LAS float* s = scr + (8 * c) * 33 + n;
        v4u o; o.x = pk2(s[0 * 33], s[1 * 33]); o.y = pk2(s[2 * 33], s[3 * 33]); o.z = pk2(s[4 * 33], s[5 * 33]); o.w = pk2(s[6 * 33], s[7 * 33]);
        *(v4u*)(WT + (size_t)dr(n0 + n) * K + k0 + 8 * c) = o; }
    LDS_WAIT(); asm volatile("" ::: "memory");
}

__device__ __forceinline__ void ph_prologue(const P& p, unsigned char* lds_g, int bid, int nb) {
    int tid = threadIdx.x; asm volatile("" : "+v"(tid));
    const int lane = tid & 63, wv = __builtin_amdgcn_readfirstlane(tid >> 6);
    LAS unsigned char* lds = (LAS unsigned char*)lds_g;
    ph_tab(p, bid, nb);
    {
        bf16_t* Wr = (bf16_t*)(p.ws + WS_WR);
        for (int i = bid * 512 + tid; i < 48 * DM; i += nb * 512) { const int j = i >> 10, d = i & 1023;
            const float w = j < 4 ? p.w_gr[d * 4 + j] : (j < 36 ? p.w_er[d * 32 + (j - 4)] : 0.f); Wr[i] = f2bf(w); }
    }
    LAS float* wg = (LAS float*)(lds + 8 * 8448);
    for (int i = tid; i < 8 * 1024; i += 512) { const int d = i >> 3, c = i & 7; wg[c * 1024 + d] = p.w_in[(size_t)d * DIN + 2048 + c]; }
    __syncthreads();
    {
        bf16_t* xb = (bf16_t*)(p.ws + WS_MIX); float* gates = (float*)(p.ws + WS_GATES);
        for (int row = bid * 8 + wv; row < T; row += nb * 8) {
            const v4f* xr = (const v4f*)(p.x + (size_t)row * DM) + lane;
            v4f v[4];
#pragma unroll
            for (int j = 0; j < 4; ++j) v[j] = xr[64 * j];
            unsigned long long* o8 = (unsigned long long*)(xb + (size_t)row * DM) + lane;
#pragma unroll
            for (int j = 0; j < 4; ++j) o8[64 * j] = (unsigned long long)pk2(v[j].x, v[j].y) | ((unsigned long long)pk2(v[j].z, v[j].w) << 32);
            float g[8];
#pragma unroll
            for (int c = 0; c < 8; ++c) { float a = 0.f;
#pragma unroll
                for (int j = 0; j < 4; ++j) { const v4f w = *(const LAS v4f*)(wg + c * 1024 + 256 * j + 4 * lane); a += v[j].x * w.x + v[j].y * w.y + v[j].z * w.z + v[j].w * w.w; }
                g[c] = wave_sum(a); }
            float gv = g[0];
#pragma unroll
            for (int c = 1; c < 8; ++c) gv = (lane == c) ? g[c] : gv;
            if (lane < 8) gates[(size_t)row * 8 + lane] = gv + p.gate_bias[lane];
        }
    }
    {
        LAS float* scr = (LAS float*)(lds + wv * 8448);
        const int gw = bid * 8 + wv, NGW = nb * 8;
        bf16_t* Win = (bf16_t*)(p.ws + WS_WIN); bf16_t* Wout = (bf16_t*)(p.ws + WS_WOUT); bf16_t* Wgu = (bf16_t*)(p.ws + WS_WGU); bf16_t* Wd = (bf16_t*)(p.ws + WS_WD);
        constexpr int I_IN = 16 * (NV / 32), I_OUT = 16 * 32, I_G = NEXP * 16 * 8, I_D = NEXP * 4 * 32;
        constexpr int NITEMS = I_IN + I_OUT + 2 * I_G + I_D;
        for (int it = gw; it < NITEMS; it += NGW) {
            int r = it;
            if (r < I_IN) { const int kb = r / (NV / 32), nbk = r % (NV / 32);
                transpose_item(p.w_in, DIN, DM, Win, kb * 64, nbk * 32, [](int v) { return vcol_to_orig(v); },
                               [](int v) { return (v >= PC_AQ && v < PC_AV) ? ((v & ~63) + rope_pos(v & 63)) : v; }, scr, lane); continue; }
            r -= I_IN;
            if (r < I_OUT) { const int kb = r / 32, nbk = r % 32;
                transpose_item(p.w_out, DM, DM, Wout, kb * 64, nbk * 32, [](int v) { return v; }, [](int v) { return v; }, scr, lane); continue; }
            r -= I_OUT;
            if (r < 2 * I_G) { const int up = r >= I_G; if (up) r -= I_G; const int e = r / 128, q = r % 128, kb = q / 8, nbk = q % 8;
                transpose_item((up ? p.w_eu : p.w_eg) + (size_t)e * DM * DEXP, DEXP, DM, Wgu + (size_t)e * 512 * DM, kb * 64, nbk * 32, [](int v) { return v; },
                               [up](int j) { return 8 * (j >> 2) + 4 * up + (j & 3); }, scr, lane); continue; }
            r -= 2 * I_G;
            { const int e = r / 128, q = r % 128, kb = q / 32, nbk = q % 32;
                transpose_item(p.w_ed + (size_t)e * DEXP * DM, DM, DEXP, Wd + (size_t)e * DM * DEXP, kb * 64, nbk * 32, [](int v) { return v; }, [](int v) { return v; }, scr, lane); }
        }
    }
}

struct ProbPlain {
    const bf16_t* A; const bf16_t* Bt; int K;
    __device__ __forceinline__ int a_row(const pg8::Unit& u, int r) const { return u.pm * 256 + r; }
    __device__ __forceinline__ const char* b_tile(const pg8::Unit& u) const { return (const char*)(Bt + (size_t)u.pn * 256 * K); }
};
struct EpiInProj {
    static constexpr bool PERM = true;
    bf16_t* proj; const float* tab;
    __device__ __forceinline__ void operator()(const pg8::f32x4 (&acc)[2][2][4][2], const pg8::Unit& u, int wr, int wc, int fr, int fq) const {
        const int row0 = u.pm * 256 + wr * 64 + fr, colt = u.pn * 256 + wc * 32 + 8 * fq;
        const int g = 4 * (wc & 1) + fq;
#pragma unroll
        for (int ai = 0; ai < 2; ++ai)
#pragma unroll
            for (int m = 0; m < 4; ++m) {
                const int row = row0 + ai * 128 + m * 16; const int pos = row & (SEQ - 1);
                bf16_t* rowp = proj + (size_t)row * NV + colt;
#pragma unroll
                for (int bj = 0; bj < 2; ++bj) {
                    pg8::f32x4 v0 = acc[ai][bj][m][0], v1 = acc[ai][bj][m][1];
                    const bool rope = (u.pn == 8) || (u.pn == 9) || (u.pn == 10 && bj == 0);
                    if (rope) {
                        const v4f t0 = *(const v4f*)(tab + (size_t)(pos * 32 + 4 * g) * 2), t1 = *(const v4f*)(tab + (size_t)(pos * 32 + 4 * g) * 2 + 4);
                        const pg8::f32x4 a = v0, b = v1;
                        v0[0] = a[0] * t0.x - b[0] * t0.y; v1[0] = a[0] * t0.y + b[0] * t0.x;
                        v0[1] = a[1] * t0.z - b[1] * t0.w; v1[1] = a[1] * t0.w + b[1] * t0.z;
                        v0[2] = a[2] * t1.x - b[2] * t1.y; v1[2] = a[2] * t1.y + b[2] * t1.x;
                        v0[3] = a[3] * t1.z - b[3] * t1.w; v1[3] = a[3] * t1.w + b[3] * t1.z;
                    }
                    pg8::u32x4 w; w.x = pg8::cvt_pk_bf16(v0[0], v0[1]); w.y = pg8::cvt_pk_bf16(v0[2], v0[3]); w.z = pg8::cvt_pk_bf16(v1[0], v1[1]); w.w = pg8::cvt_pk_bf16(v1[2], v1[3]);
                    *(pg8::u32x4*)(rowp + bj * 128) = w;
                }
                asm volatile("" ::: "memory");
            }
    }
};
__device__ __forceinline__ void ph_inproj(const P& p, unsigned char* lds_g, int bid, int nb) {
    ProbPlain G{(const bf16_t*)(p.ws + WS_MIX), (const bf16_t*)(p.ws + WS_WIN), DM};
    pg8::StaticOrder S; S.init(T, NV, nb, bid);
    EpiInProj E{(bf16_t*)(p.ws + WS_PROJ), (const float*)(p.ws + WS_TAB)};
    pg8::gemm_phase(( PG8_LAS unsigned char*)lds_g, G, S, E);
}

struct EpiOutProj {
    static constexpr bool PERM = false;
    const float* x; float* V;
    __device__ __forceinline__ void operator()(const pg8::f32x4 (&acc)[2][2][4][2], const pg8::Unit& u, int wr, int wc, int fr, int fq) const {
        const int row0 = u.pm * 256 + wr * 64 + fr, col0 = u.pn * 256 + wc * 32 + 4 * fq;
#pragma unroll
        for (int ai = 0; ai < 2; ++ai)
#pragma unroll
            for (int m = 0; m < 4; ++m) {
                const size_t off = (size_t)(row0 + ai * 128 + m * 16) * DM + col0;
#pragma unroll
                for (int bj = 0; bj < 2; ++bj)
#pragma unroll
                    for (int n = 0; n < 2; ++n) { const pg8::f32x4 xv = *(const pg8::f32x4*)(x + off + bj * 128 + n * 16); *(pg8::f32x4*)(V + off + bj * 128 + n * 16) = xv * ALPHA + acc[ai][bj][m][n]; }
                if (m & 1) asm volatile("" ::: "memory");
            }
    }
};
__device__ __forceinline__ void ph_outproj(const P& p, unsigned char* lds_g, int bid, int nb) {
    ProbPlain G{(const bf16_t*)(p.ws + WS_MIX), (const bf16_t*)(p.ws + WS_WOUT), DM};
    pg8::StaticOrder S; S.init(T, DM, nb, bid);
    EpiOutProj E{p.x, (float*)(p.ws + WS_X1F)};
    pg8::gemm_phase((PG8_LAS unsigned char*)lds_g, G, S, E);
}

__device__ __forceinline__ void ph_rowpass1(const P& p, unsigned char* lds_g, int bid, int nb) {
    int tid = threadIdx.x; asm volatile("" : "+v"(tid));
    const int lane = tid & 63, wv = __builtin_amdgcn_readfirstlane(tid >> 6);
    LAS unsigned char* lds = (LAS unsigned char*)lds_g;
    constexpr int XT_STRIDE = 2064;
    LAS unsigned char* xt = lds;
    LAS float* lg = (LAS float*)(lds + 32 * XT_STRIDE);
    LAS int* lcnt = (LAS int*)(lds + 32 * XT_STRIDE + 6144);
    LAS int* lbase = lcnt + 32;
    LAS int* recn = lbase + 32;
    LAS int* rec_e = recn + 32;
    LAS int* rec_li = rec_e + 256;
    LAS int* rec_v = rec_li + 256;
    LAS float* rec_w = (LAS float*)(rec_v + 256);
    const float* V = (const float*)(p.ws + WS_X1F); bf16_t* x1b = (bf16_t*)(p.ws + WS_X1B);
    const bf16_t* Wr = (const bf16_t*)(p.ws + WS_WR);
    unsigned* gcnt = (unsigned*)(p.ws + WS_CTL) + CW_GCNT;
    int* slot_list = (int*)(p.ws + WS_SLOT); float* w_list = (float*)(p.ws + WS_WLIST);
    if (tid < 32) { lcnt[tid] = 0; if (tid == 0) recn[0] = 0; }
    v4f lw[4], lb[4];
#pragma unroll
    for (int j = 0; j < 4; ++j) { lw[j] = *((const v4f*)p.ln1_w + lane + 64 * j); lb[j] = *((const v4f*)p.ln1_b + lane + 64 * j); }
    __syncthreads();
    for (int tile = bid; tile < T / 32; tile += nb) {
        const int row0 = tile * 32;
#pragma unroll 1
        for (int rr = 0; rr < 4; ++rr) {
            const int lr = wv * 4 + rr; const size_t row = (size_t)(row0 + lr);
            const v4f* vr = (const v4f*)(V + row * DM) + lane;
            v4f v[4]; float s = 0.f;
#pragma unroll
            for (int j = 0; j < 4; ++j) { v[j] = vr[64 * j]; s += (v[j].x + v[j].y) + (v[j].z + v[j].w); }
            const float mu = wave_sum(s) * (1.f / DM); float q = 0.f;
#pragma unroll
            for (int j = 0; j < 4; ++j) { v[j] = v[j] - mu; q += (v[j].x * v[j].x + v[j].y * v[j].y) + (v[j].z * v[j].z + v[j].w * v[j].w); }
            const float rs = 1.f / sqrtf(wave_sum(q) * (1.f / DM) + LN_EPS);
            unsigned long long* o8 = (unsigned long long*)(x1b + row * DM) + lane;
#pragma unroll
            for (int j = 0; j < 4; ++j) { const v4f o = v[j] * rs * lw[j] + lb[j];
                const unsigned long long pk = (unsigned long long)pk2(o.x, o.y) | ((unsigned long long)pk2(o.z, o.w) << 32);
                o8[64 * j] = pk; *(LAS unsigned long long*)(xt + lr * XT_STRIDE + (256 * j + 4 * lane) * 2) = pk; }
        }
        __syncthreads();
        if (wv < 6) {
            const int mt = wv / 3, ntl = wv % 3;
            pg8::f32x4 acc = {0.f, 0.f, 0.f, 0.f};
            const LAS unsigned char* ap = xt + (mt * 16 + (lane & 15)) * XT_STRIDE + (lane >> 4) * 16;
            const bf16_t* bp = Wr + (size_t)(ntl * 16 + (lane & 15)) * DM + (lane >> 4) * 8;
#pragma unroll 8
            for (int ks = 0; ks < 32; ++ks) {
                const pg8::bf16x8 a = *(const LAS pg8::bf16x8*)(ap + ks * 64);
                const pg8::bf16x8 b = *(const pg8::bf16x8*)(bp + ks * 32);
                acc = __builtin_amdgcn_mfma_f32_16x16x32_bf16(a, b, acc, 0, 0, 0);
            }
#pragma unroll
            for (int j = 0; j < 4; ++j) lg[(mt * 16 + 4 * (lane >> 4) + j) * 48 + ntl * 16 + (lane & 15)] = acc[j];
        }
        __syncthreads();
        if (tid < 32) {
            const LAS float* l = lg + tid * 48; const int row = row0 + tid;
            float g[4]; int gi = 0;
#pragma unroll
            for (int j = 0; j < 4; ++j) g[j] = l[j] + p.b_gr[j];
            float gm = g[0];
#pragma unroll
            for (int j = 1; j < 4; ++j) if (g[j] > gm) { gm = g[j]; gi = j; }
            float gs = 0.f;
#pragma unroll
            for (int j = 0; j < 4; ++j) gs += expf(g[j] - gm);
            const float gp = 1.f / gs;
            float ev[8];
#pragma unroll
            for (int j = 0; j < 8; ++j) ev[j] = l[4 + gi * 8 + j] + p.b_er[gi * 8 + j];
            int i0 = 0; float v0 = ev[0];
#pragma unroll
            for (int j = 1; j < 8; ++j) if (ev[j] > v0) { v0 = ev[j]; i0 = j; }
            int i1 = -1; float v1 = -INFINITY;
#pragma unroll
            for (int j = 0; j < 8; ++j) if (j != i0 && ev[j] > v1) { v1 = ev[j]; i1 = j; }
            const float e1 = expf(v1 - v0); const float w0 = gp / (1.f + e1), w1 = gp * e1 / (1.f + e1);
            const int e_0 = gi * 8 + i0, e_1 = gi * 8 + i1;
            const int li0 = atomicAdd((int*)(lcnt + e_0), 1), li1 = atomicAdd((int*)(lcnt + e_1), 1);
            const int ri = atomicAdd((int*)recn, 2);
            rec_e[ri] = e_0; rec_li[ri] = li0; rec_v[ri] = row * 2; rec_w[ri] = w0;
            rec_e[ri + 1] = e_1; rec_li[ri + 1] = li1; rec_v[ri + 1] = row * 2 + 1; rec_w[ri + 1] = w1;
        }
        __syncthreads();
    }
    if (tid < 32) lbase[tid] = (int)atomicAdd(gcnt + tid, (unsigned)lcnt[tid]);
    __syncthreads();
    const int nrec = recn[0];
    for (int i = tid; i < nrec; i += 512) { const int e = rec_e[i]; const int pos = lbase[e] + rec_li[i]; slot_list[(size_t)e * T + pos] = rec_v[i]; w_list[(size_t)e * T + pos] = rec_w[i]; }
    __syncthreads();
}

constexpr int MOE_TAB_OFF = 131072;
__device__ __forceinline__ void moe_tables(const P& p, unsigned char* lds_g) {
    LAS int* tab = (LAS int*)((LAS unsigned char*)lds_g + MOE_TAB_OFF);
    const unsigned* gcnt = (const unsigned*)(p.ws + WS_CTL) + CW_GCNT;
    if (threadIdx.x == 0) { int acc = 0;
        for (int e = 0; e < NEXP; ++e) { const int c = (int)__hip_atomic_load(gcnt + e, __ATOMIC_RELAXED, __HIP_MEMORY_SCOPE_AGENT); tab[e] = acc; tab[33 + e] = c; acc += (c + 255) >> 8; }
        tab[32] = acc; }
    __syncthreads();
}
struct MoeOrder {
    const LAS int* tab; int nN, G, c;
    __device__ __forceinline__ bool next(int i, pg8::Unit& u) const {
        const int L = i * G + c; const int ntile = tab[32];
        if (L >= ntile * nN) return false;
        const int ti = L / nN; int e = 0;
#pragma unroll 1
        for (int k = 1; k < NEXP; ++k) e = (tab[k] <= ti) ? k : e;
        u.e = e; u.mt = ti - tab[e]; u.pm = ti; u.pn = L % nN; return true;
    }
};
struct ProbGU {
    const bf16_t* A; const bf16_t* Bt; int K; const LAS int* tab; const int* slot_list;
    __device__ __forceinline__ int a_row(const pg8::Unit& u, int r) const { const int idx = u.mt * 256 + r; return idx < tab[33 + u.e] ? (slot_list[(size_t)u.e * T + idx] >> 1) : 0; }
    __device__ __forceinline__ const char* b_tile(const pg8::Unit& u) const { return (const char*)(Bt + ((size_t)u.e * 512 + (size_t)u.pn * 256) * DM); }
};
struct EpiGU {
    static constexpr bool PERM = true;
    bf16_t* H; const LAS int* tab; const float* w_list;
    __device__ __forceinline__ void operator()(const pg8::f32x4 (&acc)[2][2][4][2], const pg8::Unit& u, int wr, int wc, int fr, int fq) const {
        const int r0 = wr * 64 + fr; const int cnt = tab[33 + u.e];
        float wrow[2][4];
#pragma unroll
        for (int ai = 0; ai < 2; ++ai)
#pragma unroll
            for (int m = 0; m < 4; ++m) { const int idx = u.mt * 256 + r0 + ai * 128 + m * 16; wrow[ai][m] = idx < cnt ? w_list[(size_t)u.e * T + idx] : 0.f; }
#pragma unroll
        for (int ai = 0; ai < 2; ++ai)
#pragma unroll
            for (int m = 0; m < 4; ++m) {
                bf16_t* hp = H + (size_t)(u.pm * 256 + r0 + ai * 128 + m * 16) * DEXP + u.pn * 128 + wc * 16 + 4 * fq;
#pragma unroll
                for (int bj = 0; bj < 2; ++bj) { const pg8::f32x4 g = acc[ai][bj][m][0], uu = acc[ai][bj][m][1]; float h[4];
#pragma unroll
                    for (int i = 0; i < 4; ++i) h[i] = g[i] * __builtin_amdgcn_rcpf(1.f + __expf(-g[i])) * uu[i] * wrow[ai][m];
                    pg8::u32x2 w; w.x = pg8::cvt_pk_bf16(h[0], h[1]); w.y = pg8::cvt_pk_bf16(h[2], h[3]);
                    *(pg8::u32x2*)(hp + bj * 64) = w; }
            }
    }
};
struct ProbDown {
    const bf16_t* A; const bf16_t* Bt; int K;
    __device__ __forceinline__ int a_row(const pg8::Unit& u, int r) const { return u.pm * 256 + r; }
    __device__ __forceinline__ const char* b_tile(const pg8::Unit& u) const { return (const char*)(Bt + ((size_t)u.e * DM + (size_t)u.pn * 256) * DEXP); }
};
struct EpiDown {
    static constexpr bool PERM = true;
    bf16_t* Y; const LAS int* tab; const int* slot_list;
    __device__ __forceinline__ void operator()(const pg8::f32x4 (&acc)[2][2][4][2], const pg8::Unit& u, int wr, int wc, int fr, int fq) const {
        const int r0 = wr * 64 + fr; const int cnt = tab[33 + u.e];
        int drow[2][4];
#pragma unroll
        for (int ai = 0; ai < 2; ++ai)
#pragma unroll
            for (int m = 0; m < 4; ++m) { const int idx = u.mt * 256 + r0 + ai * 128 + m * 16; drow[ai][m] = idx < cnt ? slot_list[(size_t)u.e * T + idx] : -1; }
#pragma unroll
        for (int ai = 0; ai < 2; ++ai)
#pragma unroll
            for (int m = 0; m < 4; ++m) if (drow[ai][m] >= 0) {
                bf16_t* yp = Y + (size_t)drow[ai][m] * DM + u.pn * 256 + wc * 32 + 8 * fq;
#pragma unroll
                for (int bj = 0; bj < 2; ++bj) { const pg8::f32x4 v0 = acc[ai][bj][m][0], v1 = acc[ai][bj][m][1];
                    pg8::u32x4 w; w.x = pg8::cvt_pk_bf16(v0[0], v0[1]); w.y = pg8::cvt_pk_bf16(v0[2], v0[3]); w.z = pg8::cvt_pk_bf16(v1[0], v1[1]); w.w = pg8::cvt_pk_bf16(v1[2], v1[3]);
                    *(pg8::u32x4*)(yp + bj * 128) = w; }
            }
    }
};
__device__ __forceinline__ void ph_moe_gu(const P& p, unsigned char* lds_g, int bid, int nb) {
    moe_tables(p, lds_g);
    const LAS int* tab = (const LAS int*)((LAS unsigned char*)lds_g + MOE_TAB_OFF);
    ProbGU G{(const bf16_t*)(p.ws + WS_X1B), (const bf16_t*)(p.ws + WS_WGU), DM, tab, (const int*)(p.ws + WS_SLOT)};
    MoeOrder S{tab, 2, nb, bid};
    EpiGU E{(bf16_t*)(p.ws + WS_H), tab, (const float*)(p.ws + WS_WLIST)};
    pg8::gemm_phase((PG8_LAS unsigned char*)lds_g, G, S, E);
}
__device__ __forceinline__ void ph_moe_down(const P& p, unsigned char* lds_g, int bid, int nb) {
    const LAS int* tab = (const LAS int*)((LAS unsigned char*)lds_g + MOE_TAB_OFF);
    ProbDown G{(const bf16_t*)(p.ws + WS_H), (const bf16_t*)(p.ws + WS_WD), DEXP};
    MoeOrder S{tab, 4, nb, bid};
    EpiDown E{(bf16_t*)(p.ws + WS_Y), tab, (const int*)(p.ws + WS_SLOT)};
    pg8::gemm_phase((PG8_LAS unsigned char*)lds_g, G, S, E);
}
__device__ __forceinline__ void ph_rowpass2(const P& p, int bid, int nb) {
    const int tid = threadIdx.x, lane = tid & 63, wv = tid >> 6;
    const bf16_t* x1b = (const bf16_t*)(p.ws + WS_X1B); const bf16_t* Y = (const bf16_t*)(p.ws + WS_Y);
    v4f lw[4], lb[4];
#pragma unroll
    for (int j = 0; j < 4; ++j) { lw[j] = *((const v4f*)p.ln2_w + lane + 64 * j); lb[j] = *((const v4f*)p.ln2_b + lane + 64 * j); }
    for (int row = bid * 8 + wv; row < T; row += nb * 8) {
        const unsigned long long* xr = (const unsigned long long*)(x1b + (size_t)row * DM) + lane;
        const unsigned long long* y0 = (const unsigned long long*)(Y + (size_t)row * 2 * DM) + lane;
        const unsigned long long* y1 = y0 + DM / 4;
        v4f v[4]; float s = 0.f;
#pragma unroll
        for (int j = 0; j < 4; ++j) { const unsigned long long a = xr[64 * j], b = y0[64 * j], c = y1[64 * j];
            v[j].x = ALPHA * __uint_as_float((unsigned)a << 16) + __uint_as_float((unsigned)b << 16) + __uint_as_float((unsigned)c << 16);
            v[j].y = ALPHA * __uint_as_float((unsigned)a & 0xffff0000u) + __uint_as_float((unsigned)b & 0xffff0000u) + __uint_as_float((unsigned)c & 0xffff0000u);
            v[j].z = ALPHA * __uint_as_float((unsigned)(a >> 32) << 16) + __uint_as_float((unsigned)(b >> 32) << 16) + __uint_as_float((unsigned)(c >> 32) << 16);
            v[j].w = ALPHA * __uint_as_float((unsigned)(a >> 32) & 0xffff0000u) + __uint_as_float((unsigned)(b >> 32) & 0xffff0000u) + __uint_as_float((unsigned)(c >> 32) & 0xffff0000u);
            s += (v[j].x + v[j].y) + (v[j].z + v[j].w); }
        const float mu = wave_sum(s) * (1.f / DM); float q = 0.f;
#pragma unroll
        for (int j = 0; j < 4; ++j) { v[j] = v[j] - mu; q += (v[j].x * v[j].x + v[j].y * v[j].y) + (v[j].z * v[j].z + v[j].w * v[j].w); }
        const float rs = 1.f / sqrtf(wave_sum(q) * (1.f / DM) + LN_EPS);
        v4f* o = (v4f*)(p.out + (size_t)row * DM) + lane;
#pragma unroll
        for (int j = 0; j < 4; ++j) o[64 * j] = v[j] * rs * lw[j] + lb[j];
    }
}

typedef float f32x16 __attribute__((ext_vector_type(16)));
typedef unsigned u32x2_t __attribute__((ext_vector_type(2)));
__device__ __forceinline__ void ph_swa(const P& p, unsigned char* lds_g, int bid, int nb) {
    int tid = threadIdx.x; asm volatile("" : "+v"(tid));
    const int lane = tid & 63, wv = __builtin_amdgcn_readfirstlane(tid >> 6);
    const int g = wv & 3, hf = wv >> 2, r32 = lane & 31, hi = lane >> 5;
    LAS unsigned char* Ks = (LAS unsigned char*)lds_g;
    LAS unsigned char* Vt = Ks + 256 * 144;
    const bf16_t* proj = (const bf16_t*)(p.ws + WS_PROJ); bf16_t* mix = (bf16_t*)(p.ws + WS_MIX);
    constexpr float LOG2E = 1.4426950408889634f, SC = 0.125f * LOG2E;
    for (int unit = bid; unit < BATCH * AKH * (SEQ / 128); unit += nb) {
        const int b = unit / (AKH * 64), rem = unit % (AKH * 64), kvh = rem / 64, blk = rem % 64, q0 = blk * 128;
#pragma unroll
        for (int i = 0; i < 4; ++i) {
            const int c = tid + 512 * i, wl = c >> 3, ch = c & 7, pos = q0 - 128 + wl;
            v4u kv = {0u, 0u, 0u, 0u}, vv = {0u, 0u, 0u, 0u};
            if (pos >= 0) { const bf16_t* rp = proj + (size_t)(b * SEQ + pos) * NV + kvh * 64 + ch * 8; kv = *(const v4u*)(rp + PC_AK); vv = *(const v4u*)(rp + PC_AV); }
            *(LAS v4u*)(Ks + wl * 144 + ch * 16) = kv;
#pragma unroll
            for (int j = 0; j < 8; ++j) *(LAS unsigned short*)(Vt + (ch * 8 + j) * 520 + wl * 2) = (unsigned short)(vv[j >> 1] >> (16 * (j & 1)));
        }
        __syncthreads();
        const int hq = kvh * 4 + g; const float sink2 = p.sinks[hq] * LOG2E;
#pragma unroll 1
        for (int i = 0; i < 2; ++i) {
            const size_t row = (size_t)(b * SEQ + q0 + 64 * hf + 32 * i + r32);
            pg8::bf16x8 qf[4];
#pragma unroll
            for (int ks = 0; ks < 4; ++ks) qf[ks] = *(const pg8::bf16x8*)(proj + row * NV + PC_AQ + hq * 64 + 16 * ks + 8 * hi);
            const int t0 = 2 * hf + i;
            f32x16 sacc[5];
#pragma unroll
            for (int kt = 0; kt < 5; ++kt) {
                f32x16 acc = {0.f, 0.f, 0.f, 0.f, 0.f, 0.f, 0.f, 0.f, 0.f, 0.f, 0.f, 0.f, 0.f, 0.f, 0.f, 0.f};
                const LAS unsigned char* kp = Ks + (32 * (t0 + kt) + r32) * 144 + 16 * hi;
#pragma unroll
                for (int ks = 0; ks < 4; ++ks) acc = __builtin_amdgcn_mfma_f32_32x32x16_bf16(*(const LAS pg8::bf16x8*)(kp + 32 * ks), qf[ks], acc, 0, 0, 0);
                sacc[kt] = acc;
            }
            float m2 = sink2;
#pragma unroll
            for (int kt = 0; kt < 5; ++kt) {
                const bool tvalid = (blk > 0) || (t0 + kt >= 4);
#pragma unroll
                for (int r = 0; r < 16; ++r) {
                    const int kc = (r & 3) + 8 * (r >> 2) + 4 * hi;
                    bool ok = tvalid;
                    if (kt == 0) ok = ok && (kc > r32);
                    if (kt == 4) ok = ok && (kc <= r32);
                    const float s = ok ? sacc[kt][r] * SC : -INFINITY;
                    sacc[kt][r] = s; m2 = fmaxf(m2, s);
                }
            }
            m2 = fmaxf(m2, __shfl_xor(m2, 32));
            float l = 0.f;
#pragma unroll
            for (int kt = 0; kt < 5; ++kt)
#pragma unroll
                for (int r = 0; r < 16; ++r) { const float e = __builtin_amdgcn_exp2f(sacc[kt][r] - m2); sacc[kt][r] = e; l += e; }
            l += __shfl_xor(l, 32); l += __builtin_amdgcn_exp2f(sink2 - m2);
            f32x16 o[2];
            o[0] = (f32x16){0.f, 0.f, 0.f, 0.f, 0.f, 0.f, 0.f, 0.f, 0.f, 0.f, 0.f, 0.f, 0.f, 0.f, 0.f, 0.f}; o[1] = o[0];
#pragma unroll
            for (int kt = 0; kt < 5; ++kt)
#pragma unroll
                for (int s2 = 0; s2 < 2; ++s2) {
                    v4u pw; pw.x = pg8::cvt_pk_bf16(sacc[kt][8 * s2 + 0], sacc[kt][8 * s2 + 1]); pw.y = pg8::cvt_pk_bf16(sacc[kt][8 * s2 + 2], sacc[kt][8 * s2 + 3]);
                    pw.z = pg8::cvt_pk_bf16(sacc[kt][8 * s2 + 4], sacc[kt][8 * s2 + 5]); pw.w = pg8::cvt_pk_bf16(sacc[kt][8 * s2 + 6], sacc[kt][8 * s2 + 7]);
                    const pg8::bf16x8 pf = __builtin_bit_cast(pg8::bf16x8, pw);
#pragma unroll
                    for (int dt = 0; dt < 2; ++dt) {
                        const LAS unsigned char* vp = Vt + (32 * dt + r32) * 520 + (32 * (t0 + kt) + 16 * s2 + 4 * hi) * 2;
                        const u32x2_t c1 = *(const LAS u32x2_t*)vp, c2 = *(const LAS u32x2_t*)(vp + 16);
                        v4u vw; vw.x = c1.x; vw.y = c1.y; vw.z = c2.x; vw.w = c2.y;
                        o[dt] = __builtin_amdgcn_mfma_f32_32x32x16_bf16(__builtin_bit_cast(pg8::bf16x8, vw), pf, o[dt], 0, 0, 0);
                    }
                }
            const float inv = 1.f / l;
            bf16_t* op = mix + row * DM + 512 + hq * 64 + 4 * hi;
#pragma unroll
            for (int dt = 0; dt < 2; ++dt)
#pragma unroll
                for (int r4 = 0; r4 < 4; ++r4) {
                    u32x2_t w; w.x = pg8::cvt_pk_bf16(o[dt][4 * r4] * inv, o[dt][4 * r4 + 1] * inv); w.y = pg8::cvt_pk_bf16(o[dt][4 * r4 + 2] * inv, o[dt][4 * r4 + 3] * inv);
                    *(u32x2_t*)(op + 32 * dt + 8 * r4) = w;
                }
        }
        __syncthreads();
    }
}

constexpr size_t WS_QKC = WS_X1B;
constexpr size_t WS_DC = WS_H;
constexpr size_t WS_DN = 336 * MiB, WS_NST = WS_DN + 512 * 1024, WS_SCAL = WS_NST + 512 * 1024;
constexpr int KT_STRIDE = 272;

__device__ __forceinline__ float scan_add64(float v, int lane) {
#pragma unroll
    for (int o = 1; o < 64; o <<= 1) { const float t = __shfl_up(v, o); v = (lane >= o) ? v + t : v; }
    return v;
}
__device__ __forceinline__ float scan_max64(float v, int lane) {
#pragma unroll
    for (int o = 1; o < 64; o <<= 1) { const float t = __shfl_up(v, o); v = (lane >= o) ? fmaxf(v, t) : v; }
    return v;
}
__device__ __forceinline__ void gate_scan(const float* gates, size_t row0, int h, int lane, float& b0, float& b1, float& a0, float& a1) {
    const float* g0 = gates + (row0 + 2 * lane) * 8; const float* g1 = g0 + 8;
    const float i0 = g0[h], i1 = g1[h], lf0 = logsigmoid_f(g0[4 + h]), lf1 = logsigmoid_f(g1[4 + h]);
    const float pair = lf0 + lf1, incl = scan_add64(pair, lane), excl = incl - pair;
    b0 = excl + lf0; b1 = incl; a0 = i0 - b0; a1 = i1 - b1;
}
template <int WHICH>
__device__ __forceinline__ void conv_stage(const P& p, const bf16_t* proj, bf16_t* qkc, LAS unsigned char* Kt, int b, int h, int chunk, int cc, int tg) {
    const int colb = WHICH * 512 + h * 128 + cc * 8;
    float w[4][8], bias[8];
#pragma unroll
    for (int j = 0; j < 4; ++j) { const v4f w0 = *(const v4f*)(p.conv_w + j * 1024 + colb), w1 = *(const v4f*)(p.conv_w + j * 1024 + colb + 4);
        w[j][0] = w0.x; w[j][1] = w0.y; w[j][2] = w0.z; w[j][3] = w0.w; w[j][4] = w1.x; w[j][5] = w1.y; w[j][6] = w1.z; w[j][7] = w1.w; }
    { const v4f b0 = *(const v4f*)(p.conv_b + colb), b1 = *(const v4f*)(p.conv_b + colb + 4);
      bias[0] = b0.x; bias[1] = b0.y; bias[2] = b0.z; bias[3] = b0.w; bias[4] = b1.x; bias[5] = b1.y; bias[6] = b1.z; bias[7] = b1.w; }
    v4u u[7];
#pragma unroll
    for (int rr = 0; rr < 7; ++rr) { const int t = chunk * 128 + 4 * tg - 3 + rr;
        u[rr] = (v4u){0u, 0u, 0u, 0u};
        if (t >= 0) u[rr] = *(const v4u*)(proj + (size_t)(b * SEQ + t) * NV + colb); }
#pragma unroll
    for (int tt = 0; tt < 4; ++tt) {
        float o[8];
#pragma unroll
        for (int c = 0; c < 8; ++c) o[c] = bias[c];
#pragma unroll
        for (int j = 0; j < 4; ++j)
#pragma unroll
            for (int c = 0; c < 8; ++c) { const unsigned wd = u[tt + j][c >> 1]; const float uv = __uint_as_float((c & 1) ? (wd & 0xffff0000u) : (wd << 16)); o[c] += w[j][c] * uv; }
#pragma unroll
        for (int c = 0; c < 8; ++c) { o[c] = silu_f(o[c]); if (WHICH) o[c] *= 0.08838834764831845f; }
        v4u pk; pk.x = pk2(o[0], o[1]); pk.y = pk2(o[2], o[3]); pk.z = pk2(o[4], o[5]); pk.w = pk2(o[6], o[7]);
        const int tok = 4 * tg + tt;
        *(v4u*)(qkc + (size_t)(b * SEQ + chunk * 128 + tok) * DM + colb) = pk;
        if (WHICH) {
#pragma unroll
            for (int c = 0; c < 8; ++c) *(LAS unsigned short*)(Kt + (cc * 8 + c) * KT_STRIDE + tok * 2) = (unsigned short)(pk[c >> 1] >> (16 * (c & 1)));
        }
    }
}

__device__ __forceinline__ void ph_mlstm_a1(const P& p, unsigned char* lds_g, int bid, int nb) {
    int tid = threadIdx.x; asm volatile("" : "+v"(tid));
    const int lane = tid & 63, wv = __builtin_amdgcn_readfirstlane(tid >> 6), r32 = lane & 31, hi = lane >> 5;
    LAS unsigned char* Kt = (LAS unsigned char*)lds_g;
    LAS unsigned char* Vt = Kt + 128 * KT_STRIDE;
    LAS float* wsh = (LAS float*)(Vt + 128 * KT_STRIDE);
    const bf16_t* proj = (const bf16_t*)(p.ws + WS_PROJ); const float* gates = (const float*)(p.ws + WS_GATES);
    bf16_t* qkc = (bf16_t*)(p.ws + WS_QKC); bf16_t* dC = (bf16_t*)(p.ws + WS_DC);
    float* dn = (float*)(p.ws + WS_DN); float* scal = (float*)(p.ws + WS_SCAL);
    for (int item = bid; item < BATCH * MLH * 64; item += nb) {
        const int bh = item >> 6, chunk = item & 63, b = bh >> 2, h = bh & 3; const size_t row0 = (size_t)b * SEQ + chunk * 128;
        if (wv == 0) {
            float b0, b1, a0, a1; gate_scan(gates, row0, h, lane, b0, b1, a0, a1);
            const float amax = wave_max(fmaxf(a0, a1)); const float blast = __shfl(b1, 63);
            wsh[2 * lane] = expf(a0 - amax); wsh[2 * lane + 1] = expf(a1 - amax);
            if (lane == 0) { scal[bh * 64 + chunk] = blast + amax; scal[1024 + bh * 64 + chunk] = blast; }
        }
        conv_stage<0>(p, proj, qkc, Kt, b, h, chunk, tid & 15, tid >> 4);
        conv_stage<1>(p, proj, qkc, Kt, b, h, chunk, tid & 15, tid >> 4);
        __syncthreads();
#pragma unroll
        for (int i = 0; i < 4; ++i) { const int idx = tid + 512 * i, s = idx >> 4, ec = idx & 15;
            const v4u vv = *(const v4u*)(proj + (row0 + s) * NV + PC_MV + h * 128 + ec * 8); const float ws = wsh[s];
#pragma unroll
            for (int j = 0; j < 8; ++j) { const unsigned wd = vv[j >> 1]; const float v = __uint_as_float((j & 1) ? (wd & 0xffff0000u) : (wd << 16)) * ws;
                *(LAS unsigned short*)(Vt + (ec * 8 + j) * KT_STRIDE + s * 2) = f2bf(v); } }
        __syncthreads();
        {
            const int et = wv >> 1;
            f32x16 acc[2];
            acc[0] = (f32x16){0.f, 0.f, 0.f, 0.f, 0.f, 0.f, 0.f, 0.f, 0.f, 0.f, 0.f, 0.f, 0.f, 0.f, 0.f, 0.f}; acc[1] = acc[0];
            const LAS unsigned char* ap = Vt + (32 * et + r32) * KT_STRIDE + 16 * hi;
#pragma unroll
            for (int ks = 0; ks < 8; ++ks) { const pg8::bf16x8 a = *(const LAS pg8::bf16x8*)(ap + 32 * ks);
#pragma unroll
                for (int j = 0; j < 2; ++j) { const int dt = 2 * (wv & 1) + j;
                    const pg8::bf16x8 bb = *(const LAS pg8::bf16x8*)(Kt + (32 * dt + r32) * KT_STRIDE + 16 * hi + 32 * ks);
                    acc[j] = __builtin_amdgcn_mfma_f32_32x32x16_bf16(a, bb, acc[j], 0, 0, 0); } }
            bf16_t* out = dC + ((size_t)item * 128) * 128;
#pragma unroll
            for (int j = 0; j < 2; ++j) { const int dt = 2 * (wv & 1) + j;
#pragma unroll
                for (int r = 0; r < 16; ++r) { const int e = 32 * et + (r & 3) + 8 * (r >> 2) + 4 * hi; out[(size_t)e * 128 + 32 * dt + r32] = f2bf(acc[j][r]); } }
        }
        if (tid < 128) {
            float a = 0.f; const LAS unsigned char* kp = Kt + tid * KT_STRIDE;
            for (int s8 = 0; s8 < 16; ++s8) { const v4u kk = *(const LAS v4u*)(kp + s8 * 16);
#pragma unroll
                for (int j = 0; j < 8; ++j) { const unsigned wd = kk[j >> 1]; a += __uint_as_float((j & 1) ? (wd & 0xffff0000u) : (wd << 16)) * wsh[s8 * 8 + j]; } }
            dn[(size_t)item * 128 + tid] = a;
        }
        __syncthreads();
    }
}

__device__ __forceinline__ void ph_mlstm_a2(const P& p, unsigned char* lds_g, int bid, int nb) {
    const int tid = threadIdx.x;
    LAS float* dec = (LAS float*)lds_g; LAS float* gg = dec + 64;
    const bf16_t* dC = (const bf16_t*)(p.ws + WS_DC); bf16_t* Cst = (bf16_t*)(p.ws + WS_CST);
    const float* dn = (const float*)(p.ws + WS_DN); float* nst = (float*)(p.ws + WS_NST); float* scal = (float*)(p.ws + WS_SCAL);
    for (int it = bid; it < 256; it += nb) {
        const int bh = it >> 4, part = it & 15;
        if (tid == 0) { float m = 0.f;
            for (int k = 0; k < 64; ++k) { const float al = scal[bh * 64 + k], bl = scal[1024 + bh * 64 + k]; const float mn = fmaxf(bl + m, al);
                dec[k] = expf(bl + m - mn); gg[k] = expf(al - mn); if (part == 0) scal[2048 + bh * 64 + k] = m; m = mn; } }
        __syncthreads();
        {
            const size_t eoff = (size_t)part * 1024 + 2 * tid;
            const unsigned* src = (const unsigned*)(dC + (size_t)bh * 64 * 16384 + eoff); unsigned* dst = (unsigned*)(Cst + (size_t)bh * 64 * 16384 + eoff);
            float c0 = 0.f, c1 = 0.f;
#pragma unroll 8
            for (int k = 0; k < 64; ++k) { const unsigned d = src[(size_t)k * 8192];
                dst[(size_t)k * 8192] = pk2(c0, c1);
                c0 = dec[k] * c0 + gg[k] * __uint_as_float(d << 16); c1 = dec[k] * c1 + gg[k] * __uint_as_float(d & 0xffff0000u); }
        }
        if (part == 0 && tid < 128) { float n = 0.f;
            for (int k = 0; k < 64; ++k) { nst[((size_t)bh * 64 + k) * 128 + tid] = n; n = dec[k] * n + gg[k] * dn[((size_t)bh * 64 + k) * 128 + tid]; } }
        __syncthreads();
    }
}

__device__ __forceinline__ void ph_mlstm_b(const P& p, unsigned char* lds_g, int bid, int nb) {
    int tid = threadIdx.x; asm volatile("" : "+v"(tid));
    const int lane = tid & 63, wv = __builtin_amdgcn_readfirstlane(tid >> 6), r32 = lane & 31, hi = lane >> 5;
    LAS unsigned char* Ks = (LAS unsigned char*)lds_g;
    LAS unsigned char* Vt = Ks + 128 * KT_STRIDE;
    LAS float* a2s = (LAS float*)(Vt + 128 * KT_STRIDE);
    LAS float* M2s = a2s + 128;
    LAS float* wis = M2s + 128;
    LAS float* ems = wis + 128;
    LAS float* red = ems + 128;
    const bf16_t* proj = (const bf16_t*)(p.ws + WS_PROJ); const float* gates = (const float*)(p.ws + WS_GATES);
    const bf16_t* qkc = (const bf16_t*)(p.ws + WS_QKC); const bf16_t* Cst = (const bf16_t*)(p.ws + WS_CST);
    const float* nst = (const float*)(p.ws + WS_NST); const float* scal = (const float*)(p.ws + WS_SCAL);
    bf16_t* mix = (bf16_t*)(p.ws + WS_MIX);
    constexpr float LOG2E = 1.4426950408889634f;
    const int lt = wv >> 1, eh = wv & 1;
    for (int item = bid; item < BATCH * MLH * 64; item += nb) {
        const int bh = item >> 6, chunk = item & 63, b = bh >> 2, h = bh & 3; const size_t row0 = (size_t)b * SEQ + chunk * 128;
        const float mk = scal[2048 + bh * 64 + chunk];
        if (wv == 0) {
            float b0, b1, a0, a1; gate_scan(gates, row0, h, lane, b0, b1, a0, a1);
            const float incl = scan_max64(fmaxf(a0, a1), lane); float excl = __shfl_up(incl, 1); if (lane == 0) excl = -INFINITY;
            const float M0 = fmaxf(mk, fmaxf(excl, a0)), M1 = fmaxf(mk, incl);
            a2s[2 * lane] = a0 * LOG2E; a2s[2 * lane + 1] = a1 * LOG2E; M2s[2 * lane] = M0 * LOG2E; M2s[2 * lane + 1] = M1 * LOG2E;
            wis[2 * lane] = expf(mk - M0); wis[2 * lane + 1] = expf(mk - M1); ems[2 * lane] = expf(-b0 - M0); ems[2 * lane + 1] = expf(-b1 - M1);
        }
#pragma unroll
        for (int i = 0; i < 4; ++i) { const int idx = tid + 512 * i, s = idx >> 4, ch = idx & 15;
            *(LAS v4u*)(Ks + s * KT_STRIDE + ch * 16) = *(const v4u*)(qkc + (row0 + s) * DM + 512 + h * 128 + ch * 8);
            const v4u vv = *(const v4u*)(proj + (row0 + s) * NV + PC_MV + h * 128 + ch * 8);
#pragma unroll
            for (int j = 0; j < 8; ++j) *(LAS unsigned short*)(Vt + (ch * 8 + j) * KT_STRIDE + s * 2) = (unsigned short)(vv[j >> 1] >> (16 * (j & 1))); }
        __syncthreads();
        const int l = 32 * lt + r32; const size_t row = row0 + l;
        pg8::bf16x8 qf[8];
#pragma unroll
        for (int ks = 0; ks < 8; ++ks) qf[ks] = *(const pg8::bf16x8*)(qkc + row * DM + h * 128 + 16 * ks + 8 * hi);
        const float M2 = M2s[l], wint = wis[l], emr = ems[l];
        f32x16 acc[2];
        acc[0] = (f32x16){0.f, 0.f, 0.f, 0.f, 0.f, 0.f, 0.f, 0.f, 0.f, 0.f, 0.f, 0.f, 0.f, 0.f, 0.f, 0.f}; acc[1] = acc[0];
        float dq = 0.f;
        {
            const bf16_t* Cb = Cst + (size_t)item * 16384; const float* nb_ = nst + (size_t)item * 128;
#pragma unroll
            for (int ks = 0; ks < 8; ++ks) {
#pragma unroll
                for (int j = 0; j < 2; ++j) { const int e = 32 * (2 * eh + j) + r32;
                    const pg8::bf16x8 cf = *(const pg8::bf16x8*)(Cb + (size_t)e * 128 + 16 * ks + 8 * hi);
                    acc[j] = __builtin_amdgcn_mfma_f32_32x32x16_bf16(cf, qf[ks], acc[j], 0, 0, 0); }
                const v4f n0 = *(const v4f*)(nb_ + 16 * ks + 8 * hi), n1 = *(const v4f*)(nb_ + 16 * ks + 8 * hi + 4);
                const v4u qw = __builtin_bit_cast(v4u, qf[ks]);
                dq += n0.x * __uint_as_float(qw.x << 16) + n0.y * __uint_as_float(qw.x & 0xffff0000u) + n0.z * __uint_as_float(qw.y << 16) + n0.w * __uint_as_float(qw.y & 0xffff0000u)
                    + n1.x * __uint_as_float(qw.z << 16) + n1.y * __uint_as_float(qw.z & 0xffff0000u) + n1.z * __uint_as_float(qw.w << 16) + n1.w * __uint_as_float(qw.w & 0xffff0000u);
            }
            dq += __shfl_xor(dq, 32);
#pragma unroll
            for (int j = 0; j < 2; ++j)
#pragma unroll
                for (int r = 0; r < 16; ++r) acc[j][r] *= wint;
        }
        float ssum = 0.f;
#pragma unroll 1
        for (int st = 0; st <= lt; ++st) {
            f32x16 sa = {0.f, 0.f, 0.f, 0.f, 0.f, 0.f, 0.f, 0.f, 0.f, 0.f, 0.f, 0.f, 0.f, 0.f, 0.f, 0.f};
            const LAS unsigned char* kp = Ks + (32 * st + r32) * KT_STRIDE + 16 * hi;
#pragma unroll
            for (int ks = 0; ks < 8; ++ks) sa = __builtin_amdgcn_mfma_f32_32x32x16_bf16(*(const LAS pg8::bf16x8*)(kp + 32 * ks), qf[ks], sa, 0, 0, 0);
#pragma unroll
            for (int r4 = 0; r4 < 4; ++r4) { const v4f av = *(const LAS v4f*)(a2s + 32 * st + 8 * r4 + 4 * hi);
#pragma unroll
                for (int q = 0; q < 4; ++q) { const int s = 32 * st + 8 * r4 + 4 * hi + q;
                    const float wgt = (s <= l) ? __builtin_amdgcn_exp2f(av[q] - M2) : 0.f; const float sw = sa[4 * r4 + q] * wgt; sa[4 * r4 + q] = sw; ssum += sw; } }
#pragma unroll
            for (int s2 = 0; s2 < 2; ++s2) {
                v4u pw; pw.x = pg8::cvt_pk_bf16(sa[8 * s2 + 0], sa[8 * s2 + 1]); pw.y = pg8::cvt_pk_bf16(sa[8 * s2 + 2], sa[8 * s2 + 3]);
                pw.z = pg8::cvt_pk_bf16(sa[8 * s2 + 4], sa[8 * s2 + 5]); pw.w = pg8::cvt_pk_bf16(sa[8 * s2 + 6], sa[8 * s2 + 7]);
                const pg8::bf16x8 pf = __builtin_bit_cast(pg8::bf16x8, pw);
#pragma unroll
                for (int j = 0; j < 2; ++j) {
                    const LAS unsigned char* vp = Vt + (32 * (2 * eh + j) + r32) * KT_STRIDE + (32 * st + 16 * s2 + 4 * hi) * 2;
                    const u32x2_t c1 = *(const LAS u32x2_t*)vp, c2 = *(const LAS u32x2_t*)(vp + 16);
                    v4u vw; vw.x = c1.x; vw.y = c1.y; vw.z = c2.x; vw.w = c2.y;
                    acc[j] = __builtin_amdgcn_mfma_f32_32x32x16_bf16(__builtin_bit_cast(pg8::bf16x8, vw), pf, acc[j], 0, 0, 0);
                }
            }
        }
        ssum += __shfl_xor(ssum, 32);
        const float den = wint * dq + ssum; const float inv = 1.f / fmaxf(fabsf(den), emr);
        float s1 = 0.f, s2q = 0.f;
#pragma unroll
        for (int j = 0; j < 2; ++j)
#pragma unroll
            for (int r = 0; r < 16; ++r) { const float hv = acc[j][r] * inv; acc[j][r] = hv; s1 += hv; s2q += hv * hv; }
        s1 += __shfl_xor(s1, 32); s2q += __shfl_xor(s2q, 32);
        if (hi == 0) { red[((lt * 2 + eh) * 32 + r32) * 2] = s1; red[((lt * 2 + eh) * 32 + r32) * 2 + 1] = s2q; }
        __syncthreads();
        {
            const float t1 = red[((lt * 2) * 32 + r32) * 2] + red[((lt * 2 + 1) * 32 + r32) * 2], t2 = red[((lt * 2) * 32 + r32) * 2 + 1] + red[((lt * 2 + 1) * 32 + r32) * 2 + 1];
            const float mu = t1 * (1.f / 128.f); const float var = fmaxf(t2 * (1.f / 128.f) - mu * mu, 0.f); const float rs = 1.f / sqrtf(var + LN_EPS);
#pragma unroll
            for (int j = 0; j < 2; ++j)
#pragma unroll
                for (int r4 = 0; r4 < 4; ++r4) { const int e0 = 32 * (2 * eh + j) + 8 * r4 + 4 * hi;
                    const u32x2_t ow = *(const u32x2_t*)(proj + row * NV + PC_MO + h * 128 + e0); const v4f nw = *(const v4f*)(p.norm_w + h * 128 + e0);
                    const float o0 = __uint_as_float(ow.x << 16), o1 = __uint_as_float(ow.x & 0xffff0000u), o2 = __uint_as_float(ow.y << 16), o3 = __uint_as_float(ow.y & 0xffff0000u);
                    const float y0 = sigmoid_f(o0) * (acc[j][4 * r4] - mu) * rs * nw.x, y1 = sigmoid_f(o1) * (acc[j][4 * r4 + 1] - mu) * rs * nw.y;
                    const float y2 = sigmoid_f(o2) * (acc[j][4 * r4 + 2] - mu) * rs * nw.z, y3 = sigmoid_f(o3) * (acc[j][4 * r4 + 3] - mu) * rs * nw.w;
                    u32x2_t w; w.x = pg8::cvt_pk_bf16(y0, y1); w.y = pg8::cvt_pk_bf16(y2, y3);
                    *(u32x2_t*)(mix + row * DM + h * 128 + e0) = w; }
        }
        __syncthreads();
    }
}
#define GAS __attribute__((address_space(1)))
#define XB_TMO      128
#define XB_XCNT(j)  (256  + 64 * (j))
#define XB_XSUB(j)  (1280 + 64 * (j))
#define XB_XGEN(j)  (2304 + 64 * (j))
#define XB_TOP      3328
#define XB_TOPGEN   3392
#define XCD_BAR_WORDS 3456
#define XB_SPIN_CAP (1u << 18)

__device__ __forceinline__ unsigned xb_ld(unsigned* p)              { return __hip_atomic_load(p, __ATOMIC_RELAXED, __HIP_MEMORY_SCOPE_AGENT); }
__device__ __forceinline__ unsigned xb_add(unsigned* p, unsigned v) { return __hip_atomic_fetch_add(p, v, __ATOMIC_RELAXED, __HIP_MEMORY_SCOPE_AGENT); }
__device__ __forceinline__ unsigned xb_xcc_id() { return (unsigned)__builtin_amdgcn_s_getreg((3 << 11) | 20) & 0xFu; }
#define XB_SPIN(cond, bar) do { unsigned _sp = 0; while (cond) { __builtin_amdgcn_s_sleep(1); \
    if ((++_sp & 255u) == 0u) { if (xb_ld(&(bar)[XB_TMO])) break; if (_sp > XB_SPIN_CAP) { atomicAdd(&(bar)[XB_TMO], 1u); break; } } } } while (0)

struct XcdBarrier {
    unsigned* bar; unsigned x;
    volatile LAS unsigned* st;
};

__device__ __forceinline__ XcdBarrier xcd_barrier_post(unsigned* bar, volatile LAS unsigned* st) {
    XcdBarrier b; b.bar = bar; b.x = xb_xcc_id(); b.st = st;
    if (threadIdx.x == 0) (void)xb_add(&bar[XB_XCNT(b.x)], 1u);
    return b;
}
__device__ __forceinline__ void xcd_barrier_complete(unsigned* bar, unsigned x, unsigned& nloc, unsigned& nx) {
    const unsigned G = gridDim.x * gridDim.y * gridDim.z;
    unsigned sum, cnt, mine, sp = 0u;
    for (;;) {
        sum = 0u; cnt = 0u; mine = 0u;
#pragma unroll
        for (unsigned j = 0; j < 16; ++j) { const unsigned c = xb_ld(&bar[XB_XCNT(j)]); sum += c; cnt += (c > 0u) ? 1u : 0u; mine = (j == x) ? c : mine; }
        if (sum == G) break;
        __builtin_amdgcn_s_sleep(1);
        if ((++sp & 255u) == 0u) { if (xb_ld(&bar[XB_TMO])) break; if (sp > XB_SPIN_CAP) { atomicAdd(&bar[XB_TMO], 1u); break; } }
    }
    nloc = mine > 0u ? mine : 1u; nx = cnt > 0u ? cnt : 1u;
}

__device__ __forceinline__ void xcd_barrier(const XcdBarrier& b) {
    asm volatile("s_waitcnt vmcnt(0)" ::: "memory");
    __syncthreads();
    if (threadIdx.x == 0) {
        unsigned* bar = b.bar;
        __builtin_amdgcn_s_waitcnt(0);
        unsigned nloc = b.st[0], nx = b.st[1];
        if (nloc == 0u) { xcd_barrier_complete(bar, b.x, nloc, nx); b.st[0] = nloc; b.st[1] = nx; }
        const unsigned old = xb_add(&bar[XB_XSUB(b.x)], 1u);
        const unsigned gen = old / nloc;
        if (old + 1u == (gen + 1u) * nloc) {
            __builtin_amdgcn_fence(__ATOMIC_RELEASE, "agent");
            asm volatile("s_waitcnt vmcnt(0)" ::: "memory");
            const unsigned og = xb_add(&bar[XB_TOP], 1u);
            const unsigned tg = og / nx;
            if (og + 1u == (tg + 1u) * nx) xb_add(&bar[XB_TOPGEN], 1u);
            else XB_SPIN(xb_ld(&bar[XB_TOPGEN]) == tg, bar);
            __builtin_amdgcn_fence(__ATOMIC_ACQUIRE, "agent");
            xb_add(&bar[XB_XGEN(b.x)], 1u);
            asm volatile("s_waitcnt vmcnt(0)" ::: "memory");
        } else {
            XB_SPIN(xb_ld(&bar[XB_XGEN(b.x)]) == gen, bar);
            __builtin_amdgcn_fence(__ATOMIC_ACQUIRE, "agent");
            asm volatile("s_waitcnt vmcnt(0)" ::: "memory");
        }
    }
    __syncthreads();
}

extern __shared__ __attribute__((aligned(16))) unsigned char g_lds[];
constexpr int BAR_ST_OFF = 131072 + 1024;
constexpr int CW_BAR = 4096;
constexpr size_t CTL_ZERO_BYTES = 65536;
constexpr int LDS_BYTES = 147456;
__global__ void __launch_bounds__(512, 2) mega_fwd(P p) {
    cg::grid_group grid = cg::this_grid();
    const int bid = blockIdx.x, nb = gridDim.x;
    volatile LAS unsigned* bst = (volatile LAS unsigned*)((LAS unsigned char*)g_lds + BAR_ST_OFF);
    if (threadIdx.x < 2) bst[threadIdx.x] = 0u;
    __syncthreads();
    XcdBarrier bar = xcd_barrier_post((unsigned*)(p.ws + WS_CTL) + CW_BAR, bst);
    ph_prologue(p, g_lds, bid, nb);
    grid.sync();
    ph_inproj(p, g_lds, bid, nb);
    xcd_barrier(bar);
    ph_swa(p, g_lds, bid, nb);
    __syncthreads();
    ph_mlstm_a1(p, g_lds, bid, nb);
    xcd_barrier(bar);
    ph_mlstm_a2(p, g_lds, bid, nb);
    xcd_barrier(bar);
    ph_mlstm_b(p, g_lds, bid, nb);
    xcd_barrier(bar);
    ph_outproj(p, g_lds, bid, nb);
    xcd_barrier(bar);
    ph_rowpass1(p, g_lds, bid, nb);
    xcd_barrier(bar);
    ph_moe_gu(p, g_lds, bid, nb);
    xcd_barrier(bar);
    ph_moe_down(p, g_lds, bid, nb);
    xcd_barrier(bar);
    ph_rowpass2(p, bid, nb);
}

extern "C" void kernel_launch(void* const* d_in, const int* in_sizes, int n_in, void* d_out, int out_size, void* d_ws, size_t ws_size, hipStream_t stream) {
    if (n_in != 19 || in_sizes[0] != T * DM || out_size != T * DM || ws_size < WS_END) {
        fprintf(stderr, "kernel_launch: unexpected shapes (n_in %d in0 %d out %d ws %zu)\n", n_in, n_in > 0 ? in_sizes[0] : -1, out_size, ws_size); return; }
    static int grid_blocks = 0;
    if (!grid_blocks) {
        int dev = 0, cus = 0, per_cu = 0;
        (void)hipGetDevice(&dev);
        (void)hipDeviceGetAttribute(&cus, hipDeviceAttributeMultiprocessorCount, dev);
        (void)hipFuncSetAttribute((const void*)mega_fwd, hipFuncAttributeMaxDynamicSharedMemorySize, LDS_BYTES);
        (void)hipOccupancyMaxActiveBlocksPerMultiprocessor(&per_cu, (const void*)mega_fwd, 512, LDS_BYTES);
        if (per_cu < 1) { fprintf(stderr, "kernel_launch: occupancy query says %d blocks per CU\n", per_cu); per_cu = 1; }
        if (per_cu > 1) per_cu = 1;
        grid_blocks = cus * per_cu;
        (void)hipGetLastError();
    }
    P p{};
    const float** f = (const float**)&p;
    for (int i = 0; i < 19; ++i) f[i] = (const float*)d_in[i];
    p.out = (float*)d_out; p.ws = (unsigned char*)d_ws;
    (void)hipMemsetAsync((char*)d_ws + WS_CTL, 0, CTL_ZERO_BYTES, stream);
    void* args[] = {&p};
    hipError_t e = hipLaunchCooperativeKernel((const void*)mega_fwd, dim3(grid_blocks), dim3(512), args, LDS_BYTES, stream);
    if (e != hipSuccess) fprintf(stderr, "cooperative launch failed: %s (grid %d)\n", hipGetErrorString(e), grid_blocks);
}
```

```cpp
#include <hip/hip_runtime.h>
#include <hip/hip_cooperative_groups.h>
namespace cg = cooperative_groups;
#include <cstdio>
#include <cstdint>

typedef unsigned short bf16_t;

constexpr int BATCH = 4, SEQ = 8192, T = BATCH * SEQ, DM = 1024;
constexpr int MLH = 4, MLD = 128, MLW = 512;
constexpr int AQH = 8, AKH = 2, AHD = 64;
constexpr int DIN = 2824;
constexpr int NV = 2816;
constexpr int NGRP = 4, EPG = 8, NEXP = 32, DEXP = 256;
constexpr float LN_EPS = 1e-5f;
constexpr float ALPHA = 1.189207115002721f;
constexpr int PC_MQ = 0, PC_MK = 512, PC_MV = 1024, PC_MO = 1536, PC_AQ = 2048, PC_AK = 2560, PC_AV = 2688;

constexpr size_t MiB = 1u << 20;
constexpr size_t WS_CTL = 0, WS_TAB = 1 * MiB, WS_GATES = 3 * MiB, WS_RT = 4 * MiB, WS_MISC = 5 * MiB;
constexpr size_t WS_WIN = 8 * MiB, WS_WOUT = 14 * MiB, WS_WGU = 16 * MiB, WS_WD = 48 * MiB;
constexpr size_t WS_PROJ = 64 * MiB, WS_X1F = 64 * MiB, WS_Y = 192 * MiB;
constexpr size_t WS_MIX = 240 * MiB, WS_CST = 304 * MiB, WS_H = 340 * MiB, WS_X1B = 376 * MiB, WS_SLOT = 440 * MiB, WS_WLIST = 444 * MiB, WS_END = 448 * MiB;
constexpr size_t WS_WR = WS_MISC;

struct P {
    const float *x, *w_in, *conv_w, *conv_b, *gate_bias, *norm_w, *sinks, *w_out, *ln1_w, *ln1_b;
    const float *w_gr, *b_gr, *w_er, *b_er, *w_eg, *w_eu, *w_ed, *ln2_w, *ln2_b;
    float* out; unsigned char* ws;
};

__device__ __forceinline__ float bf2f(bf16_t v) { return __uint_as_float((unsigned)v << 16); }
__device__ __forceinline__ bf16_t f2bf(float f) { unsigned u = __float_as_uint(f); return (bf16_t)((u + 0x7fffu + ((u >> 16) & 1u)) >> 16); }
__device__ __forceinline__ float wave_sum(float v) {
#pragma unroll
    for (int o = 1; o < 64; o <<= 1) v += __shfl_xor(v, o);
    return v;
}
__device__ __forceinline__ float wave_max(float v) {
#pragma unroll
    for (int o = 1; o < 64; o <<= 1) v = fmaxf(v, __shfl_xor(v, o));
    return v;
}
__device__ __forceinline__ float silu_f(float v) { return v / (1.f + expf(-v)); }
__device__ __forceinline__ float sigmoid_f(float v) { return 1.f / (1.f + expf(-v)); }
__device__ __forceinline__ float logsigmoid_f(float v) { return fminf(v, 0.f) - log1pf(expf(-fabsf(v))); }
__device__ __forceinline__ int rope_pos(int d) { return d < 32 ? 8 * (d >> 2) + (d & 3) : 8 * ((d - 32) >> 2) + 4 + (d & 3); }
__device__ __forceinline__ int vcol_to_orig(int v) { return v < 2048 ? v : (v < NV ? v + 8 : v - NV + 2048); }

__device__ void ph_tab(const P& p, int bid, int nb) {
    float2* tab = (float2*)(p.ws + WS_TAB);
    for (int i = bid * 512 + threadIdx.x; i < SEQ * 32; i += nb * 512) {
        const int pos = i >> 5, f = i & 31;
        const double ang = (double)pos * pow(10000.0, -(double)f / 32.0);
        tab[i] = make_float2((float)cos(ang), (float)sin(ang));
    }
}

template <class AF, class BF>
__device__ __forceinline__ void naive_tile(AF af, BF bfn, int row0, int col0, int K, float* As, float* Bs, float* Ct) {
    const int tid = threadIdx.x, ty = tid >> 4, tx = tid & 15;
    float acc[4][4];
#pragma unroll
    for (int i = 0; i < 4; ++i)
#pragma unroll
        for (int j = 0; j < 4; ++j) acc[i][j] = 0.f;
    for (int k0 = 0; k0 < K; k0 += 16) {
#pragma unroll
        for (int i = 0; i < 4; ++i) { const int e = tid + 512 * i, r = e >> 4, kk = e & 15; As[kk * 132 + r] = af(row0 + r, k0 + kk); }
#pragma unroll
        for (int i = 0; i < 2; ++i) { const int e = tid + 512 * i, kk = e >> 6, c = e & 63; Bs[kk * 64 + c] = bfn(k0 + kk, col0 + c); }
        __syncthreads();
#pragma unroll
        for (int kk = 0; kk < 16; ++kk) {
            float a[4], b[4];
#pragma unroll
            for (int i = 0; i < 4; ++i) { a[i] = As[kk * 132 + 4 * ty + i]; b[i] = Bs[kk * 64 + 4 * tx + i]; }
#pragma unroll
            for (int i = 0; i < 4; ++i)
#pragma unroll
                for (int j = 0; j < 4; ++j) acc[i][j] += a[i] * b[j];
        }
        __syncthreads();
    }
#pragma unroll
    for (int i = 0; i < 4; ++i)
#pragma unroll
        for (int j = 0; j < 4; ++j) Ct[(4 * ty + i) * 65 + 4 * tx + j] = acc[i][j];
    __syncthreads();
}

__device__ void ph_inproj_naive(const P& p, unsigned char* lds, int bid, int nb) {
    float* As = (float*)lds; float* Bs = As + 16 * 132; float* Ct = Bs + 16 * 64;
    bf16_t* proj = (bf16_t*)(p.ws + WS_PROJ);
    float* gates = (float*)(p.ws + WS_GATES);
    const float2* tab = (const float2*)(p.ws + WS_TAB);
    const float* x = p.x; const float* w = p.w_in;
    constexpr int NCT = (DIN + 63) / 64;
    const int ntiles = (T / 128) * NCT;
    const int tid = threadIdx.x;
    for (int it = bid; it < ntiles; it += nb) {
        const int rt = it / NCT, ct = it % NCT, row0 = rt * 128, col0 = ct * 64;
        naive_tile([&](int r, int k) { return x[(size_t)r * DM + k]; },
                   [&](int k, int vc) { return vc < DIN ? w[(size_t)k * DIN + vcol_to_orig(vc)] : 0.f; },
                   row0, col0, DM, As, Bs, Ct);
        if (col0 >= NV) {
            for (int e = tid; e < 128 * 8; e += 512) { const int r = e >> 3, c = e & 7; gates[(size_t)(row0 + r) * 8 + c] = Ct[r * 65 + c] + p.gate_bias[c]; }
        } else if (col0 >= PC_AQ && col0 < PC_AV) {
            for (int e = tid; e < 128 * 32; e += 512) {
                const int r = e >> 5, d = e & 31; const int pos = (row0 + r) & (SEQ - 1);
                const float2 cs = tab[pos * 32 + d]; const float x1 = Ct[r * 65 + d], x2 = Ct[r * 65 + d + 32];
                bf16_t* o = proj + (size_t)(row0 + r) * NV + col0;
                o[rope_pos(d)] = f2bf(x1 * cs.x - x2 * cs.y); o[rope_pos(d + 32)] = f2bf(x1 * cs.y + x2 * cs.x);
            }
        } else {
            for (int e = tid; e < 128 * 64; e += 512) { const int r = e >> 6, c = e & 63; proj[(size_t)(row0 + r) * NV + col0 + c] = f2bf(Ct[r * 65 + c]); }
        }
        __syncthreads();
    }
}

__device__ void ph_mlstm_naive(const P& p, unsigned char* lds, int bid, int nb) {
    constexpr int TB = 16;
    float* qs = (float*)lds;
    float* ks = qs + TB * 128;
    float* vs = ks + TB * 128;
    float* hs = vs + TB * 128;
    float* gi = hs + TB * 128;
    float* gl = gi + TB;
    const bf16_t* proj = (const bf16_t*)(p.ws + WS_PROJ);
    const float* gates = (const float*)(p.ws + WS_GATES);
    bf16_t* mix = (bf16_t*)(p.ws + WS_MIX);
    const int tid = threadIdx.x, lane = tid & 63, wv = tid >> 6;
    const int e = tid >> 2, dq = tid & 3;
    for (int it = bid; it < BATCH * MLH; it += nb) {
        const int b = it / MLH, h = it % MLH;
        float C[32], n[32];
#pragma unroll
        for (int j = 0; j < 32; ++j) { C[j] = 0.f; n[j] = 0.f; }
        float m = 0.f;
        for (int t0 = 0; t0 < SEQ; t0 += TB) {
            for (int idx = tid; idx < TB * 256; idx += 512) {
                const int tok = idx >> 8, c = idx & 255; const int t = t0 + tok;
                const int ch = (c < 128) ? (h * 128 + c) : (512 + h * 128 + (c - 128));
                float a = p.conv_b[ch];
#pragma unroll
                for (int j = 0; j < 4; ++j) { const int tt = t - 3 + j; if (tt >= 0) a += p.conv_w[j * 1024 + ch] * bf2f(proj[(size_t)(b * SEQ + tt) * NV + ch]); }
                a = silu_f(a);
                if (c < 128) qs[tok * 128 + c] = a; else ks[tok * 128 + (c - 128)] = a * 0.08838834764831845f;
            }
            for (int idx = tid; idx < TB * 128; idx += 512) { const int tok = idx >> 7, c = idx & 127; vs[idx] = bf2f(proj[(size_t)(b * SEQ + t0 + tok) * NV + PC_MV + h * 128 + c]); }
            if (tid < TB) { const float* g = gates + (size_t)(b * SEQ + t0 + tid) * 8; gi[tid] = g[h]; gl[tid] = logsigmoid_f(g[4 + h]); }
            __syncthreads();
            for (int tok = 0; tok < TB; ++tok) {
                const float iv = gi[tok], lf = gl[tok];
                const float mn = fmaxf(lf + m, iv), fd = expf(lf + m - mn), iw = expf(iv - mn);
                const float ve = vs[tok * 128 + e] * iw;
                float nump = 0.f, denp = 0.f;
#pragma unroll
                for (int j = 0; j < 32; ++j) {
                    const float kk = ks[tok * 128 + dq * 32 + j], qq = qs[tok * 128 + dq * 32 + j];
                    C[j] = fd * C[j] + ve * kk; n[j] = fd * n[j] + iw * kk;
                    nump += C[j] * qq; denp += n[j] * qq;
                }
                nump += __shfl_xor(nump, 1); nump += __shfl_xor(nump, 2);
                denp += __shfl_xor(denp, 1); denp += __shfl_xor(denp, 2);
                if (dq == 0) hs[tok * 128 + e] = nump / fmaxf(fabsf(denp), expf(-mn));
                m = mn;
            }
            __syncthreads();
            for (int tk = wv * 2; tk < wv * 2 + 2; ++tk) {
                const float h0 = hs[tk * 128 + lane], h1 = hs[tk * 128 + 64 + lane];
                const float mu = wave_sum(h0 + h1) * (1.f / 128.f);
                const float d0 = h0 - mu, d1 = h1 - mu;
                const float var = wave_sum(d0 * d0 + d1 * d1) * (1.f / 128.f);
                const float rs = 1.f / sqrtf(var + LN_EPS);
                const size_t row = (size_t)(b * SEQ + t0 + tk);
                const float o0 = bf2f(proj[row * NV + PC_MO + h * 128 + lane]), o1 = bf2f(proj[row * NV + PC_MO + h * 128 + 64 + lane]);
                mix[row * DM + h * 128 + lane] = f2bf(sigmoid_f(o0) * d0 * rs * p.norm_w[h * 128 + lane]);
                mix[row * DM + h * 128 + 64 + lane] = f2bf(sigmoid_f(o1) * d1 * rs * p.norm_w[h * 128 + 64 + lane]);
            }
            __syncthreads();
        }
    }
}

__device__ void ph_swa_naive(const P& p, unsigned char* lds, int bid, int nb) {
    const int tid = threadIdx.x, lane = tid & 63, wv = tid >> 6;
    float* qsh = (float*)lds + wv * 192;
    float* psh = qsh + 64;
    const bf16_t* proj = (const bf16_t*)(p.ws + WS_PROJ);
    bf16_t* mix = (bf16_t*)(p.ws + WS_MIX);
    const long nitems = (long)T * AQH;
    for (long it = (long)bid * 8 + wv; it < nitems; it += (long)nb * 8) {
        const int hq = (int)(it & 7); const int row = (int)(it >> 3); const int s = row & (SEQ - 1); const int kvh = hq >> 2;
        qsh[lane] = bf2f(proj[(size_t)row * NV + PC_AQ + hq * 64 + lane]);
        __builtin_amdgcn_wave_barrier();
        float sc[2]; bool val[2];
#pragma unroll
        for (int u = 0; u < 2; ++u) {
            const int kidx = lane + 64 * u; const int kpos = s - 127 + kidx; val[u] = kpos >= 0;
            float a = 0.f;
            if (val[u]) { const bf16_t* kr = proj + (size_t)(row - 127 + kidx) * NV + PC_AK + kvh * 64;
                for (int d = 0; d < 64; ++d) a += qsh[d] * bf2f(kr[d]); }
            sc[u] = val[u] ? a * 0.125f : -INFINITY;
        }
        const float sink = p.sinks[hq];
        const float mx = fmaxf(wave_max(fmaxf(sc[0], sc[1])), sink);
        const float p0 = val[0] ? expf(sc[0] - mx) : 0.f, p1 = val[1] ? expf(sc[1] - mx) : 0.f;
        const float den = wave_sum(p0 + p1) + expf(sink - mx);
        psh[lane] = p0; psh[lane + 64] = p1;
        __builtin_amdgcn_wave_barrier();
        float o = 0.f;
        for (int kidx = 0; kidx < 128; ++kidx) { const int kpos = s - 127 + kidx; if (kpos >= 0) o += psh[kidx] * bf2f(proj[(size_t)(row - 127 + kidx) * NV + PC_AV + kvh * 64 + lane]); }
        mix[(size_t)row * DM + 512 + hq * 64 + lane] = f2bf(o / den);
        __builtin_amdgcn_wave_barrier();
    }
}

__device__ void ph_outproj_naive(const P& p, unsigned char* lds, int bid, int nb) {
    float* As = (float*)lds; float* Bs = As + 16 * 132; float* Ct = Bs + 16 * 64;
    const bf16_t* mix = (const bf16_t*)(p.ws + WS_MIX);
    float* y = (float*)(p.ws + WS_X1F);
    const float* w = p.w_out;
    const int ntiles = (T / 128) * (DM / 64);
    const int tid = threadIdx.x;
    for (int it = bid; it < ntiles; it += nb) {
        const int rt = it / (DM / 64), ct = it % (DM / 64), row0 = rt * 128, col0 = ct * 64;
        naive_tile([&](int r, int k) { return bf2f(mix[(size_t)r * DM + k]); },
                   [&](int k, int c) { return w[(size_t)k * DM + c]; }, row0, col0, DM, As, Bs, Ct);
        for (int e = tid; e < 128 * 64; e += 512) { const int r = e >> 6, c = e & 63; y[(size_t)(row0 + r) * DM + col0 + c] = Ct[r * 65 + c]; }
        __syncthreads();
    }
}

__device__ void ph_ln1_naive(const P& p, int bid, int nb) {
    const int tid = threadIdx.x, lane = tid & 63, wv = tid >> 6;
    float* x1 = (float*)(p.ws + WS_X1F); bf16_t* x1b = (bf16_t*)(p.ws + WS_X1B);
    for (int row = bid * 8 + wv; row < T; row += nb * 8) {
        float v[16]; float s = 0.f;
#pragma unroll
        for (int i = 0; i < 16; ++i) { const int c = i * 64 + lane; v[i] = ALPHA * p.x[(size_t)row * DM + c] + x1[(size_t)row * DM + c]; s += v[i]; }
        const float mu = wave_sum(s) * (1.f / DM); float q = 0.f;
#pragma unroll
        for (int i = 0; i < 16; ++i) { v[i] -= mu; q += v[i] * v[i]; }
        const float rs = 1.f / sqrtf(wave_sum(q) * (1.f / DM) + LN_EPS);
#pragma unroll
        for (int i = 0; i < 16; ++i) { const int c = i * 64 + lane; const float o = v[i] * rs * p.ln1_w[c] + p.ln1_b[c]; x1[(size_t)row * DM + c] = o; x1b[(size_t)row * DM + c] = f2bf(o); }
    }
}

__device__ void ph_route_naive(const P& p, int bid, int nb) {
    const int tid = threadIdx.x, lane = tid & 63, wv = tid >> 6;
    const float* x1 = (const float*)(p.ws + WS_X1F);
    int* rt_e = (int*)(p.ws + WS_RT); float* rt_w = (float*)(p.ws + WS_RT + 512 * 1024);
    for (int row = bid * 8 + wv; row < T; row += nb * 8) {
        float lg[36];
#pragma unroll
        for (int j = 0; j < 36; ++j) lg[j] = 0.f;
        for (int i = 0; i < 16; ++i) {
            const int d = i * 64 + lane; const float xv = x1[(size_t)row * DM + d];
#pragma unroll
            for (int j = 0; j < 4; ++j) lg[j] += xv * p.w_gr[d * 4 + j];
#pragma unroll
            for (int j = 0; j < 32; ++j) lg[4 + j] += xv * p.w_er[d * 32 + j];
        }
#pragma unroll
        for (int j = 0; j < 36; ++j) lg[j] = wave_sum(lg[j]);
        if (lane == 0) {
            float g[4]; int gi = 0;
#pragma unroll
            for (int j = 0; j < 4; ++j) g[j] = lg[j] + p.b_gr[j];
            float gm = g[0];
#pragma unroll
            for (int j = 1; j < 4; ++j) if (g[j] > gm) { gm = g[j]; gi = j; }
            float gs = 0.f;
#pragma unroll
            for (int j = 0; j < 4; ++j) gs += expf(g[j] - gm);
            const float gp = 1.f / gs;
            float ev[8];
#pragma unroll
            for (int j = 0; j < 8; ++j) { float a = 0.f;
#pragma unroll
                for (int q = 0; q < 4; ++q) a = (q == gi) ? (lg[4 + q * 8 + j] + p.b_er[q * 8 + j]) : a;
                ev[j] = a; }
            int i0 = 0; float v0 = ev[0];
#pragma unroll
            for (int j = 1; j < 8; ++j) if (ev[j] > v0) { v0 = ev[j]; i0 = j; }
            int i1 = -1; float v1 = -INFINITY;
#pragma unroll
            for (int j = 0; j < 8; ++j) if (j != i0 && ev[j] > v1) { v1 = ev[j]; i1 = j; }
            const float e1 = expf(v1 - v0); const float w0 = gp / (1.f + e1), w1 = gp * e1 / (1.f + e1);
            rt_e[row * 2] = gi * 8 + i0; rt_e[row * 2 + 1] = gi * 8 + i1; rt_w[row * 2] = w0; rt_w[row * 2 + 1] = w1;
        }
    }
}

__device__ void ph_moe_naive(const P& p, unsigned char* lds, int bid, int nb) {
    float* xs = (float*)lds;
    float* gu = xs + 1024;
    float* hs = gu + 512;
    float* red = hs + 512;
    const int tid = threadIdx.x, lane = tid & 63, wv = tid >> 6;
    const float* x1 = (const float*)(p.ws + WS_X1F); const bf16_t* x1b = (const bf16_t*)(p.ws + WS_X1B);
    const int* rt_e = (const int*)(p.ws + WS_RT); const float* rt_w = (const float*)(p.ws + WS_RT + 512 * 1024);
    for (int row = bid; row < T; row += nb) {
        xs[tid] = bf2f(x1b[(size_t)row * DM + tid]); xs[tid + 512] = bf2f(x1b[(size_t)row * DM + tid + 512]);
        __syncthreads();
        for (int k = 0; k < 2; ++k) {
            const int e = rt_e[row * 2 + k]; const float wk = rt_w[row * 2 + k];
            const float* W = (tid < 256 ? p.w_eg : p.w_eu) + (size_t)e * DM * DEXP + (tid & 255);
            float a = 0.f;
            for (int d = 0; d < DM; ++d) a += xs[d] * W[(size_t)d * DEXP];
            gu[tid] = a;
            __syncthreads();
            if (tid < 256) hs[k * 256 + tid] = silu_f(gu[tid]) * gu[256 + tid] * wk;
            __syncthreads();
        }
        float acc[2] = {0.f, 0.f};
        for (int k = 0; k < 2; ++k) {
            const int e = rt_e[row * 2 + k]; const float* W = p.w_ed + (size_t)e * DEXP * DM;
            for (int j = 0; j < DEXP; ++j) { const float hv = hs[k * 256 + j]; acc[0] += hv * W[(size_t)j * DM + tid]; acc[1] += hv * W[(size_t)j * DM + tid + 512]; }
        }
        float v0 = ALPHA * x1[(size_t)row * DM + tid] + acc[0], v1 = ALPHA * x1[(size_t)row * DM + tid + 512] + acc[1];
        float s = wave_sum(v0 + v1); if (lane == 0) red[wv] = s; __syncthreads();
        float mu = 0.f;
#pragma unroll
        for (int i = 0; i < 8; ++i) mu += red[i];
        mu *= (1.f / DM); v0 -= mu; v1 -= mu;
        float q = wave_sum(v0 * v0 + v1 * v1); if (lane == 0) red[8 + wv] = q; __syncthreads();
        float var = 0.f;
#pragma unroll
        for (int i = 0; i < 8; ++i) var += red[8 + i];
        const float rs = 1.f / sqrtf(var * (1.f / DM) + LN_EPS);
        p.out[(size_t)row * DM + tid] = v0 * rs * p.ln2_w[tid] + p.ln2_b[tid];
        p.out[(size_t)row * DM + tid + 512] = v1 * rs * p.ln2_w[tid + 512] + p.ln2_b[tid + 512];
        __syncthreads();
    }
}

namespace pg8 {
#define PG8_LAS __attribute__((address_space(3)))
typedef short bf16x8 __attribute__((ext_vector_type(8)));
typedef float f32x4 __attribute__((ext_vector_type(4)));
typedef unsigned u32x4 __attribute__((ext_vector_type(4)));
typedef unsigned u32x2 __attribute__((ext_vector_type(2)));
constexpr int BM = 256, BK = 64, HALF = 128, HTB = HALF * BK * 2, STAGE_BYTES = 8 * HTB, NXCD = 8, WGM = 8;

__host__ __device__ __forceinline__ int lds_byte(int r, int c) { const int st = (r >> 4) * 2 + (c >> 5), rr = r & 15, cc = c & 31, ob = rr * 64 + cc * 2; return st * 1024 + (ob ^ (((ob >> 9) & 1) << 5)); }
__host__ __device__ __forceinline__ void stage_rc(int b, int& R, int& C) { const int st = b / 1024, sb = b % 1024, swz = sb ^ (((sb >> 9) & 1) << 5); R = (st >> 1) * 16 + swz / 64; C = (st & 1) * 32 + (swz % 64) / 2; }
__host__ __device__ __forceinline__ int perm32(int rho) { const int n = rho >> 4, i = rho & 15; return 8 * (i >> 2) + 4 * n + (i & 3); }

struct Unit { int pm, pn, e, mt; };

__device__ __forceinline__ unsigned cvt_pk_bf16(float lo, float hi) { unsigned r; asm volatile("v_cvt_pk_bf16_f32 %0, %1, %2" : "=v"(r) : "v"(lo), "v"(hi)); return r; }

struct StaticOrder {
    int nM, nN, nwg, G, c;
    __device__ void init(int M, int N, int G_, int c_) { nM = M / BM; nN = N / BM; nwg = nM * nN; G = G_; c = c_; }
    __device__ bool next(int i, Unit& u) const {
        const long L = (long)i * G + c; if (L >= nwg) return false;
        int wgid = (int)L; { const int q = nwg / NXCD, r = nwg % NXCD, xcd = wgid % NXCD, off = wgid / NXCD; wgid = (xcd < r ? xcd * (q + 1) : r * (q + 1) + (xcd - r) * q) + off; }
        const int nig = WGM * nN, gid = wgid / nig, fm = gid * WGM, gsz = (nM - fm) < WGM ? (nM - fm) : WGM;
        u.pm = fm + ((wgid % nig) % gsz); u.pn = (wgid % nig) / gsz; u.e = 0; u.mt = 0; return true;
    }
};

template <class Epi, class Prob, class Sched>
__device__ __forceinline__ void gemm_phase(PG8_LAS unsigned char* lds, const Prob& G, const Sched& S, const Epi& E) {
    int tid = threadIdx.x; asm volatile("" : "+v"(tid));
    const int wid = __builtin_amdgcn_readfirstlane(tid >> 6), lane = tid & 63, wr = wid >> 2, wc = wid & 3, fr = lane & 15, fq = lane >> 4;
    const int K = G.K, nt = K / BK;
    unsigned voffB[2];
    { int Rr0, Cc0, Rr1, Cc1; stage_rc(tid * 16, Rr0, Cc0); stage_rc(tid * 16 + 8192, Rr1, Cc1);
      const int Rb0 = Epi::PERM ? ((Rr0 & ~31) + perm32(Rr0 & 31)) : Rr0, Rb1 = Epi::PERM ? ((Rr1 & ~31) + perm32(Rr1 & 31)) : Rr1;
      voffB[0] = (unsigned)(Rb0 * K + Cc0) * 2u; voffB[1] = (unsigned)(Rb1 * K + Cc1) * 2u; }
    const size_t kstep = (size_t)(BK * 2);
    const size_t hstep = (size_t)HALF * K * 2;
    const unsigned ldsw = (unsigned)wid * 1024u;
    const int aoff = lds_byte(wr * 64 + fr, fq * 8), boff = lds_byte(wc * 32 + fr, fq * 8);
    const char* const Abase = (const char*)G.A;
#define PG8_SA(b, h) (((b) * 2 + (h)) * HTB)
#define PG8_SB(b, h) ((4 + (b) * 2 + (h)) * HTB)
#define PG8_GLDS(gp, ldsoff) __builtin_amdgcn_global_load_lds((const unsigned*)(gp), (PG8_LAS unsigned*)(lds + (ldsoff)), 16, 0, 0)
#define PG8_STAGE_B(bufoff, gbase) do { PG8_GLDS((const char*)(gbase) + voffB[0], (bufoff) + ldsw); PG8_GLDS((const char*)(gbase) + voffB[1], (bufoff) + ldsw + 8192); } while (0)
#define PG8_STAGE_A(bufoff, kb, o0, o1) do { PG8_GLDS(Abase + (kb) + (o0), (bufoff) + ldsw); PG8_GLDS(Abase + (kb) + (o1), (bufoff) + ldsw + 8192); } while (0)
#define PG8_AOFFS(u, o00, o01, o10, o11) do { int t2_ = tid; asm volatile("" : "+v"(t2_)); int Rr0, Cc0, Rr1, Cc1; stage_rc(t2_ * 16, Rr0, Cc0); stage_rc(t2_ * 16 + 8192, Rr1, Cc1); \
        o00 = (unsigned)(((size_t)G.a_row(u, Rr0) * K + Cc0) * 2u); o01 = (unsigned)(((size_t)G.a_row(u, Rr1) * K + Cc1) * 2u); \
        o10 = (unsigned)(((size_t)G.a_row(u, 128 + Rr0) * K + Cc0) * 2u); o11 = (unsigned)(((size_t)G.a_row(u, 128 + Rr1) * K + Cc1) * 2u); } while (0)
#define PG8_LDA(dst, b, h) do { _Pragma("unroll") for (int m = 0; m < 4; ++m) _Pragma("unroll") for (int k = 0; k < 2; ++k) dst[m][k] = *(const PG8_LAS bf16x8*)(lds + PG8_SA(b, h) + aoff + m * 2048 + k * 1024); } while (0)
#define PG8_LDB(dst, b, h) do { _Pragma("unroll") for (int n = 0; n < 2; ++n) _Pragma("unroll") for (int k = 0; k < 2; ++k) dst[n][k] = *(const PG8_LAS bf16x8*)(lds + PG8_SB(b, h) + boff + n * 2048 + k * 1024); } while (0)
#define PG8_MMA(ai, bj, At, Bt) do { __builtin_amdgcn_s_setprio(1); _Pragma("unroll") for (int m = 0; m < 4; ++m) _Pragma("unroll") for (int n = 0; n < 2; ++n) _Pragma("unroll") for (int k = 0; k < 2; ++k) \
        acc[ai][bj][m][n] = __builtin_amdgcn_mfma_f32_16x16x32_bf16(Bt[n][k], At[m][k], acc[ai][bj][m][n], 0, 0, 0); __builtin_amdgcn_s_setprio(0); } while (0)
#define PG8_WAIT_V(n) asm volatile("s_waitcnt vmcnt(" #n ")" ::: "memory")
#define PG8_WAIT_L(n) asm volatile("s_waitcnt lgkmcnt(" #n ")" ::: "memory")
#define PG8_BAR __builtin_amdgcn_s_barrier()
#define PG8_SCHED __builtin_amdgcn_sched_barrier(0)
    Unit cur, nxt; int ui = 0;
    if (!S.next(0, cur)) return;
    f32x4 acc[2][2][4][2];
#pragma unroll
    for (int a = 0; a < 2; ++a)
#pragma unroll
        for (int b = 0; b < 2; ++b)
#pragma unroll
            for (int m = 0; m < 4; ++m)
#pragma unroll
                for (int n = 0; n < 2; ++n) acc[a][b][m][n] = (f32x4){0.f, 0.f, 0.f, 0.f};
    bf16x8 At[4][2], B0[2][2], B1[2][2];
    unsigned c00, c01, c10, c11;
    PG8_AOFFS(cur, c00, c01, c10, c11);
    const char* cB = G.b_tile(cur);
    PG8_STAGE_B(PG8_SB(0, 0), cB); PG8_STAGE_B(PG8_SB(0, 1), cB + hstep); PG8_STAGE_A(PG8_SA(0, 0), 0, c00, c01); PG8_STAGE_A(PG8_SA(0, 1), 0, c10, c11);
    if (wr == 1) PG8_BAR;
    PG8_WAIT_V(2); PG8_BAR;
    PG8_STAGE_B(PG8_SB(1, 0), cB + kstep); PG8_STAGE_A(PG8_SA(1, 0), kstep, c00, c01); PG8_STAGE_B(PG8_SB(1, 1), cB + hstep + kstep);
    PG8_WAIT_V(6); PG8_BAR;
    for (;;) {
        const bool has_next = S.next(ui + 1, nxt);
        const char* nB = has_next ? G.b_tile(nxt) : cB;
        for (int t = 0; t < nt; t += 2) {
            const bool last = (t == nt - 2);
            const size_t ka1 = (size_t)(t + 1) * kstep;
            const size_t ka2 = last ? 0 : (size_t)(t + 2) * kstep, ka3 = ka2 + kstep;
            const char* b2 = last ? nB : cB + (size_t)(t + 2) * kstep; const char* b3 = b2 + kstep;
            PG8_LDB(B0, 0, 0); PG8_LDB(B1, 0, 1); PG8_SCHED; PG8_LDA(At, 0, 0); PG8_STAGE_A(PG8_SA(1, 1), ka1, c10, c11);
            if (last && has_next) { PG8_AOFFS(nxt, c00, c01, c10, c11); }
            PG8_WAIT_V(8); PG8_WAIT_L(0); PG8_BAR; PG8_MMA(0, 0, At, B0); PG8_MMA(0, 1, At, B1); PG8_BAR; PG8_SCHED;
            PG8_LDA(At, 0, 1); PG8_STAGE_B(PG8_SB(0, 0), b2); PG8_STAGE_B(PG8_SB(0, 1), b2 + hstep); PG8_STAGE_A(PG8_SA(0, 0), ka2, c00, c01);
            PG8_WAIT_V(8); PG8_WAIT_L(0); PG8_BAR; PG8_MMA(1, 0, At, B0); PG8_MMA(1, 1, At, B1); PG8_BAR; PG8_SCHED;
            PG8_LDB(B0, 1, 0); PG8_LDB(B1, 1, 1); PG8_SCHED; PG8_LDA(At, 1, 0); PG8_STAGE_A(PG8_SA(0, 1), ka2, c10, c11);
            PG8_WAIT_V(8); PG8_WAIT_L(0); PG8_BAR; PG8_MMA(0, 0, At, B0); PG8_MMA(0, 1, At, B1); PG8_BAR; PG8_SCHED;
            PG8_LDA(At, 1, 1); PG8_STAGE_B(PG8_SB(1, 0), b3); PG8_STAGE_B(PG8_SB(1, 1), b3 + hstep); PG8_STAGE_A(PG8_SA(1, 0), ka3, c00, c01);
            PG8_WAIT_V(8); PG8_WAIT_L(0); PG8_BAR; PG8_MMA(1, 0, At, B0); PG8_MMA(1, 1, At, B1); PG8_BAR; PG8_SCHED;
        }
        if (wr == 0) PG8_BAR;
        E(acc, cur, wr, wc, fr, fq);
        if (!has_next) break;
#pragma unroll
        for (int a = 0; a < 2; ++a)
#pragma unroll
            for (int b = 0; b < 2; ++b)
#pragma unroll
                for (int m = 0; m < 4; ++m)
#pragma unroll
                    for (int n = 0; n < 2; ++n) acc[a][b][m][n] = (f32x4){0.f, 0.f, 0.f, 0.f};
        cur = nxt; cB = nB; ++ui;
        if (wr == 1) PG8_BAR;
    }
    PG8_WAIT_V(0);
    PG8_BAR;
#undef PG8_SA
#undef PG8_SB
#undef PG8_GLDS
#undef PG8_STAGE_A
#undef PG8_STAGE_B
#undef PG8_AOFFS
#undef PG8_LDA
#undef PG8_LDB
#undef PG8_MMA
#undef PG8_WAIT_V
#undef PG8_WAIT_L
#undef PG8_BAR
#undef PG8_SCHED
}
}
#define LAS __attribute__((address_space(3)))
typedef unsigned v4u __attribute__((ext_vector_type(4)));
typedef float v4f __attribute__((ext_vector_type(4)));
#define LDS_WAIT() asm volatile("s_waitcnt lgkmcnt(0)" ::: "memory")
__device__ __forceinline__ unsigned pk2(float lo, float hi) { unsigned r; asm volatile("v_cvt_pk_bf16_f32 %0, %1, %2" : "=v"(r) : "v"(lo), "v"(hi)); return r; }
__device__ __forceinline__ float fsigmoid(float v) { return __builtin_amdgcn_rcpf(1.f + __builtin_amdgcn_exp2f(v * -1.4426950408889634f)); }
__device__ __forceinline__ float fsilu(float v) { return v * fsigmoid(v); }

constexpr int CW_GCNT = 64;

template <class SrcCol, class DstRow>
__device__ __forceinline__ void transpose_item(const float* W, int ldw, int K, bf16_t* WT, int k0, int n0, SrcCol sc, DstRow dr, LAS float* scr, int lane) {
    const int scol = sc(n0 + (lane & 31));
#pragma unroll 8
    for (int i = 0; i < 32; ++i) { const int kk = 2 * i + (lane >> 5); scr[kk * 33 + (lane & 31)] = W[(size_t)(k0 + kk) * ldw + scol]; }
    LDS_WAIT(); asm volatile("" ::: "memory");
    const int c = lane & 7;
#pragma unroll
    for (int j = 0; j < 4; ++j) { const int n = (lane >> 3) + 8 * j; const LAS float* s = scr + (8 * c) * 33 + n;
        v4u o; o.x = pk2(s[0 * 33], s[1 * 33]); o.y = pk2(s[2 * 33], s[3 * 33]); o.z = pk2(s[4 * 33], s[5 * 33]); o.w = pk2(s[6 * 33], s[7 * 33]);
        *(v4u*)(WT + (size_t)dr(n0 + n) * K + k0 + 8 * c) = o; }
    LDS_WAIT(); asm volatile("" ::: "memory");
}

__device__ __forceinline__ void ph_prologue(const P& p, unsigned char* lds_g, int bid, int nb) {
    int tid = threadIdx.x; asm volatile("" : "+v"(tid));
    const int lane = tid & 63, wv = __builtin_amdgcn_readfirstlane(tid >> 6);
    LAS unsigned char* lds = (LAS unsigned char*)lds_g;
    ph_tab(p, bid, nb);
    {
        bf16_t* Wr = (bf16_t*)(p.ws + WS_WR);
        for (int i = bid * 512 + tid; i < 48 * DM; i += nb * 512) { const int j = i >> 10, d = i & 1023;
            const float w = j < 4 ? p.w_gr[d * 4 + j] : (j < 36 ? p.w_er[d * 32 + (j - 4)] : 0.f); Wr[i] = f2bf(w); }
    }
    LAS float* wg = (LAS float*)(lds + 8 * 8448);
    for (int i = tid; i < 8 * 1024; i += 512) { const int d = i >> 3, c = i & 7; wg[c * 1024 + d] = p.w_in[(size_t)d * DIN + 2048 + c]; }
    __syncthreads();
    {
        bf16_t* xb = (bf16_t*)(p.ws + WS_MIX); float* gates = (float*)(p.ws + WS_GATES);
        for (int row = bid * 8 + wv; row < T; row += nb * 8) {
            const v4f* xr = (const v4f*)(p.x + (size_t)row * DM) + lane;
            v4f v[4];
#pragma unroll
            for (int j = 0; j < 4; ++j) v[j] = xr[64 * j];
            unsigned long long* o8 = (unsigned long long*)(xb + (size_t)row * DM) + lane;
#pragma unroll
            for (int j = 0; j < 4; ++j) o8[64 * j] = (unsigned long long)pk2(v[j].x, v[j].y) | ((unsigned long long)pk2(v[j].z, v[j].w) << 32);
            float g[8];
#pragma unroll
            for (int c = 0; c < 8; ++c) { float a = 0.f;
#pragma unroll
                for (int j = 0; j < 4; ++j) { const v4f w = *(const LAS v4f*)(wg + c * 1024 + 256 * j + 4 * lane); a += v[j].x * w.x + v[j].y * w.y + v[j].z * w.z + v[j].w * w.w; }
                g[c] = wave_sum(a); }
            float gv = g[0];
#pragma unroll
            for (int c = 1; c < 8; ++c) gv = (lane == c) ? g[c] : gv;
            if (lane < 8) gates[(size_t)row * 8 + lane] = gv + p.gate_bias[lane];
        }
    }
    {
        LAS float* scr = (LAS float*)(lds + wv * 8448);
        const int gw = bid * 8 + wv, NGW = nb * 8;
        bf16_t* Win = (bf16_t*)(p.ws + WS_WIN);
        constexpr int I_IN = 16 * (NV / 32);
        for (int r = gw; r < I_IN; r += NGW) { const int kb = r / (NV / 32), nbk = r % (NV / 32);
            transpose_item(p.w_in, DIN, DM, Win, kb * 64, nbk * 32, [](int v) { return vcol_to_orig(v); },
                           [](int v) { return (v >= PC_AQ && v < PC_AV) ? ((v & ~63) + rope_pos(v & 63)) : v; }, scr, lane); }
    }
}

constexpr int CW_CONVQ = 32;
__device__ __forceinline__ void ph_convert_rest(const P& p, unsigned char* lds_g) {
    int tid = threadIdx.x; asm volatile("" : "+v"(tid));
    const int lane = tid & 63, wv = __builtin_amdgcn_readfirstlane(tid >> 6);
    LAS float* scr = (LAS float*)((LAS unsigned char*)lds_g + wv * 8448);
    unsigned* q = (unsigned*)(p.ws + WS_CTL) + CW_CONVQ;
    bf16_t* Wout = (bf16_t*)(p.ws + WS_WOUT); bf16_t* Wgu = (bf16_t*)(p.ws + WS_WGU); bf16_t* Wd = (bf16_t*)(p.ws + WS_WD);
    constexpr int I_OUT = 16 * 32, I_G = NEXP * 16 * 8, I_D = NEXP * 4 * 32;
    constexpr int NITEMS = I_OUT + 2 * I_G + I_D;
    for (;;) {
        unsigned base = 0; if (lane == 0) base = __hip_atomic_fetch_add(q, 16u, __ATOMIC_RELAXED, __HIP_MEMORY_SCOPE_AGENT);
        base = (unsigned)__builtin_amdgcn_readfirstlane((int)base);
        if (base >= (unsigned)NITEMS) break;
        for (int it = (int)base; it < (int)base + 16 && it < NITEMS; ++it) {
            int r = it;
            if (r < I_OUT) { const int kb = r / 32, nbk = r % 32;
                transpose_item(p.w_out, DM, DM, Wout, kb * 64, nbk * 32, [](int v) { return v; }, [](int v) { return v; }, scr, lane); continue; }
            r -= I_OUT;
            if (r < 2 * I_G) { const int up = r >= I_G; if (up) r -= I_G; const int e = r / 128, qq = r % 128, kb = qq / 8, nbk = qq % 8;
                transpose_item((up ? p.w_eu : p.w_eg) + (size_t)e * DM * DEXP, DEXP, DM, Wgu + (size_t)e * 512 * DM, kb * 64, nbk * 32, [](int v) { return v; },
                               [up](int j) { return 8 * (j >> 2) + 4 * up + (j & 3); }, scr, lane); continue; }
            r -= 2 * I_G;
            { const int e = r / 128, qq = r % 128, kb = qq / 32, nbk = qq % 32;
                transpose_item(p.w_ed + (size_t)e * DEXP * DM, DM, DEXP, Wd + (size_t)e * DM * DEXP, kb * 64, nbk * 32, [](int v) { return v; }, [](int v) { return v; }, scr, lane); }
        }
    }
}

struct ProbPlain {
    const bf16_t* A; const bf16_t* Bt; int K;
    __device__ __forceinline__ int a_row(const pg8::Unit& u, int r) const { return u.pm * 256 + r; }
    __device__ __forceinline__ const char* b_tile(const pg8::Unit& u) const { return (const char*)(Bt + (size_t)u.pn * 256 * K); }
};
struct EpiInProj {
    static constexpr bool PERM = true;
    bf16_t* proj; const float* tab;
    __device__ __forceinline__ void operator()(const pg8::f32x4 (&acc)[2][2][4][2], const pg8::Unit& u, int wr, int wc, int fr, int fq) const {
        const int row0 = u.pm * 256 + wr * 64 + fr, colt = u.pn * 256 + wc * 32 + 8 * fq;
        const int g = 4 * (wc & 1) + fq;
#pragma unroll
        for (int ai = 0; ai < 2; ++ai)
#pragma unroll
            for (int m = 0; m < 4; ++m) {
                const int row = row0 + ai * 128 + m * 16; const int pos = row & (SEQ - 1);
                bf16_t* rowp = proj + (size_t)row * NV + colt;
#pragma unroll
                for (int bj = 0; bj < 2; ++bj) {
                    pg8::f32x4 v0 = acc[ai][bj][m][0], v1 = acc[ai][bj][m][1];
                    const bool rope = (u.pn == 8) || (u.pn == 9) || (u.pn == 10 && bj == 0);
                    if (rope) {
                        const v4f t0 = *(const v4f*)(tab + (size_t)(pos * 32 + 4 * g) * 2), t1 = *(const v4f*)(tab + (size_t)(pos * 32 + 4 * g) * 2 + 4);
                        const pg8::f32x4 a = v0, b = v1;
                        v0[0] = a[0] * t0.x - b[0] * t0.y; v1[0] = a[0] * t0.y + b[0] * t0.x;
                        v0[1] = a[1] * t0.z - b[1] * t0.w; v1[1] = a[1] * t0.w + b[1] * t0.z;
                        v0[2] = a[2] * t1.x - b[2] * t1.y; v1[2] = a[2] * t1.y + b[2] * t1.x;
                        v0[3] = a[3] * t1.z - b[3] * t1.w; v1[3] = a[3] * t1.w + b[3] * t1.z;
                    }
                    pg8::u32x4 w; w.x = pg8::cvt_pk_bf16(v0[0], v0[1]); w.y = pg8::cvt_pk_bf16(v0[2], v0[3]); w.z = pg8::cvt_pk_bf16(v1[0], v1[1]); w.w = pg8::cvt_pk_bf16(v1[2], v1[3]);
                    *(pg8::u32x4*)(rowp + bj * 128) = w;
                }
                asm volatile("" ::: "memory");
            }
    }
};
__device__ __forceinline__ void ph_inproj(const P& p, unsigned char* lds_g, int bid, int nb) {
    ProbPlain G{(const bf16_t*)(p.ws + WS_MIX), (const bf16_t*)(p.ws + WS_WIN), DM};
    pg8::StaticOrder S; S.init(T, NV, nb, bid);
    EpiInProj E{(bf16_t*)(p.ws + WS_PROJ), (const float*)(p.ws + WS_TAB)};
    pg8::gemm_phase(( PG8_LAS unsigned char*)lds_g, G, S, E);
}

struct EpiOutProj {
    static constexpr bool PERM = true;
    const float* x; bf16_t* V;
    __device__ __forceinline__ void operator()(const pg8::f32x4 (&acc)[2][2][4][2], const pg8::Unit& u, int wr, int wc, int fr, int fq) const {
        const int row0 = u.pm * 256 + wr * 64 + fr, col0 = u.pn * 256 + wc * 32 + 8 * fq;
#pragma unroll
        for (int ai = 0; ai < 2; ++ai)
#pragma unroll
            for (int m = 0; m < 4; ++m) {
                const size_t off = (size_t)(row0 + ai * 128 + m * 16) * DM + col0;
#pragma unroll
                for (int bj = 0; bj < 2; ++bj) {
                    const pg8::f32x4 x0 = *(const pg8::f32x4*)(x + off + bj * 128), x1 = *(const pg8::f32x4*)(x + off + bj * 128 + 4);
                    const pg8::f32x4 v0 = x0 * ALPHA + acc[ai][bj][m][0], v1 = x1 * ALPHA + acc[ai][bj][m][1];
                    pg8::u32x4 w; w.x = pg8::cvt_pk_bf16(v0[0], v0[1]); w.y = pg8::cvt_pk_bf16(v0[2], v0[3]); w.z = pg8::cvt_pk_bf16(v1[0], v1[1]); w.w = pg8::cvt_pk_bf16(v1[2], v1[3]);
                    *(pg8::u32x4*)(V + off + bj * 128) = w; }
                if (m & 1) asm volatile("" ::: "memory");
            }
    }
};
__device__ __forceinline__ void ph_outproj(const P& p, unsigned char* lds_g, int bid, int nb) {
    ProbPlain G{(const bf16_t*)(p.ws + WS_MIX), (const bf16_t*)(p.ws + WS_WOUT), DM};
    pg8::StaticOrder S; S.init(T, DM, nb, bid);
    EpiOutProj E{p.x, (bf16_t*)(p.ws + WS_X1F)};
    pg8::gemm_phase((PG8_LAS unsigned char*)lds_g, G, S, E);
}

__device__ __forceinline__ void ph_rowpass1(const P& p, unsigned char* lds_g, int bid, int nb) {
    int tid = threadIdx.x; asm volatile("" : "+v"(tid));
    const int lane = tid & 63, wv = __builtin_amdgcn_readfirstlane(tid >> 6);
    LAS unsigned char* lds = (LAS unsigned char*)lds_g;
    constexpr int XT_STRIDE = 2064;
    LAS unsigned char* xt = lds;
    LAS float* lg = (LAS float*)(lds + 32 * XT_STRIDE);
    LAS int* lcnt = (LAS int*)(lds + 32 * XT_STRIDE + 6144);
    LAS int* lbase = lcnt + 32;
    LAS int* recn = lbase + 32;
    LAS int* rec_e = recn + 32;
    LAS int* rec_li = rec_e + 256;
    LAS int* rec_v = rec_li + 256;
    LAS float* rec_w = (LAS float*)(rec_v + 256);
    const bf16_t* V = (const bf16_t*)(p.ws + WS_X1F); bf16_t* x1b = (bf16_t*)(p.ws + WS_X1B);
    const bf16_t* Wr = (const bf16_t*)(p.ws + WS_WR);
    unsigned* gcnt = (unsigned*)(p.ws + WS_CTL) + CW_GCNT;
    int* slot_list = (int*)(p.ws + WS_SLOT); float* w_list = (float*)(p.ws + WS_WLIST);
    if (tid < 32) { lcnt[tid] = 0; if (tid == 0) recn[0] = 0; }
    v4f lw[4], lb[4];
#pragma unroll
    for (int j = 0; j < 4; ++j) { lw[j] = *((const v4f*)p.ln1_w + lane + 64 * j); lb[j] = *((const v4f*)p.ln1_b + lane + 64 * j); }
    __syncthreads();
    for (int tile = bid; tile < T / 32; tile += nb) {
        const int row0 = tile * 32;
#pragma unroll 1
        for (int rr = 0; rr < 4; ++rr) {
            const int lr = wv * 4 + rr; const size_t row = (size_t)(row0 + lr);
            const unsigned long long* vr = (const unsigned long long*)(V + row * DM) + lane;
            v4f v[4]; float s = 0.f;
#pragma unroll
            for (int j = 0; j < 4; ++j) { const unsigned long long a = vr[64 * j];
                v[j].x = __uint_as_float((unsigned)a << 16); v[j].y = __uint_as_float((unsigned)a & 0xffff0000u);
                v[j].z = __uint_as_float((unsigned)(a >> 32) << 16); v[j].w = __uint_as_float((unsigned)(a >> 32) & 0xffff0000u);
                s += (v[j].x + v[j].y) + (v[j].z + v[j].w); }
            const float mu = wave_sum(s) * (1.f / DM); float q = 0.f;
#pragma unroll
            for (int j = 0; j < 4; ++j) { v[j] = v[j] - mu; q += (v[j].x * v[j].x + v[j].y * v[j].y) + (v[j].z * v[j].z + v[j].w * v[j].w); }
            const float rs = 1.f / sqrtf(wave_sum(q) * (1.f / DM) + LN_EPS);
            unsigned long long* o8 = (unsigned long long*)(x1b + row * DM) + lane;
#pragma unroll
            for (int j = 0; j < 4; ++j) { const v4f o = v[j] * rs * lw[j] + lb[j];
                const unsigned long long pk = (unsigned long long)pk2(o.x, o.y) | ((unsigned long long)pk2(o.z, o.w) << 32);
                o8[64 * j] = pk; *(LAS unsigned long long*)(xt + lr * XT_STRIDE + (256 * j + 4 * lane) * 2) = pk; }
        }
        __syncthreads();
        if (wv < 6) {
            const int mt = wv / 3, ntl = wv % 3;
            pg8::f32x4 acc = {0.f, 0.f, 0.f, 0.f};
            const LAS unsigned char* ap = xt + (mt * 16 + (lane & 15)) * XT_STRIDE + (lane >> 4) * 16;
            const bf16_t* bp = Wr + (size_t)(ntl * 16 + (lane & 15)) * DM + (lane >> 4) * 8;
#pragma unroll 8
            for (int ks = 0; ks < 32; ++ks) {
                const pg8::bf16x8 a = *(const LAS pg8::bf16x8*)(ap + ks * 64);
                const pg8::bf16x8 b = *(const pg8::bf16x8*)(bp + ks * 32);
                acc = __builtin_amdgcn_mfma_f32_16x16x32_bf16(a, b, acc, 0, 0, 0);
            }
#pragma unroll
            for (int j = 0; j < 4; ++j) lg[(mt * 16 + 4 * (lane >> 4) + j) * 48 + ntl * 16 + (lane & 15)] = acc[j];
        }
        __syncthreads();
        if (tid < 32) {
            const LAS float* l = lg + tid * 48; const int row = row0 + tid;
            float g[4]; int gi = 0;
#pragma unroll
            for (int j = 0; j < 4; ++j) g[j] = l[j] + p.b_gr[j];
            float gm = g[0];
#pragma unroll
            for (int j = 1; j < 4; ++j) if (g[j] > gm) { gm = g[j]; gi = j; }
            float gs = 0.f;
#pragma unroll
            for (int j = 0; j < 4; ++j) gs += expf(g[j] - gm);
            const float gp = 1.f / gs;
            float ev[8];
#pragma unroll
            for (int j = 0; j < 8; ++j) ev[j] = l[4 + gi * 8 + j] + p.b_er[gi * 8 + j];
            int i0 = 0; float v0 = ev[0];
#pragma unroll
            for (int j = 1; j < 8; ++j) if (ev[j] > v0) { v0 = ev[j]; i0 = j; }
            int i1 = -1; float v1 = -INFINITY;
#pragma unroll
            for (int j = 0; j < 8; ++j) if (j != i0 && ev[j] > v1) { v1 = ev[j]; i1 = j; }
            const float e1 = expf(v1 - v0); const float w0 = gp / (1.f + e1), w1 = gp * e1 / (1.f + e1);
            const int e_0 = gi * 8 + i0, e_1 = gi * 8 + i1;
            const int li0 = atomicAdd((int*)(lcnt + e_0), 1), li1 = atomicAdd((int*)(lcnt + e_1), 1);
            const int ri = atomicAdd((int*)recn, 2);
            rec_e[ri] = e_0; rec_li[ri] = li0; rec_v[ri] = row * 2; rec_w[ri] = w0;
            rec_e[ri + 1] = e_1; rec_li[ri + 1] = li1; rec_v[ri + 1] = row * 2 + 1; rec_w[ri + 1] = w1;
        }
        __syncthreads();
    }
    if (tid < 32) lbase[tid] = (int)atomicAdd(gcnt + tid, (unsigned)lcnt[tid]);
    __syncthreads();
    const int nrec = recn[0];
    for (int i = tid; i < nrec; i += 512) { const int e = rec_e[i]; const int pos = lbase[e] + rec_li[i]; slot_list[(size_t)e * T + pos] = rec_v[i]; w_list[(size_t)e * T + pos] = rec_w[i]; }
    __syncthreads();
}

constexpr int MOE_TAB_OFF = 131072;
__device__ __forceinline__ void moe_tables(const P& p, unsigned char* lds_g) {
    LAS int* tab = (LAS int*)((LAS unsigned char*)lds_g + MOE_TAB_OFF);
    const unsigned* gcnt = (const unsigned*)(p.ws + WS_CTL) + CW_GCNT;
    if (threadIdx.x == 0) { int acc = 0;
        for (int e = 0; e < NEXP; ++e) { const int c = (int)__hip_atomic_load(gcnt + e, __ATOMIC_RELAXED, __HIP_MEMORY_SCOPE_AGENT); tab[e] = acc; tab[33 + e] = c; acc += (c + 255) >> 8; }
        tab[32] = acc; }
    __syncthreads();
}
struct MoeOrder {
    const LAS int* tab; int nN, G, c;
    __device__ __forceinline__ bool next(int i, pg8::Unit& u) const {
        const int L = i * G + c; const int ntile = tab[32];
        if (L >= ntile * nN) return false;
        const int ti = L / nN; int e = 0;
#pragma unroll 1
        for (int k = 1; k < NEXP; ++k) e = (tab[k] <= ti) ? k : e;
        u.e = e; u.mt = ti - tab[e]; u.pm = ti; u.pn = L % nN; return true;
    }
};
struct ProbGU {
    const bf16_t* A; const bf16_t* Bt; int K; const LAS int* tab; const int* slot_list;
    __device__ __forceinline__ int a_row(const pg8::Unit& u, int r) const { const int idx = u.mt * 256 + r; return idx < tab[33 + u.e] ? (slot_list[(size_t)u.e * T + idx] >> 1) : 0; }
    __device__ __forceinline__ const char* b_tile(const pg8::Unit& u) const { return (const char*)(Bt + ((size_t)u.e * 512 + (size_t)u.pn * 256) * DM); }
};
struct EpiGU {
    static constexpr bool PERM = true;
    bf16_t* H; const LAS int* tab; const float* w_list;
    __device__ __forceinline__ void operator()(const pg8::f32x4 (&acc)[2][2][4][2], const pg8::Unit& u, int wr, int wc, int fr, int fq) const {
        const int r0 = wr * 64 + fr; const int cnt = tab[33 + u.e];
        float wrow[2][4];
#pragma unroll
        for (int ai = 0; ai < 2; ++ai)
#pragma unroll
            for (int m = 0; m < 4; ++m) { const int idx = u.mt * 256 + r0 + ai * 128 + m * 16; wrow[ai][m] = idx < cnt ? w_list[(size_t)u.e * T + idx] : 0.f; }
#pragma unroll
        for (int ai = 0; ai < 2; ++ai)
#pragma unroll
            for (int m = 0; m < 4; ++m) {
                bf16_t* hp = H + (size_t)(u.pm * 256 + r0 + ai * 128 + m * 16) * DEXP + u.pn * 128 + wc * 16 + 4 * fq;
#pragma unroll
                for (int bj = 0; bj < 2; ++bj) { const pg8::f32x4 g = acc[ai][bj][m][0], uu = acc[ai][bj][m][1]; float h[4];
#pragma unroll
                    for (int i = 0; i < 4; ++i) h[i] = g[i] * __builtin_amdgcn_rcpf(1.f + __expf(-g[i])) * uu[i] * wrow[ai][m];
                    pg8::u32x2 w; w.x = pg8::cvt_pk_bf16(h[0], h[1]); w.y = pg8::cvt_pk_bf16(h[2], h[3]);
                    *(pg8::u32x2*)(hp + bj * 64) = w; }
            }
    }
};
struct ProbDown {
    const bf16_t* A; const bf16_t* Bt; int K;
    __device__ __forceinline__ int a_row(const pg8::Unit& u, int r) const { return u.pm * 256 + r; }
    __device__ __forceinline__ const char* b_tile(const pg8::Unit& u) const { return (const char*)(Bt + ((size_t)u.e * DM + (size_t)u.pn * 256) * DEXP); }
};
struct EpiDown {
    static constexpr bool PERM = true;
    bf16_t* Y; const LAS int* tab; const int* slot_list;
    __device__ __forceinline__ void operator()(const pg8::f32x4 (&acc)[2][2][4][2], const pg8::Unit& u, int wr, int wc, int fr, int fq) const {
        const int r0 = wr * 64 + fr; const int cnt = tab[33 + u.e];
        int drow[2][4];
#pragma unroll
        for (int ai = 0; ai < 2; ++ai)
#pragma unroll
            for (int m = 0; m < 4; ++m) { const int idx = u.mt * 256 + r0 + ai * 128 + m * 16; drow[ai][m] = idx < cnt ? slot_list[(size_t)u.e * T + idx] : -1; }
#pragma unroll
        for (int ai = 0; ai < 2; ++ai)
#pragma unroll
            for (int m = 0; m < 4; ++m) if (drow[ai][m] >= 0) {
                bf16_t* yp = Y + (size_t)drow[ai][m] * DM + u.pn * 256 + wc * 32 + 8 * fq;
#pragma unroll
                for (int bj = 0; bj < 2; ++bj) { const pg8::f32x4 v0 = acc[ai][bj][m][0], v1 = acc[ai][bj][m][1];
                    pg8::u32x4 w; w.x = pg8::cvt_pk_bf16(v0[0], v0[1]); w.y = pg8::cvt_pk_bf16(v0[2], v0[3]); w.z = pg8::cvt_pk_bf16(v1[0], v1[1]); w.w = pg8::cvt_pk_bf16(v1[2], v1[3]);
                    *(pg8::u32x4*)(yp + bj * 128) = w; }
            }
    }
};
__device__ __forceinline__ void ph_moe_gu(const P& p, unsigned char* lds_g, int bid, int nb) {
    moe_tables(p, lds_g);
    const LAS int* tab = (const LAS int*)((LAS unsigned char*)lds_g + MOE_TAB_OFF);
    ProbGU G{(const bf16_t*)(p.ws + WS_X1B), (const bf16_t*)(p.ws + WS_WGU), DM, tab, (const int*)(p.ws + WS_SLOT)};
    MoeOrder S{tab, 2, nb, bid};
    EpiGU E{(bf16_t*)(p.ws + WS_H), tab, (const float*)(p.ws + WS_WLIST)};
    pg8::gemm_phase((PG8_LAS unsigned char*)lds_g, G, S, E);
}
__device__ __forceinline__ void ph_moe_down(const P& p, unsigned char* lds_g, int bid, int nb) {
    const LAS int* tab = (const LAS int*)((LAS unsigned char*)lds_g + MOE_TAB_OFF);
    ProbDown G{(const bf16_t*)(p.ws + WS_H), (const bf16_t*)(p.ws + WS_WD), DEXP};
    MoeOrder S{tab, 4, nb, bid};
    EpiDown E{(bf16_t*)(p.ws + WS_Y), tab, (const int*)(p.ws + WS_SLOT)};
    pg8::gemm_phase((PG8_LAS unsigned char*)lds_g, G, S, E);
}
__device__ __forceinline__ void ph_rowpass2(const P& p, int bid, int nb) {
    const int tid = threadIdx.x, lane = tid & 63, wv = tid >> 6;
    const bf16_t* x1b = (const bf16_t*)(p.ws + WS_X1B); const bf16_t* Y = (const bf16_t*)(p.ws + WS_Y);
    v4f lw[4], lb[4];
#pragma unroll
    for (int j = 0; j < 4; ++j) { lw[j] = *((const v4f*)p.ln2_w + lane + 64 * j); lb[j] = *((const v4f*)p.ln2_b + lane + 64 * j); }
    for (int row = bid * 8 + wv; row < T; row += nb * 8) {
        const unsigned long long* xr = (const unsigned long long*)(x1b + (size_t)row * DM) + lane;
        const unsigned long long* y0 = (const unsigned long long*)(Y + (size_t)row * 2 * DM) + lane;
        const unsigned long long* y1 = y0 + DM / 4;
        v4f v[4]; float s = 0.f;
#pragma unroll
        for (int j = 0; j < 4; ++j) { const unsigned long long a = xr[64 * j], b = y0[64 * j], c = y1[64 * j];
            v[j].x = ALPHA * __uint_as_float((unsigned)a << 16) + __uint_as_float((unsigned)b << 16) + __uint_as_float((unsigned)c << 16);
            v[j].y = ALPHA * __uint_as_float((unsigned)a & 0xffff0000u) + __uint_as_float((unsigned)b & 0xffff0000u) + __uint_as_float((unsigned)c & 0xffff0000u);
            v[j].z = ALPHA * __uint_as_float((unsigned)(a >> 32) << 16) + __uint_as_float((unsigned)(b >> 32) << 16) + __uint_as_float((unsigned)(c >> 32) << 16);
            v[j].w = ALPHA * __uint_as_float((unsigned)(a >> 32) & 0xffff0000u) + __uint_as_float((unsigned)(b >> 32) & 0xffff0000u) + __uint_as_float((unsigned)(c >> 32) & 0xffff0000u);
            s += (v[j].x + v[j].y) + (v[j].z + v[j].w); }
        const float mu = wave_sum(s) * (1.f / DM); float q = 0.f;
#pragma unroll
        for (int j = 0; j < 4; ++j) { v[j] = v[j] - mu; q += (v[j].x * v[j].x + v[j].y * v[j].y) + (v[j].z * v[j].z + v[j].w * v[j].w); }
        const float rs = 1.f / sqrtf(wave_sum(q) * (1.f / DM) + LN_EPS);
        v4f* o = (v4f*)(p.out + (size_t)row * DM) + lane;
#pragma unroll
        for (int j = 0; j < 4; ++j) o[64 * j] = v[j] * rs * lw[j] + lb[j];
    }
}

typedef float f32x16 __attribute__((ext_vector_type(16)));
typedef unsigned u32x2_t __attribute__((ext_vector_type(2)));
__device__ __forceinline__ void ph_swa(const P& p, unsigned char* lds_g, int bid, int nb) {
    int tid = threadIdx.x; asm volatile("" : "+v"(tid));
    const int lane = tid & 63, wv = __builtin_amdgcn_readfirstlane(tid >> 6);
    const int g = wv & 3, hf = wv >> 2, r32 = lane & 31, hi = lane >> 5;
    LAS unsigned char* Ks = (LAS unsigned char*)lds_g;
    LAS unsigned char* Vt = Ks + 256 * 144;
    const bf16_t* proj = (const bf16_t*)(p.ws + WS_PROJ); bf16_t* mix = (bf16_t*)(p.ws + WS_MIX);
    constexpr float LOG2E = 1.4426950408889634f, SC = 0.125f * LOG2E;
    for (int unit = bid; unit < BATCH * AKH * (SEQ / 128); unit += nb) {
        const int b = unit / (AKH * 64), rem = unit % (AKH * 64), kvh = rem / 64, blk = rem % 64, q0 = blk * 128;
#pragma unroll
        for (int i = 0; i < 4; ++i) {
            const int c = tid + 512 * i, wl = c >> 3, ch = c & 7, pos = q0 - 128 + wl;
            v4u kv = {0u, 0u, 0u, 0u}, vv = {0u, 0u, 0u, 0u};
            if (pos >= 0) { const bf16_t* rp = proj + (size_t)(b * SEQ + pos) * NV + kvh * 64 + ch * 8; kv = *(const v4u*)(rp + PC_AK); vv = *(const v4u*)(rp + PC_AV); }
            *(LAS v4u*)(Ks + wl * 144 + ch * 16) = kv;
#pragma unroll
            for (int j = 0; j < 8; ++j) *(LAS unsigned short*)(Vt + (ch * 8 + j) * 520 + wl * 2) = (unsigned short)(vv[j >> 1] >> (16 * (j & 1)));
        }
        __syncthreads();
        const int hq = kvh * 4 + g; const float sink2 = p.sinks[hq] * LOG2E;
#pragma unroll 1
        for (int i = 0; i < 2; ++i) {
            const size_t row = (size_t)(b * SEQ + q0 + 64 * hf + 32 * i + r32);
            pg8::bf16x8 qf[4];
#pragma unroll
            for (int ks = 0; ks < 4; ++ks) qf[ks] = *(const pg8::bf16x8*)(proj + row * NV + PC_AQ + hq * 64 + 16 * ks + 8 * hi);
            const int t0 = 2 * hf + i;
            f32x16 sacc[5];
#pragma unroll
            for (int kt = 0; kt < 5; ++kt) {
                f32x16 acc = {0.f, 0.f, 0.f, 0.f, 0.f, 0.f, 0.f, 0.f, 0.f, 0.f, 0.f, 0.f, 0.f, 0.f, 0.f, 0.f};
                const LAS unsigned char* kp = Ks + (32 * (t0 + kt) + r32) * 144 + 16 * hi;
#pragma unroll
                for (int ks = 0; ks < 4; ++ks) acc = __builtin_amdgcn_mfma_f32_32x32x16_bf16(*(const LAS pg8::bf16x8*)(kp + 32 * ks), qf[ks], acc, 0, 0, 0);
                sacc[kt] = acc;
            }
            float m2 = sink2;
#pragma unroll
            for (int kt = 0; kt < 5; ++kt) {
                const bool tvalid = (blk > 0) || (t0 + kt >= 4);
#pragma unroll
                for (int r = 0; r < 16; ++r) {
                    const int kc = (r & 3) + 8 * (r >> 2) + 4 * hi;
                    bool ok = tvalid;
                    if (kt == 0) ok = ok && (kc > r32);
                    if (kt == 4) ok = ok && (kc <= r32);
                    const float s = ok ? sacc[kt][r] * SC : -INFINITY;
                    sacc[kt][r] = s; m2 = fmaxf(m2, s);
                }
            }
            m2 = fmaxf(m2, __shfl_xor(m2, 32));
            float l = 0.f;
#pragma unroll
            for (int kt = 0; kt < 5; ++kt)
#pragma unroll
                for (int r = 0; r < 16; ++r) { const float e = __builtin_amdgcn_exp2f(sacc[kt][r] - m2); sacc[kt][r] = e; l += e; }
            l += __shfl_xor(l, 32); l += __builtin_amdgcn_exp2f(sink2 - m2);
            f32x16 o[2];
            o[0] = (f32x16){0.f, 0.f, 0.f, 0.f, 0.f, 0.f, 0.f, 0.f, 0.f, 0.f, 0.f, 0.f, 0.f, 0.f, 0.f, 0.f}; o[1] = o[0];
#pragma unroll
            for (int kt = 0; kt < 5; ++kt)
#pragma unroll
                for (int s2 = 0; s2 < 2; ++s2) {
                    v4u pw; pw.x = pg8::cvt_pk_bf16(sacc[kt][8 * s2 + 0], sacc[kt][8 * s2 + 1]); pw.y = pg8::cvt_pk_bf16(sacc[kt][8 * s2 + 2], sacc[kt][8 * s2 + 3]);
                    pw.z = pg8::cvt_pk_bf16(sacc[kt][8 * s2 + 4], sacc[kt][8 * s2 + 5]); pw.w = pg8::cvt_pk_bf16(sacc[kt][8 * s2 + 6], sacc[kt][8 * s2 + 7]);
                    const pg8::bf16x8 pf = __builtin_bit_cast(pg8::bf16x8, pw);
#pragma unroll
                    for (int dt = 0; dt < 2; ++dt) {
                        const LAS unsigned char* vp = Vt + (32 * dt + r32) * 520 + (32 * (t0 + kt) + 16 * s2 + 4 * hi) * 2;
                        const u32x2_t c1 = *(const LAS u32x2_t*)vp, c2 = *(const LAS u32x2_t*)(vp + 16);
                        v4u vw; vw.x = c1.x; vw.y = c1.y; vw.z = c2.x; vw.w = c2.y;
                        o[dt] = __builtin_amdgcn_mfma_f32_32x32x16_bf16(__builtin_bit_cast(pg8::bf16x8, vw), pf, o[dt], 0, 0, 0);
                    }
                }
            const float inv = 1.f / l;
            bf16_t* op = mix + row * DM + 512 + hq * 64 + 4 * hi;
#pragma unroll
            for (int dt = 0; dt < 2; ++dt)
#pragma unroll
                for (int r4 = 0; r4 < 4; ++r4) {
                    u32x2_t w; w.x = pg8::cvt_pk_bf16(o[dt][4 * r4] * inv, o[dt][4 * r4 + 1] * inv); w.y = pg8::cvt_pk_bf16(o[dt][4 * r4 + 2] * inv, o[dt][4 * r4 + 3] * inv);
                    *(u32x2_t*)(op + 32 * dt + 8 * r4) = w;
                }
        }
        __syncthreads();
    }
}

constexpr size_t WS_QKC = WS_X1B;
constexpr size_t WS_DC = WS_H;
constexpr size_t WS_DN = 336 * MiB, WS_NST = WS_DN + 512 * 1024, WS_SCAL = WS_NST + 512 * 1024;
constexpr int KT_STRIDE = 272;

__device__ __forceinline__ float scan_add64(float v, int lane) {
#pragma unroll
    for (int o = 1; o < 64; o <<= 1) { const float t = __shfl_up(v, o); v = (lane >= o) ? v + t : v; }
    return v;
}
__device__ __forceinline__ float scan_max64(float v, int lane) {
#pragma unroll
    for (int o = 1; o < 64; o <<= 1) { const float t = __shfl_up(v, o); v = (lane >= o) ? fmaxf(v, t) : v; }
    return v;
}
__device__ __forceinline__ void gate_scan(const float* gates, size_t row0, int h, int lane, float& b0, float& b1, float& a0, float& a1) {
    const float* g0 = gates + (row0 + 2 * lane) * 8; const float* g1 = g0 + 8;
    const float i0 = g0[h], i1 = g1[h], lf0 = logsigmoid_f(g0[4 + h]), lf1 = logsigmoid_f(g1[4 + h]);
    const float pair = lf0 + lf1, incl = scan_add64(pair, lane), excl = incl - pair;
    b0 = excl + lf0; b1 = incl; a0 = i0 - b0; a1 = i1 - b1;
}
template <int WHICH>
__device__ __forceinline__ void conv_stage(const P& p, const bf16_t* proj, bf16_t* qkc, LAS unsigned char* Kt, int b, int h, int chunk, int cc, int tg) {
    const int colb = WHICH * 512 + h * 128 + cc * 8;
    float w[4][8], bias[8];
#pragma unroll
    for (int j = 0; j < 4; ++j) { const v4f w0 = *(const v4f*)(p.conv_w + j * 1024 + colb), w1 = *(const v4f*)(p.conv_w + j * 1024 + colb + 4);
        w[j][0] = w0.x; w[j][1] = w0.y; w[j][2] = w0.z; w[j][3] = w0.w; w[j][4] = w1.x; w[j][5] = w1.y; w[j][6] = w1.z; w[j][7] = w1.w; }
    { const v4f b0 = *(const v4f*)(p.conv_b + colb), b1 = *(const v4f*)(p.conv_b + colb + 4);
      bias[0] = b0.x; bias[1] = b0.y; bias[2] = b0.z; bias[3] = b0.w; bias[4] = b1.x; bias[5] = b1.y; bias[6] = b1.z; bias[7] = b1.w; }
    v4u u[7];
#pragma unroll
    for (int rr = 0; rr < 7; ++rr) { const int t = chunk * 128 + 4 * tg - 3 + rr;
        u[rr] = (v4u){0u, 0u, 0u, 0u};
        if (t >= 0) u[rr] = *(const v4u*)(proj + (size_t)(b * SEQ + t) * NV + colb); }
#pragma unroll
    for (int tt = 0; tt < 4; ++tt) {
        float o[8];
#pragma unroll
        for (int c = 0; c < 8; ++c) o[c] = bias[c];
#pragma unroll
        for (int j = 0; j < 4; ++j)
#pragma unroll
            for (int c = 0; c < 8; ++c) { const unsigned wd = u[tt + j][c >> 1]; const float uv = __uint_as_float((c & 1) ? (wd & 0xffff0000u) : (wd << 16)); o[c] += w[j][c] * uv; }
#pragma unroll
        for (int c = 0; c < 8; ++c) { o[c] = fsilu(o[c]); if (WHICH) o[c] *= 0.08838834764831845f; }
        v4u pk; pk.x = pk2(o[0], o[1]); pk.y = pk2(o[2], o[3]); pk.z = pk2(o[4], o[5]); pk.w = pk2(o[6], o[7]);
        const int tok = 4 * tg + tt;
        *(v4u*)(qkc + (size_t)(b * SEQ + chunk * 128 + tok) * DM + colb) = pk;
        if (WHICH) {
#pragma unroll
            for (int c = 0; c < 8; ++c) *(LAS unsigned short*)(Kt + (cc * 8 + c) * KT_STRIDE + tok * 2) = (unsigned short)(pk[c >> 1] >> (16 * (c & 1)));
        }
    }
}

constexpr int A1_HALF_BYTES = 2 * 128 * KT_STRIDE + 512;
__device__ __forceinline__ void ph_mlstm_a1(const P& p, unsigned char* lds_g, int bid, int nb) {
    int tid = threadIdx.x; asm volatile("" : "+v"(tid));
    const int lane = tid & 63, wv = __builtin_amdgcn_readfirstlane(tid >> 6), r32 = lane & 31, hi = lane >> 5;
    const int half = wv >> 2, hw = wv & 3, htid = tid & 255;
    LAS unsigned char* Kt = (LAS unsigned char*)lds_g + half * A1_HALF_BYTES;
    LAS unsigned char* Vt = Kt + 128 * KT_STRIDE;
    LAS float* wsh = (LAS float*)(Vt + 128 * KT_STRIDE);
    const bf16_t* proj = (const bf16_t*)(p.ws + WS_PROJ); const float* gates = (const float*)(p.ws + WS_GATES);
    bf16_t* qkc = (bf16_t*)(p.ws + WS_QKC); bf16_t* dC = (bf16_t*)(p.ws + WS_DC);
    float* dn = (float*)(p.ws + WS_DN); float* scal = (float*)(p.ws + WS_SCAL);
    for (int it0 = bid * 2; it0 < BATCH * MLH * 64; it0 += nb * 2) {
        const int item = it0 + half;
        const int bh = item >> 6, chunk = item & 63, b = bh >> 2, h = bh & 3; const size_t row0 = (size_t)b * SEQ + chunk * 128;
        if (hw == 0) {
            float b0, b1, a0, a1; gate_scan(gates, row0, h, lane, b0, b1, a0, a1);
            const float amax = wave_max(fmaxf(a0, a1)); const float blast = __shfl(b1, 63);
            wsh[2 * lane] = expf(a0 - amax); wsh[2 * lane + 1] = expf(a1 - amax);
            if (lane == 0) { scal[bh * 64 + chunk] = blast + amax; scal[1024 + bh * 64 + chunk] = blast; }
        }
#pragma unroll 1
        for (int tq = 0; tq < 2; ++tq) {
            conv_stage<0>(p, proj, qkc, Kt, b, h, chunk, htid & 15, (htid >> 4) + 16 * tq);
            conv_stage<1>(p, proj, qkc, Kt, b, h, chunk, htid & 15, (htid >> 4) + 16 * tq);
        }
        __syncthreads();
#pragma unroll
        for (int i = 0; i < 8; ++i) { const int idx = htid + 256 * i, s = idx >> 4, ec = idx & 15;
            const v4u vv = *(const v4u*)(proj + (row0 + s) * NV + PC_MV + h * 128 + ec * 8); const float ws = wsh[s];
#pragma unroll
            for (int j2 = 0; j2 < 4; ++j2) { const unsigned wd = vv[j2]; const unsigned pk = pk2(__uint_as_float(wd << 16) * ws, __uint_as_float(wd & 0xffff0000u) * ws);
                *(LAS unsigned short*)(Vt + (ec * 8 + 2 * j2) * KT_STRIDE + s * 2) = (unsigned short)pk; *(LAS unsigned short*)(Vt + (ec * 8 + 2 * j2 + 1) * KT_STRIDE + s * 2) = (unsigned short)(pk >> 16); } }
        __syncthreads();
        {
            f32x16 acc[4];
#pragma unroll
            for (int j = 0; j < 4; ++j) acc[j] = (f32x16){0.f, 0.f, 0.f, 0.f, 0.f, 0.f, 0.f, 0.f, 0.f, 0.f, 0.f, 0.f, 0.f, 0.f, 0.f, 0.f};
            const LAS unsigned char* ap = Vt + (32 * hw + r32) * KT_STRIDE + 16 * hi;
#pragma unroll
            for (int ks = 0; ks < 8; ++ks) { const pg8::bf16x8 a = *(const LAS pg8::bf16x8*)(ap + 32 * ks);
#pragma unroll
                for (int j = 0; j < 4; ++j) {
                    const pg8::bf16x8 bb = *(const LAS pg8::bf16x8*)(Kt + (32 * j + r32) * KT_STRIDE + 16 * hi + 32 * ks);
                    acc[j] = __builtin_amdgcn_mfma_f32_32x32x16_bf16(a, bb, acc[j], 0, 0, 0); } }
            bf16_t* out = dC + ((size_t)item * 128) * 128;
#pragma unroll
            for (int j = 0; j < 4; ++j)
#pragma unroll
                for (int r = 0; r < 16; r += 2) { const int e = 32 * hw + (r & 3) + 8 * (r >> 2) + 4 * hi; const unsigned pk = pk2(acc[j][r], acc[j][r + 1]);
                    out[(size_t)e * 128 + 32 * j + r32] = (bf16_t)pk; out[(size_t)(e + 1) * 128 + 32 * j + r32] = (bf16_t)(pk >> 16); }
        }
        if (htid < 128) {
            float a = 0.f; const LAS unsigned char* kp = Kt + htid * KT_STRIDE;
            for (int s8 = 0; s8 < 16; ++s8) { const v4u kk = *(const LAS v4u*)(kp + s8 * 16);
#pragma unroll
                for (int j = 0; j < 8; ++j) { const unsigned wd = kk[j >> 1]; a += __uint_as_float((j & 1) ? (wd & 0xffff0000u) : (wd << 16)) * wsh[s8 * 8 + j]; } }
            dn[(size_t)item * 128 + htid] = a;
        }
        __syncthreads();
    }
}

__device__ __forceinline__ void ph_mlstm_a2(const P& p, unsigned char* lds_g, int bid, int nb) {
    const int tid = threadIdx.x;
    LAS float* dec = (LAS float*)lds_g; LAS float* gg = dec + 64;
    const bf16_t* dC = (const bf16_t*)(p.ws + WS_DC); bf16_t* Cst = (bf16_t*)(p.ws + WS_CST);
    const float* dn = (const float*)(p.ws + WS_DN); float* nst = (float*)(p.ws + WS_NST); float* scal = (float*)(p.ws + WS_SCAL);
    for (int it = bid; it < 256; it += nb) {
        const int bh = it >> 4, part = it & 15;
        if (tid == 0) { float m = 0.f;
            for (int k = 0; k < 64; ++k) { const float al = scal[bh * 64 + k], bl = scal[1024 + bh * 64 + k]; const float mn = fmaxf(bl + m, al);
                dec[k] = expf(bl + m - mn); gg[k] = expf(al - mn); if (part == 0) scal[2048 + bh * 64 + k] = m; m = mn; } }
        __syncthreads();
        {
            const size_t eoff = (size_t)part * 1024 + 2 * tid;
            const unsigned* src = (const unsigned*)(dC + (size_t)bh * 64 * 16384 + eoff); unsigned* dst = (unsigned*)(Cst + (size_t)bh * 64 * 16384 + eoff);
            float c0 = 0.f, c1 = 0.f;
#pragma unroll 8
            for (int k = 0; k < 64; ++k) { const unsigned d = src[(size_t)k * 8192];
                dst[(size_t)k * 8192] = pk2(c0, c1);
                c0 = dec[k] * c0 + gg[k] * __uint_as_float(d << 16); c1 = dec[k] * c1 + gg[k] * __uint_as_float(d & 0xffff0000u); }
        }
        if (part == 0 && tid < 128) { float n = 0.f;
            for (int k = 0; k < 64; ++k) { nst[((size_t)bh * 64 + k) * 128 + tid] = n; n = dec[k] * n + gg[k] * dn[((size_t)bh * 64 + k) * 128 + tid]; } }
        __syncthreads();
    }
}

constexpr int VT_STRIDE = 264;
constexpr int B_HALF_BYTES = 128 * KT_STRIDE + 128 * VT_STRIDE + 2048;
__device__ __forceinline__ void ph_mlstm_b(const P& p, unsigned char* lds_g, int bid, int nb) {
    int tid = threadIdx.x; asm volatile("" : "+v"(tid));
    const int lane = tid & 63, wv = __builtin_amdgcn_readfirstlane(tid >> 6), r32 = lane & 31, hi = lane >> 5;
    const int half = wv >> 2, lt = wv & 3, htid = tid & 255;
    LAS unsigned char* Ks = (LAS unsigned char*)lds_g + half * B_HALF_BYTES;
    LAS unsigned char* Vt = Ks + 128 * KT_STRIDE;
    LAS float* a2s = (LAS float*)(Vt + 128 * VT_STRIDE);
    LAS float* M2s = a2s + 128;
    LAS float* wis = M2s + 128;
    LAS float* ems = wis + 128;
    const bf16_t* proj = (const bf16_t*)(p.ws + WS_PROJ); const float* gates = (const float*)(p.ws + WS_GATES);
    const bf16_t* qkc = (const bf16_t*)(p.ws + WS_QKC); const bf16_t* Cst = (const bf16_t*)(p.ws + WS_CST);
    const float* nst = (const float*)(p.ws + WS_NST); const float* scal = (const float*)(p.ws + WS_SCAL);
    bf16_t* mix = (bf16_t*)(p.ws + WS_MIX);
    constexpr float LOG2E = 1.4426950408889634f;
    for (int it0 = bid * 2; it0 < BATCH * MLH * 64; it0 += nb * 2) {
        const int item = it0 + half;
        const int bh = item >> 6, chunk = item & 63, b = bh >> 2, h = bh & 3; const size_t row0 = (size_t)b * SEQ + chunk * 128;
        const float mk = scal[2048 + bh * 64 + chunk];
        if (lt == 0) {
            float b0, b1, a0, a1; gate_scan(gates, row0, h, lane, b0, b1, a0, a1);
            const float incl = scan_max64(fmaxf(a0, a1), lane); float excl = __shfl_up(incl, 1); if (lane == 0) excl = -INFINITY;
            const float M0 = fmaxf(mk, fmaxf(excl, a0)), M1 = fmaxf(mk, incl);
            a2s[2 * lane] = a0 * LOG2E; a2s[2 * lane + 1] = a1 * LOG2E; M2s[2 * lane] = M0 * LOG2E; M2s[2 * lane + 1] = M1 * LOG2E;
            wis[2 * lane] = expf(mk - M0); wis[2 * lane + 1] = expf(mk - M1); ems[2 * lane] = expf(-b0 - M0); ems[2 * lane + 1] = expf(-b1 - M1);
        }
#pragma unroll
        for (int i = 0; i < 8; ++i) { const int idx = htid + 256 * i, s = idx >> 4, ch = idx & 15;
            *(LAS v4u*)(Ks + s * KT_STRIDE + ch * 16) = *(const v4u*)(qkc + (row0 + s) * DM + 512 + h * 128 + ch * 8);
            const v4u vv = *(const v4u*)(proj + (row0 + s) * NV + PC_MV + h * 128 + ch * 8);
#pragma unroll
            for (int j = 0; j < 8; ++j) *(LAS unsigned short*)(Vt + (ch * 8 + j) * VT_STRIDE + s * 2) = (unsigned short)(vv[j >> 1] >> (16 * (j & 1))); }
        const int l = 32 * lt + r32; const size_t row = row0 + l;
        pg8::bf16x8 qf[8];
#pragma unroll
        for (int ks = 0; ks < 8; ++ks) qf[ks] = *(const pg8::bf16x8*)(qkc + row * DM + h * 128 + 16 * ks + 8 * hi);
        f32x16 acc[4];
#pragma unroll
        for (int j = 0; j < 4; ++j) acc[j] = (f32x16){0.f, 0.f, 0.f, 0.f, 0.f, 0.f, 0.f, 0.f, 0.f, 0.f, 0.f, 0.f, 0.f, 0.f, 0.f, 0.f};
        float dq = 0.f;
        {
            const bf16_t* Cb = Cst + (size_t)item * 16384; const float* nb_ = nst + (size_t)item * 128;
#pragma unroll
            for (int ks = 0; ks < 8; ++ks) {
#pragma unroll
                for (int j = 0; j < 4; ++j) {
                    const pg8::bf16x8 cf = *(const pg8::bf16x8*)(Cb + (size_t)(32 * j + r32) * 128 + 16 * ks + 8 * hi);
                    acc[j] = __builtin_amdgcn_mfma_f32_32x32x16_bf16(cf, qf[ks], acc[j], 0, 0, 0); }
                const v4f n0 = *(const v4f*)(nb_ + 16 * ks + 8 * hi), n1 = *(const v4f*)(nb_ + 16 * ks + 8 * hi + 4);
                const v4u qw = __builtin_bit_cast(v4u, qf[ks]);
                dq += n0.x * __uint_as_float(qw.x << 16) + n0.y * __uint_as_float(qw.x & 0xffff0000u) + n0.z * __uint_as_float(qw.y << 16) + n0.w * __uint_as_float(qw.y & 0xffff0000u)
                    + n1.x * __uint_as_float(qw.z << 16) + n1.y * __uint_as_float(qw.z & 0xffff0000u) + n1.z * __uint_as_float(qw.w << 16) + n1.w * __uint_as_float(qw.w & 0xffff0000u);
            }
            dq += __shfl_xor(dq, 32);
        }
        __syncthreads();
        const float M2 = M2s[l], wint = wis[l], emr = ems[l];
#pragma unroll
        for (int j = 0; j < 4; ++j)
#pragma unroll
            for (int r = 0; r < 16; ++r) acc[j][r] *= wint;
        float ssum = 0.f;
#pragma unroll 1
        for (int st = 0; st <= lt; ++st) {
            f32x16 sa = {0.f, 0.f, 0.f, 0.f, 0.f, 0.f, 0.f, 0.f, 0.f, 0.f, 0.f, 0.f, 0.f, 0.f, 0.f, 0.f};
            const LAS unsigned char* kp = Ks + (32 * st + r32) * KT_STRIDE + 16 * hi;
#pragma unroll
            for (int ks = 0; ks < 8; ++ks) sa = __builtin_amdgcn_mfma_f32_32x32x16_bf16(*(const LAS pg8::bf16x8*)(kp + 32 * ks), qf[ks], sa, 0, 0, 0);
#pragma unroll
            for (int r4 = 0; r4 < 4; ++r4) { const v4f av = *(const LAS v4f*)(a2s + 32 * st + 8 * r4 + 4 * hi);
#pragma unroll
                for (int q = 0; q < 4; ++q) { const int s = 32 * st + 8 * r4 + 4 * hi + q;
                    const float wgt = (s <= l) ? __builtin_amdgcn_exp2f(av[q] - M2) : 0.f; const float sw = sa[4 * r4 + q] * wgt; sa[4 * r4 + q] = sw; ssum += sw; } }
#pragma unroll
            for (int s2 = 0; s2 < 2; ++s2) {
                v4u pw; pw.x = pg8::cvt_pk_bf16(sa[8 * s2 + 0], sa[8 * s2 + 1]); pw.y = pg8::cvt_pk_bf16(sa[8 * s2 + 2], sa[8 * s2 + 3]);
                pw.z = pg8::cvt_pk_bf16(sa[8 * s2 + 4], sa[8 * s2 + 5]); pw.w = pg8::cvt_pk_bf16(sa[8 * s2 + 6], sa[8 * s2 + 7]);
                const pg8::bf16x8 pf = __builtin_bit_cast(pg8::bf16x8, pw);
#pragma unroll
                for (int j = 0; j < 4; ++j) {
                    const LAS unsigned char* vp = Vt + (32 * j + r32) * VT_STRIDE + (32 * st + 16 * s2 + 4 * hi) * 2;
                    const u32x2_t c1 = *(const LAS u32x2_t*)vp, c2 = *(const LAS u32x2_t*)(vp + 16);
                    v4u vw; vw.x = c1.x; vw.y = c1.y; vw.z = c2.x; vw.w = c2.y;
                    acc[j] = __builtin_amdgcn_mfma_f32_32x32x16_bf16(__builtin_bit_cast(pg8::bf16x8, vw), pf, acc[j], 0, 0, 0);
                }
            }
        }
        ssum += __shfl_xor(ssum, 32);
        const float den = wint * dq + ssum; const float inv = 1.f / fmaxf(fabsf(den), emr);
        float s1 = 0.f;
#pragma unroll
        for (int j = 0; j < 4; ++j)
#pragma unroll
            for (int r = 0; r < 16; ++r) { const float hv = acc[j][r] * inv; acc[j][r] = hv; s1 += hv; }
        s1 += __shfl_xor(s1, 32);
        const float mu = s1 * (1.f / 128.f); float s2q = 0.f;
#pragma unroll
        for (int j = 0; j < 4; ++j)
#pragma unroll
            for (int r = 0; r < 16; ++r) { const float dv = acc[j][r] - mu; acc[j][r] = dv; s2q += dv * dv; }
        s2q += __shfl_xor(s2q, 32);
        const float rs = 1.f / sqrtf(s2q * (1.f / 128.f) + LN_EPS);
#pragma unroll
        for (int j = 0; j < 4; ++j)
#pragma unroll
            for (int r4 = 0; r4 < 4; ++r4) { const int e0 = 32 * j + 8 * r4 + 4 * hi;
                const u32x2_t ow = *(const u32x2_t*)(proj + row * NV + PC_MO + h * 128 + e0); const v4f nw = *(const v4f*)(p.norm_w + h * 128 + e0);
                const float o0 = __uint_as_float(ow.x << 16), o1 = __uint_as_float(ow.x & 0xffff0000u), o2 = __uint_as_float(ow.y << 16), o3 = __uint_as_float(ow.y & 0xffff0000u);
                const float y0 = fsigmoid(o0) * acc[j][4 * r4] * rs * nw.x, y1 = fsigmoid(o1) * acc[j][4 * r4 + 1] * rs * nw.y;
                const float y2 = fsigmoid(o2) * acc[j][4 * r4 + 2] * rs * nw.z, y3 = fsigmoid(o3) * acc[j][4 * r4 + 3] * rs * nw.w;
                u32x2_t w; w.x = pg8::cvt_pk_bf16(y0, y1); w.y = pg8::cvt_pk_bf16(y2, y3);
                *(u32x2_t*)(mix + row * DM + h * 128 + e0) = w; }
        __syncthreads();
    }
}
#define GAS __attribute__((address_space(1)))
#define XB_TMO      128
#define XB_XCNT(j)  (256  + 64 * (j))
#define XB_XSUB(j)  (1280 + 64 * (j))
#define XB_XGEN(j)  (2304 + 64 * (j))
#define XB_TOP      3328
#define XB_TOPGEN   3392
#define XCD_BAR_WORDS 3456
#define XB_SPIN_CAP (1u << 18)

__device__ __forceinline__ unsigned xb_ld(unsigned* p)              { return __hip_atomic_load(p, __ATOMIC_RELAXED, __HIP_MEMORY_SCOPE_AGENT); }
__device__ __forceinline__ unsigned xb_add(unsigned* p, unsigned v) { return __hip_atomic_fetch_add(p, v, __ATOMIC_RELAXED, __HIP_MEMORY_SCOPE_AGENT); }
__device__ __forceinline__ unsigned xb_xcc_id() { return (unsigned)__builtin_amdgcn_s_getreg((3 << 11) | 20) & 0xFu; }
#define XB_SPIN(cond, bar) do { unsigned _sp = 0; while (cond) { __builtin_amdgcn_s_sleep(1); \
    if ((++_sp & 255u) == 0u) { if (xb_ld(&(bar)[XB_TMO])) break; if (_sp > XB_SPIN_CAP) { atomicAdd(&(bar)[XB_TMO], 1u); break; } } } } while (0)

struct XcdBarrier {
    unsigned* bar; unsigned x;
    volatile LAS unsigned* st;
};

__device__ __forceinline__ XcdBarrier xcd_barrier_post(unsigned* bar, volatile LAS unsigned* st) {
    XcdBarrier b; b.bar = bar; b.x = xb_xcc_id(); b.st = st;
    if (threadIdx.x == 0) (void)xb_add(&bar[XB_XCNT(b.x)], 1u);
    return b;
}
__device__ __forceinline__ void xcd_barrier_complete(unsigned* bar, unsigned x, unsigned& nloc, unsigned& nx) {
    const unsigned G = gridDim.x * gridDim.y * gridDim.z;
    unsigned sum, cnt, mine, sp = 0u;
    for (;;) {
        sum = 0u; cnt = 0u; mine = 0u;
#pragma unroll
        for (unsigned j = 0; j < 16; ++j) { const unsigned c = xb_ld(&bar[XB_XCNT(j)]); sum += c; cnt += (c > 0u) ? 1u : 0u; mine = (j == x) ? c : mine; }
        if (sum == G) break;
        __builtin_amdgcn_s_sleep(1);
        if ((++sp & 255u) == 0u) { if (xb_ld(&bar[XB_TMO])) break; if (sp > XB_SPIN_CAP) { atomicAdd(&bar[XB_TMO], 1u); break; } }
    }
    nloc = mine > 0u ? mine : 1u; nx = cnt > 0u ? cnt : 1u;
}

__device__ __forceinline__ void xcd_barrier(const XcdBarrier& b) {
    asm volatile("s_waitcnt vmcnt(0)" ::: "memory");
    __syncthreads();
    if (threadIdx.x == 0) {
        unsigned* bar = b.bar;
        __builtin_amdgcn_s_waitcnt(0);
        unsigned nloc = b.st[0], nx = b.st[1];
        if (nloc == 0u) { xcd_barrier_complete(bar, b.x, nloc, nx); b.st[0] = nloc; b.st[1] = nx; }
        const unsigned old = xb_add(&bar[XB_XSUB(b.x)], 1u);
        const unsigned gen = old / nloc;
        if (old + 1u == (gen + 1u) * nloc) {
            __builtin_amdgcn_fence(__ATOMIC_RELEASE, "agent");
            asm volatile("s_waitcnt vmcnt(0)" ::: "memory");
            const unsigned og = xb_add(&bar[XB_TOP], 1u);
            const unsigned tg = og / nx;
            if (og + 1u == (tg + 1u) * nx) xb_add(&bar[XB_TOPGEN], 1u);
            else XB_SPIN(xb_ld(&bar[XB_TOPGEN]) == tg, bar);
            __builtin_amdgcn_fence(__ATOMIC_ACQUIRE, "agent");
            xb_add(&bar[XB_XGEN(b.x)], 1u);
            asm volatile("s_waitcnt vmcnt(0)" ::: "memory");
        } else {
            XB_SPIN(xb_ld(&bar[XB_XGEN(b.x)]) == gen, bar);
            __builtin_amdgcn_fence(__ATOMIC_ACQUIRE, "agent");
            asm volatile("s_waitcnt vmcnt(0)" ::: "memory");
        }
    }
    __syncthreads();
}

extern __shared__ __attribute__((aligned(16))) unsigned char g_lds[];
constexpr int BAR_ST_OFF = 147456 - 64;
constexpr int CW_BAR = 4096;
constexpr size_t CTL_ZERO_BYTES = 65536;
constexpr int LDS_BYTES = 147456;
#ifndef PROBE_DUP
#define PROBE_DUP -1
#endif
#define RUN(k, call) do { call; if (PROBE_DUP == (k)) { __syncthreads(); call; } } while (0);
__global__ void __launch_bounds__(512, 2) mega_fwd(P p) {
    cg::grid_group grid = cg::this_grid();
    const int bid = blockIdx.x, nb = gridDim.x;
    volatile LAS unsigned* bst = (volatile LAS unsigned*)((LAS unsigned char*)g_lds + BAR_ST_OFF);
    if (threadIdx.x < 2) bst[threadIdx.x] = 0u;
    __syncthreads();
    XcdBarrier bar = xcd_barrier_post((unsigned*)(p.ws + WS_CTL) + CW_BAR, bst);
    RUN(0, ph_prologue(p, g_lds, bid, nb))
    grid.sync();
    RUN(1, ph_inproj(p, g_lds, bid, nb))
    ph_convert_rest(p, g_lds);
    xcd_barrier(bar);
    RUN(2, ph_swa(p, g_lds, bid, nb))
    __syncthreads();
    RUN(3, ph_mlstm_a1(p, g_lds, bid, nb))
    xcd_barrier(bar);
    RUN(4, ph_mlstm_a2(p, g_lds, bid, nb))
    xcd_barrier(bar);
    RUN(5, ph_mlstm_b(p, g_lds, bid, nb))
    xcd_barrier(bar);
    RUN(6, ph_outproj(p, g_lds, bid, nb))
    xcd_barrier(bar);
    ph_rowpass1(p, g_lds, bid, nb);
    xcd_barrier(bar);
    RUN(8, ph_moe_gu(p, g_lds, bid, nb))
    xcd_barrier(bar);
    RUN(9, ph_moe_down(p, g_lds, bid, nb))
    xcd_barrier(bar);
    RUN(10, ph_rowpass2(p, bid, nb))
}

extern "C" void kernel_launch(void* const* d_in, const int* in_sizes, int n_in, void* d_out, int out_size, void* d_ws, size_t ws_size, hipStream_t stream) {
    if (n_in != 19 || in_sizes[0] != T * DM || out_size != T * DM || ws_size < WS_END) {
        fprintf(stderr, "kernel_launch: unexpected shapes (n_in %d in0 %d out %d ws %zu)\n", n_in, n_in > 0 ? in_sizes[0] : -1, out_size, ws_size); return; }
    static int grid_blocks = 0;
    if (!grid_blocks) {
        int dev = 0, cus = 0, per_cu = 0;
        (void)hipGetDevice(&dev);
        (void)hipDeviceGetAttribute(&cus, hipDeviceAttributeMultiprocessorCount, dev);
        (void)hipFuncSetAttribute((const void*)mega_fwd, hipFuncAttributeMaxDynamicSharedMemorySize, LDS_BYTES);
        (void)hipOccupancyMaxActiveBlocksPerMultiprocessor(&per_cu, (const void*)mega_fwd, 512, LDS_BYTES);
        if (per_cu < 1) { fprintf(stderr, "kernel_launch: occupancy query says %d blocks per CU\n", per_cu); per_cu = 1; }
        if (per_cu > 1) per_cu = 1;
        grid_blocks = cus * per_cu;
        (void)hipGetLastError();
    }
    P p{};
    const float** f = (const float**)&p;
    for (int i = 0; i < 19; ++i) f[i] = (const float*)d_in[i];
    p.out = (float*)d_out; p.ws = (unsigned char*)d_ws;
    (void)hipMemsetAsync((char*)d_ws + WS_CTL, 0, CTL_ZERO_BYTES, stream);
    void* args[] = {&p};
    hipError_t e = hipLaunchCooperativeKernel((const void*)mega_fwd, dim3(grid_blocks), dim3(512), args, LDS_BYTES, stream);
    if (e != hipSuccess) fprintf(stderr, "cooperative launch failed: %s (grid %d)\n", hipGetErrorString(e), grid_blocks);
}
```

```cpp
#include <hip/hip_runtime.h>
#include <hip/hip_cooperative_groups.h>
namespace cg = cooperative_groups;
#include <cstdio>
#include <cstdint>

typedef unsigned short bf16_t;

constexpr int BATCH = 4, SEQ = 8192, T = BATCH * SEQ, DM = 1024;
constexpr int MLH = 4, MLD = 128, MLW = 512;
constexpr int AQH = 8, AKH = 2, AHD = 64;
constexpr int DIN = 2824;
constexpr int NV = 2816;
constexpr int NGRP = 4, EPG = 8, NEXP = 32, DEXP = 256;
constexpr float LN_EPS = 1e-5f;
constexpr float ALPHA = 1.189207115002721f;
constexpr int PC_MQ = 0, PC_MK = 512, PC_MV = 1024, PC_MO = 1536, PC_AQ = 2048, PC_AK = 2560, PC_AV = 2688;

constexpr size_t MiB = 1u << 20;
constexpr size_t WS_CTL = 0, WS_TAB = 1 * MiB, WS_GATES = 3 * MiB, WS_RT = 4 * MiB, WS_MISC = 5 * MiB;
constexpr size_t WS_WIN = 8 * MiB, WS_WOUT = 14 * MiB, WS_WGU = 16 * MiB, WS_WD = 48 * MiB;
constexpr size_t WS_PROJ = 64 * MiB, WS_X1F = 64 * MiB, WS_Y = 192 * MiB;
constexpr size_t WS_MIX = 240 * MiB, WS_CST = 304 * MiB, WS_H = 340 * MiB, WS_X1B = 376 * MiB, WS_SLOT = 440 * MiB, WS_WLIST = 444 * MiB, WS_END = 448 * MiB;
constexpr size_t WS_WR = WS_MISC;

struct P {
    const float *x, *w_in, *conv_w, *conv_b, *gate_bias, *norm_w, *sinks, *w_out, *ln1_w, *ln1_b;
    const float *w_gr, *b_gr, *w_er, *b_er, *w_eg, *w_eu, *w_ed, *ln2_w, *ln2_b;
    float* out; unsigned char* ws;
};

__device__ __forceinline__ float bf2f(bf16_t v) { return __uint_as_float((unsigned)v << 16); }
__device__ __forceinline__ bf16_t f2bf(float f) { unsigned u = __float_as_uint(f); return (bf16_t)((u + 0x7fffu + ((u >> 16) & 1u)) >> 16); }
__device__ __forceinline__ float wave_sum(float v) {
#pragma unroll
    for (int o = 1; o < 64; o <<= 1) v += __shfl_xor(v, o);
    return v;
}
__device__ __forceinline__ float wave_max(float v) {
#pragma unroll
    for (int o = 1; o < 64; o <<= 1) v = fmaxf(v, __shfl_xor(v, o));
    return v;
}
__device__ __forceinline__ float silu_f(float v) { return v / (1.f + expf(-v)); }
__device__ __forceinline__ float sigmoid_f(float v) { return 1.f / (1.f + expf(-v)); }
__device__ __forceinline__ float logsigmoid_f(float v) { return fminf(v, 0.f) - log1pf(expf(-fabsf(v))); }
__device__ __forceinline__ int rope_pos(int d) { return d < 32 ? 8 * (d >> 2) + (d & 3) : 8 * ((d - 32) >> 2) + 4 + (d & 3); }
__device__ __forceinline__ int vcol_to_orig(int v) { return v < 2048 ? v : (v < NV ? v + 8 : v - NV + 2048); }

__device__ void ph_tab(const P& p, int bid, int nb) {
    float2* tab = (float2*)(p.ws + WS_TAB);
    for (int i = bid * 512 + threadIdx.x; i < SEQ * 32; i += nb * 512) {
        const int pos = i >> 5, f = i & 31;
        const double ang = (double)pos * pow(10000.0, -(double)f / 32.0);
        tab[i] = make_float2((float)cos(ang), (float)sin(ang));
    }
}

template <class AF, class BF>
__device__ __forceinline__ void naive_tile(AF af, BF bfn, int row0, int col0, int K, float* As, float* Bs, float* Ct) {
    const int tid = threadIdx.x, ty = tid >> 4, tx = tid & 15;
    float acc[4][4];
#pragma unroll
    for (int i = 0; i < 4; ++i)
#pragma unroll
        for (int j = 0; j < 4; ++j) acc[i][j] = 0.f;
    for (int k0 = 0; k0 < K; k0 += 16) {
#pragma unroll
        for (int i = 0; i < 4; ++i) { const int e = tid + 512 * i, r = e >> 4, kk = e & 15; As[kk * 132 + r] = af(row0 + r, k0 + kk); }
#pragma unroll
        for (int i = 0; i < 2; ++i) { const int e = tid + 512 * i, kk = e >> 6, c = e & 63; Bs[kk * 64 + c] = bfn(k0 + kk, col0 + c); }
        __syncthreads();
#pragma unroll
        for (int kk = 0; kk < 16; ++kk) {
            float a[4], b[4];
#pragma unroll
            for (int i = 0; i < 4; ++i) { a[i] = As[kk * 132 + 4 * ty + i]; b[i] = Bs[kk * 64 + 4 * tx + i]; }
#pragma unroll
            for (int i = 0; i < 4; ++i)
#pragma unroll
                for (int j = 0; j < 4; ++j) acc[i][j] += a[i] * b[j];
        }
        __syncthreads();
    }
#pragma unroll
    for (int i = 0; i < 4; ++i)
#pragma unroll
        for (int j = 0; j < 4; ++j) Ct[(4 * ty + i) * 65 + 4 * tx + j] = acc[i][j];
    __syncthreads();
}

__device__ void ph_inproj_naive(const P& p, unsigned char* lds, int bid, int nb) {
    float* As = (float*)lds; float* Bs = As + 16 * 132; float* Ct = Bs + 16 * 64;
    bf16_t* proj = (bf16_t*)(p.ws + WS_PROJ);
    float* gates = (float*)(p.ws + WS_GATES);
    const float2* tab = (const float2*)(p.ws + WS_TAB);
    const float* x = p.x; const float* w = p.w_in;
    constexpr int NCT = (DIN + 63) / 64;
    const int ntiles = (T / 128) * NCT;
    const int tid = threadIdx.x;
    for (int it = bid; it < ntiles; it += nb) {
        const int rt = it / NCT, ct = it % NCT, row0 = rt * 128, col0 = ct * 64;
        naive_tile([&](int r, int k) { return x[(size_t)r * DM + k]; },
                   [&](int k, int vc) { return vc < DIN ? w[(size_t)k * DIN + vcol_to_orig(vc)] : 0.f; },
                   row0, col0, DM, As, Bs, Ct);
        if (col0 >= NV) {
            for (int e = tid; e < 128 * 8; e += 512) { const int r = e >> 3, c = e & 7; gates[(size_t)(row0 + r) * 8 + c] = Ct[r * 65 + c] + p.gate_bias[c]; }
        } else if (col0 >= PC_AQ && col0 < PC_AV) {
            for (int e = tid; e < 128 * 32; e += 512) {
                const int r = e >> 5, d = e & 31; const int pos = (row0 + r) & (SEQ - 1);
                const float2 cs = tab[pos * 32 + d]; const float x1 = Ct[r * 65 + d], x2 = Ct[r * 65 + d + 32];
                bf16_t* o = proj + (size_t)(row0 + r) * NV + col0;
                o[rope_pos(d)] = f2bf(x1 * cs.x - x2 * cs.y); o[rope_pos(d + 32)] = f2bf(x1 * cs.y + x2 * cs.x);
            }
        } else {
            for (int e = tid; e < 128 * 64; e += 512) { const int r = e >> 6, c = e & 63; proj[(size_t)(row0 + r) * NV + col0 + c] = f2bf(Ct[r * 65 + c]); }
        }
        __syncthreads();
    }
}

__device__ void ph_mlstm_naive(const P& p, unsigned char* lds, int bid, int nb) {
    constexpr int TB = 16;
    float* qs = (float*)lds;
    float* ks = qs + TB * 128;
    float* vs = ks + TB * 128;
    float* hs = vs + TB * 128;
    float* gi = hs + TB * 128;
    float* gl = gi + TB;
    const bf16_t* proj = (const bf16_t*)(p.ws + WS_PROJ);
    const float* gates = (const float*)(p.ws + WS_GATES);
    bf16_t* mix = (bf16_t*)(p.ws + WS_MIX);
    const int tid = threadIdx.x, lane = tid & 63, wv = tid >> 6;
    const int e = tid >> 2, dq = tid & 3;
    for (int it = bid; it < BATCH * MLH; it += nb) {
        const int b = it / MLH, h = it % MLH;
        float C[32], n[32];
#pragma unroll
        for (int j = 0; j < 32; ++j) { C[j] = 0.f; n[j] = 0.f; }
        float m = 0.f;
        for (int t0 = 0; t0 < SEQ; t0 += TB) {
            for (int idx = tid; idx < TB * 256; idx += 512) {
                const int tok = idx >> 8, c = idx & 255; const int t = t0 + tok;
                const int ch = (c < 128) ? (h * 128 + c) : (512 + h * 128 + (c - 128));
                float a = p.conv_b[ch];
#pragma unroll
                for (int j = 0; j < 4; ++j) { const int tt = t - 3 + j; if (tt >= 0) a += p.conv_w[j * 1024 + ch] * bf2f(proj[(size_t)(b * SEQ + tt) * NV + ch]); }
                a = silu_f(a);
                if (c < 128) qs[tok * 128 + c] = a; else ks[tok * 128 + (c - 128)] = a * 0.08838834764831845f;
            }
            for (int idx = tid; idx < TB * 128; idx += 512) { const int tok = idx >> 7, c = idx & 127; vs[idx] = bf2f(proj[(size_t)(b * SEQ + t0 + tok) * NV + PC_MV + h * 128 + c]); }
            if (tid < TB) { const float* g = gates + (size_t)(b * SEQ + t0 + tid) * 8; gi[tid] = g[h]; gl[tid] = logsigmoid_f(g[4 + h]); }
            __syncthreads();
            for (int tok = 0; tok < TB; ++tok) {
                const float iv = gi[tok], lf = gl[tok];
                const float mn = fmaxf(lf + m, iv), fd = expf(lf + m - mn), iw = expf(iv - mn);
                const float ve = vs[tok * 128 + e] * iw;
                float nump = 0.f, denp = 0.f;
#pragma unroll
                for (int j = 0; j < 32; ++j) {
                    const float kk = ks[tok * 128 + dq * 32 + j], qq = qs[tok * 128 + dq * 32 + j];
                    C[j] = fd * C[j] + ve * kk; n[j] = fd * n[j] + iw * kk;
                    nump += C[j] * qq; denp += n[j] * qq;
                }
                nump += __shfl_xor(nump, 1); nump += __shfl_xor(nump, 2);
                denp += __shfl_xor(denp, 1); denp += __shfl_xor(denp, 2);
                if (dq == 0) hs[tok * 128 + e] = nump / fmaxf(fabsf(denp), expf(-mn));
                m = mn;
            }
            __syncthreads();
            for (int tk = wv * 2; tk < wv * 2 + 2; ++tk) {
                const float h0 = hs[tk * 128 + lane], h1 = hs[tk * 128 + 64 + lane];
                const float mu = wave_sum(h0 + h1) * (1.f / 128.f);
                const float d0 = h0 - mu, d1 = h1 - mu;
                const float var = wave_sum(d0 * d0 + d1 * d1) * (1.f / 128.f);
                const float rs = 1.f / sqrtf(var + LN_EPS);
                const size_t row = (size_t)(b * SEQ + t0 + tk);
                const float o0 = bf2f(proj[row * NV + PC_MO + h * 128 + lane]), o1 = bf2f(proj[row * NV + PC_MO + h * 128 + 64 + lane]);
                mix[row * DM + h * 128 + lane] = f2bf(sigmoid_f(o0) * d0 * rs * p.norm_w[h * 128 + lane]);
                mix[row * DM + h * 128 + 64 + lane] = f2bf(sigmoid_f(o1) * d1 * rs * p.norm_w[h * 128 + 64 + lane]);
            }
            __syncthreads();
        }
    }
}

__device__ void ph_swa_naive(const P& p, unsigned char* lds, int bid, int nb) {
    const int tid = threadIdx.x, lane = tid & 63, wv = tid >> 6;
    float* qsh = (float*)lds + wv * 192;
    float* psh = qsh + 64;
    const bf16_t* proj = (const bf16_t*)(p.ws + WS_PROJ);
    bf16_t* mix = (bf16_t*)(p.ws + WS_MIX);
    const long nitems = (long)T * AQH;
    for (long it = (long)bid * 8 + wv; it < nitems; it += (long)nb * 8) {
        const int hq = (int)(it & 7); const int row = (int)(it >> 3); const int s = row & (SEQ - 1); const int kvh = hq >> 2;
        qsh[lane] = bf2f(proj[(size_t)row * NV + PC_AQ + hq * 64 + lane]);
        __builtin_amdgcn_wave_barrier();
        float sc[2]; bool val[2];
#pragma unroll
        for (int u = 0; u < 2; ++u) {
            const int kidx = lane + 64 * u; const int kpos = s - 127 + kidx; val[u] = kpos >= 0;
            float a = 0.f;
            if (val[u]) { const bf16_t* kr = proj + (size_t)(row - 127 + kidx) * NV + PC_AK + kvh * 64;
                for (int d = 0; d < 64; ++d) a += qsh[d] * bf2f(kr[d]); }
            sc[u] = val[u] ? a * 0.125f : -INFINITY;
        }
        const float sink = p.sinks[hq];
        const float mx = fmaxf(wave_max(fmaxf(sc[0], sc[1])), sink);
        const float p0 = val[0] ? expf(sc[0] - mx) : 0.f, p1 = val[1] ? expf(sc[1] - mx) : 0.f;
        const float den = wave_sum(p0 + p1) + expf(sink - mx);
        psh[lane] = p0; psh[lane + 64] = p1;
        __builtin_amdgcn_wave_barrier();
        float o = 0.f;
        for (int kidx = 0; kidx < 128; ++kidx) { const int kpos = s - 127 + kidx; if (kpos >= 0) o += psh[kidx] * bf2f(proj[(size_t)(row - 127 + kidx) * NV + PC_AV + kvh * 64 + lane]); }
        mix[(size_t)row * DM + 512 + hq * 64 + lane] = f2bf(o / den);
        __builtin_amdgcn_wave_barrier();
    }
}

__device__ void ph_outproj_naive(const P& p, unsigned char* lds, int bid, int nb) {
    float* As = (float*)lds; float* Bs = As + 16 * 132; float* Ct = Bs + 16 * 64;
    const bf16_t* mix = (const bf16_t*)(p.ws + WS_MIX);
    float* y = (float*)(p.ws + WS_X1F);
    const float* w = p.w_out;
    const int ntiles = (T / 128) * (DM / 64);
    const int tid = threadIdx.x;
    for (int it = bid; it < ntiles; it += nb) {
        const int rt = it / (DM / 64), ct = it % (DM / 64), row0 = rt * 128, col0 = ct * 64;
        naive_tile([&](int r, int k) { return bf2f(mix[(size_t)r * DM + k]); },
                   [&](int k, int c) { return w[(size_t)k * DM + c]; }, row0, col0, DM, As, Bs, Ct);
        for (int e = tid; e < 128 * 64; e += 512) { const int r = e >> 6, c = e & 63; y[(size_t)(row0 + r) * DM + col0 + c] = Ct[r * 65 + c]; }
        __syncthreads();
    }
}

__device__ void ph_ln1_naive(const P& p, int bid, int nb) {
    const int tid = threadIdx.x, lane = tid & 63, wv = tid >> 6;
    float* x1 = (float*)(p.ws + WS_X1F); bf16_t* x1b = (bf16_t*)(p.ws + WS_X1B);
    for (int row = bid * 8 + wv; row < T; row += nb * 8) {
        float v[16]; float s = 0.f;
#pragma unroll
        for (int i = 0; i < 16; ++i) { const int c = i * 64 + lane; v[i] = ALPHA * p.x[(size_t)row * DM + c] + x1[(size_t)row * DM + c]; s += v[i]; }
        const float mu = wave_sum(s) * (1.f / DM); float q = 0.f;
#pragma unroll
        for (int i = 0; i < 16; ++i) { v[i] -= mu; q += v[i] * v[i]; }
        const float rs = 1.f / sqrtf(wave_sum(q) * (1.f / DM) + LN_EPS);
#pragma unroll
        for (int i = 0; i < 16; ++i) { const int c = i * 64 + lane; const float o = v[i] * rs * p.ln1_w[c] + p.ln1_b[c]; x1[(size_t)row * DM + c] = o; x1b[(size_t)row * DM + c] = f2bf(o); }
    }
}

__device__ void ph_route_naive(const P& p, int bid, int nb) {
    const int tid = threadIdx.x, lane = tid & 63, wv = tid >> 6;
    const float* x1 = (const float*)(p.ws + WS_X1F);
    int* rt_e = (int*)(p.ws + WS_RT); float* rt_w = (float*)(p.ws + WS_RT + 512 * 1024);
    for (int row = bid * 8 + wv; row < T; row += nb * 8) {
        float lg[36];
#pragma unroll
        for (int j = 0; j < 36; ++j) lg[j] = 0.f;
        for (int i = 0; i < 16; ++i) {
            const int d = i * 64 + lane; const float xv = x1[(size_t)row * DM + d];
#pragma unroll
            for (int j = 0; j < 4; ++j) lg[j] += xv * p.w_gr[d * 4 + j];
#pragma unroll
            for (int j = 0; j < 32; ++j) lg[4 + j] += xv * p.w_er[d * 32 + j];
        }
#pragma unroll
        for (int j = 0; j < 36; ++j) lg[j] = wave_sum(lg[j]);
        if (lane == 0) {
            float g[4]; int gi = 0;
#pragma unroll
            for (int j = 0; j < 4; ++j) g[j] = lg[j] + p.b_gr[j];
            float gm = g[0];
#pragma unroll
            for (int j = 1; j < 4; ++j) if (g[j] > gm) { gm = g[j]; gi = j; }
            float gs = 0.f;
#pragma unroll
            for (int j = 0; j < 4; ++j) gs += expf(g[j] - gm);
            const float gp = 1.f / gs;
            float ev[8];
#pragma unroll
            for (int j = 0; j < 8; ++j) { float a = 0.f;
#pragma unroll
                for (int q = 0; q < 4; ++q) a = (q == gi) ? (lg[4 + q * 8 + j] + p.b_er[q * 8 + j]) : a;
                ev[j] = a; }
            int i0 = 0; float v0 = ev[0];
#pragma unroll
            for (int j = 1; j < 8; ++j) if (ev[j] > v0) { v0 = ev[j]; i0 = j; }
            int i1 = -1; float v1 = -INFINITY;
#pragma unroll
            for (int j = 0; j < 8; ++j) if (j != i0 && ev[j] > v1) { v1 = ev[j]; i1 = j; }
            const float e1 = expf(v1 - v0); const float w0 = gp / (1.f + e1), w1 = gp * e1 / (1.f + e1);
            rt_e[row * 2] = gi * 8 + i0; rt_e[row * 2 + 1] = gi * 8 + i1; rt_w[row * 2] = w0; rt_w[row * 2 + 1] = w1;
        }
    }
}

__device__ void ph_moe_naive(const P& p, unsigned char* lds, int bid, int nb) {
    float* xs = (float*)lds;
    float* gu = xs + 1024;
    float* hs = gu + 512;
    float* red = hs + 512;
    const int tid = threadIdx.x, lane = tid & 63, wv = tid >> 6;
    const float* x1 = (const float*)(p.ws + WS_X1F); const bf16_t* x1b = (const bf16_t*)(p.ws + WS_X1B);
    const int* rt_e = (const int*)(p.ws + WS_RT); const float* rt_w = (const float*)(p.ws + WS_RT + 512 * 1024);
    for (int row = bid; row < T; row += nb) {
        xs[tid] = bf2f(x1b[(size_t)row * DM + tid]); xs[tid + 512] = bf2f(x1b[(size_t)row * DM + tid + 512]);
        __syncthreads();
        for (int k = 0; k < 2; ++k) {
            const int e = rt_e[row * 2 + k]; const float wk = rt_w[row * 2 + k];
            const float* W = (tid < 256 ? p.w_eg : p.w_eu) + (size_t)e * DM * DEXP + (tid & 255);
            float a = 0.f;
            for (int d = 0; d < DM; ++d) a += xs[d] * W[(size_t)d * DEXP];
            gu[tid] = a;
            __syncthreads();
            if (tid < 256) hs[k * 256 + tid] = silu_f(gu[tid]) * gu[256 + tid] * wk;
            __syncthreads();
        }
        float acc[2] = {0.f, 0.f};
        for (int k = 0; k < 2; ++k) {
            const int e = rt_e[row * 2 + k]; const float* W = p.w_ed + (size_t)e * DEXP * DM;
            for (int j = 0; j < DEXP; ++j) { const float hv = hs[k * 256 + j]; acc[0] += hv * W[(size_t)j * DM + tid]; acc[1] += hv * W[(size_t)j * DM + tid + 512]; }
        }
        float v0 = ALPHA * x1[(size_t)row * DM + tid] + acc[0], v1 = ALPHA * x1[(size_t)row * DM + tid + 512] + acc[1];
        float s = wave_sum(v0 + v1); if (lane == 0) red[wv] = s; __syncthreads();
        float mu = 0.f;
#pragma unroll
        for (int i = 0; i < 8; ++i) mu += red[i];
        mu *= (1.f / DM); v0 -= mu; v1 -= mu;
        float q = wave_sum(v0 * v0 + v1 * v1); if (lane == 0) red[8 + wv] = q; __syncthreads();
        float var = 0.f;
#pragma unroll
        for (int i = 0; i < 8; ++i) var += red[8 + i];
        const float rs = 1.f / sqrtf(var * (1.f / DM) + LN_EPS);
        p.out[(size_t)row * DM + tid] = v0 * rs * p.ln2_w[tid] + p.ln2_b[tid];
        p.out[(size_t)row * DM + tid + 512] = v1 * rs * p.ln2_w[tid + 512] + p.ln2_b[tid + 512];
        __syncthreads();
    }
}

namespace pg8 {
#define PG8_LAS __attribute__((address_space(3)))
typedef short bf16x8 __attribute__((ext_vector_type(8)));
typedef float f32x4 __attribute__((ext_vector_type(4)));
typedef unsigned u32x4 __attribute__((ext_vector_type(4)));
typedef unsigned u32x2 __attribute__((ext_vector_type(2)));
constexpr int BM = 256, BK = 64, HALF = 128, HTB = HALF * BK * 2, STAGE_BYTES = 8 * HTB, NXCD = 8, WGM = 8;

__host__ __device__ __forceinline__ int lds_byte(int r, int c) { const int st = (r >> 4) * 2 + (c >> 5), rr = r & 15, cc = c & 31, ob = rr * 64 + cc * 2; return st * 1024 + (ob ^ (((ob >> 9) & 1) << 5)); }
__host__ __device__ __forceinline__ void stage_rc(int b, int& R, int& C) { const int st = b / 1024, sb = b % 1024, swz = sb ^ (((sb >> 9) & 1) << 5); R = (st >> 1) * 16 + swz / 64; C = (st & 1) * 32 + (swz % 64) / 2; }
__host__ __device__ __forceinline__ int perm32(int rho) { const int n = rho >> 4, i = rho & 15; return 8 * (i >> 2) + 4 * n + (i & 3); }

struct Unit { int pm, pn, e, mt; };

__device__ __forceinline__ unsigned cvt_pk_bf16(float lo, float hi) { unsigned r; asm volatile("v_cvt_pk_bf16_f32 %0, %1, %2" : "=v"(r) : "v"(lo), "v"(hi)); return r; }

struct StaticOrder {
    int nM, nN, nwg, G, c;
    __device__ void init(int M, int N, int G_, int c_) { nM = M / BM; nN = N / BM; nwg = nM * nN; G = G_; c = c_; }
    __device__ bool next(int i, Unit& u) const {
        const long L = (long)i * G + c; if (L >= nwg) return false;
        int wgid = (int)L; { const int q = nwg / NXCD, r = nwg % NXCD, xcd = wgid % NXCD, off = wgid / NXCD; wgid = (xcd < r ? xcd * (q + 1) : r * (q + 1) + (xcd - r) * q) + off; }
        const int nig = WGM * nN, gid = wgid / nig, fm = gid * WGM, gsz = (nM - fm) < WGM ? (nM - fm) : WGM;
        u.pm = fm + ((wgid % nig) % gsz); u.pn = (wgid % nig) / gsz; u.e = 0; u.mt = 0; return true;
    }
};

template <class Epi, class Prob, class Sched>
__device__ __forceinline__ void gemm_phase(PG8_LAS unsigned char* lds, const Prob& G, const Sched& S, const Epi& E) {
    int tid = threadIdx.x; asm volatile("" : "+v"(tid));
    const int wid = __builtin_amdgcn_readfirstlane(tid >> 6), lane = tid & 63, wr = wid >> 2, wc = wid & 3, fr = lane & 15, fq = lane >> 4;
    const int K = G.K, nt = K / BK;
    unsigned voffB[2];
    { int Rr0, Cc0, Rr1, Cc1; stage_rc(tid * 16, Rr0, Cc0); stage_rc(tid * 16 + 8192, Rr1, Cc1);
      const int Rb0 = Epi::PERM ? ((Rr0 & ~31) + perm32(Rr0 & 31)) : Rr0, Rb1 = Epi::PERM ? ((Rr1 & ~31) + perm32(Rr1 & 31)) : Rr1;
      voffB[0] = (unsigned)(Rb0 * K + Cc0) * 2u; voffB[1] = (unsigned)(Rb1 * K + Cc1) * 2u; }
    const size_t kstep = (size_t)(BK * 2);
    const size_t hstep = (size_t)HALF * K * 2;
    const unsigned ldsw = (unsigned)wid * 1024u;
    const int aoff = lds_byte(wr * 64 + fr, fq * 8), boff = lds_byte(wc * 32 + fr, fq * 8);
    const char* const Abase = (const char*)G.A;
#define PG8_SA(b, h) (((b) * 2 + (h)) * HTB)
#define PG8_SB(b, h) ((4 + (b) * 2 + (h)) * HTB)
#define PG8_GLDS(gp, ldsoff) __builtin_amdgcn_global_load_lds((const unsigned*)(gp), (PG8_LAS unsigned*)(lds + (ldsoff)), 16, 0, 0)
#define PG8_STAGE_B(bufoff, gbase) do { PG8_GLDS((const char*)(gbase) + voffB[0], (bufoff) + ldsw); PG8_GLDS((const char*)(gbase) + voffB[1], (bufoff) + ldsw + 8192); } while (0)
#define PG8_STAGE_A(bufoff, kb, o0, o1) do { PG8_GLDS(Abase + (kb) + (o0), (bufoff) + ldsw); PG8_GLDS(Abase + (kb) + (o1), (bufoff) + ldsw + 8192); } while (0)
#define PG8_AOFFS(u, o00, o01, o10, o11) do { int t2_ = tid; asm volatile("" : "+v"(t2_)); int Rr0, Cc0, Rr1, Cc1; stage_rc(t2_ * 16, Rr0, Cc0); stage_rc(t2_ * 16 + 8192, Rr1, Cc1); \
        o00 = (unsigned)(((size_t)G.a_row(u, Rr0) * K + Cc0) * 2u); o01 = (unsigned)(((size_t)G.a_row(u, Rr1) * K + Cc1) * 2u); \
        o10 = (unsigned)(((size_t)G.a_row(u, 128 + Rr0) * K + Cc0) * 2u); o11 = (unsigned)(((size_t)G.a_row(u, 128 + Rr1) * K + Cc1) * 2u); } while (0)
#define PG8_LDA(dst, b, h) do { _Pragma("unroll") for (int m = 0; m < 4; ++m) _Pragma("unroll") for (int k = 0; k < 2; ++k) dst[m][k] = *(const PG8_LAS bf16x8*)(lds + PG8_SA(b, h) + aoff + m * 2048 + k * 1024); } while (0)
#define PG8_LDB(dst, b, h) do { _Pragma("unroll") for (int n = 0; n < 2; ++n) _Pragma("unroll") for (int k = 0; k < 2; ++k) dst[n][k] = *(const PG8_LAS bf16x8*)(lds + PG8_SB(b, h) + boff + n * 2048 + k * 1024); } while (0)
#define PG8_MMA(ai, bj, At, Bt) do { __builtin_amdgcn_s_setprio(1); _Pragma("unroll") for (int m = 0; m < 4; ++m) _Pragma("unroll") for (int n = 0; n < 2; ++n) _Pragma("unroll") for (int k = 0; k < 2; ++k) \
        acc[ai][bj][m][n] = __builtin_amdgcn_mfma_f32_16x16x32_bf16(Bt[n][k], At[m][k], acc[ai][bj][m][n], 0, 0, 0); __builtin_amdgcn_s_setprio(0); } while (0)
#define PG8_WAIT_V(n) asm volatile("s_waitcnt vmcnt(" #n ")" ::: "memory")
#define PG8_WAIT_L(n) asm volatile("s_waitcnt lgkmcnt(" #n ")" ::: "memory")
#define PG8_BAR __builtin_amdgcn_s_barrier()
#define PG8_SCHED __builtin_amdgcn_sched_barrier(0)
    Unit cur, nxt; int ui = 0;
    if (!S.next(0, cur)) return;
    f32x4 acc[2][2][4][2];
#pragma unroll
    for (int a = 0; a < 2; ++a)
#pragma unroll
        for (int b = 0; b < 2; ++b)
#pragma unroll
            for (int m = 0; m < 4; ++m)
#pragma unroll
                for (int n = 0; n < 2; ++n) acc[a][b][m][n] = (f32x4){0.f, 0.f, 0.f, 0.f};
    bf16x8 At[4][2], B0[2][2], B1[2][2];
    unsigned c00, c01, c10, c11;
    PG8_AOFFS(cur, c00, c01, c10, c11);
    const char* cB = G.b_tile(cur);
    PG8_STAGE_B(PG8_SB(0, 0), cB); PG8_STAGE_B(PG8_SB(0, 1), cB + hstep); PG8_STAGE_A(PG8_SA(0, 0), 0, c00, c01); PG8_STAGE_A(PG8_SA(0, 1), 0, c10, c11);
    if (wr == 1) PG8_BAR;
    PG8_WAIT_V(2); PG8_BAR;
    PG8_STAGE_B(PG8_SB(1, 0), cB + kstep); PG8_STAGE_A(PG8_SA(1, 0), kstep, c00, c01); PG8_STAGE_B(PG8_SB(1, 1), cB + hstep + kstep);
    PG8_WAIT_V(6); PG8_BAR;
    for (;;) {
        const bool has_next = S.next(ui + 1, nxt);
        const char* nB = has_next ? G.b_tile(nxt) : cB;
        for (int t = 0; t < nt; t += 2) {
            const bool last = (t == nt - 2);
            const size_t ka1 = (size_t)(t + 1) * kstep;
            const size_t ka2 = last ? 0 : (size_t)(t + 2) * kstep, ka3 = ka2 + kstep;
            const char* b2 = last ? nB : cB + (size_t)(t + 2) * kstep; const char* b3 = b2 + kstep;
            PG8_LDB(B0, 0, 0); PG8_LDB(B1, 0, 1); PG8_SCHED; PG8_LDA(At, 0, 0); PG8_STAGE_A(PG8_SA(1, 1), ka1, c10, c11);
            if (last && has_next) { PG8_AOFFS(nxt, c00, c01, c10, c11); }
            PG8_WAIT_V(8); PG8_WAIT_L(0); PG8_BAR; PG8_MMA(0, 0, At, B0); PG8_MMA(0, 1, At, B1); PG8_BAR; PG8_SCHED;
            PG8_LDA(At, 0, 1); PG8_STAGE_B(PG8_SB(0, 0), b2); PG8_STAGE_B(PG8_SB(0, 1), b2 + hstep); PG8_STAGE_A(PG8_SA(0, 0), ka2, c00, c01);
            PG8_WAIT_V(8); PG8_WAIT_L(0); PG8_BAR; PG8_MMA(1, 0, At, B0); PG8_MMA(1, 1, At, B1); PG8_BAR; PG8_SCHED;
            PG8_LDB(B0, 1, 0); PG8_LDB(B1, 1, 1); PG8_SCHED; PG8_LDA(At, 1, 0); PG8_STAGE_A(PG8_SA(0, 1), ka2, c10, c11);
            PG8_WAIT_V(8); PG8_WAIT_L(0); PG8_BAR; PG8_MMA(0, 0, At, B0); PG8_MMA(0, 1, At, B1); PG8_BAR; PG8_SCHED;
            PG8_LDA(At, 1, 1); PG8_STAGE_B(PG8_SB(1, 0), b3); PG8_STAGE_B(PG8_SB(1, 1), b3 + hstep); PG8_STAGE_A(PG8_SA(1, 0), ka3, c00, c01);
            PG8_WAIT_V(8); PG8_WAIT_L(0); PG8_BAR; PG8_MMA(1, 0, At, B0); PG8_MMA(1, 1, At, B1); PG8_BAR; PG8_SCHED;
        }
        if (wr == 0) PG8_BAR;
        E(acc, cur, wr, wc, fr, fq);
        if (!has_next) break;
#pragma unroll
        for (int a = 0; a < 2; ++a)
#pragma unroll
            for (int b = 0; b < 2; ++b)
#pragma unroll
                for (int m = 0; m < 4; ++m)
#pragma unroll
                    for (int n = 0; n < 2; ++n) acc[a][b][m][n] = (f32x4){0.f, 0.f, 0.f, 0.f};
        cur = nxt; cB = nB; ++ui;
        if (wr == 1) PG8_BAR;
    }
    PG8_WAIT_V(0);
    PG8_BAR;
#undef PG8_SA
#undef PG8_SB
#undef PG8_GLDS
#undef PG8_STAGE_A
#undef PG8_STAGE_B
#undef PG8_AOFFS
#undef PG8_LDA
#undef PG8_LDB
#undef PG8_MMA
#undef PG8_WAIT_V
#undef PG8_WAIT_L
#undef PG8_BAR
#undef PG8_SCHED
}
}
#define LAS __attribute__((address_space(3)))
typedef unsigned v4u __attribute__((ext_vector_type(4)));
typedef float v4f __attribute__((ext_vector_type(4)));
#define LDS_WAIT() asm volatile("s_waitcnt lgkmcnt(0)" ::: "memory")
__device__ __forceinline__ unsigned pk2(float lo, float hi) { unsigned r; asm volatile("v_cvt_pk_bf16_f32 %0, %1, %2" : "=v"(r) : "v"(lo), "v"(hi)); return r; }
__device__ __forceinline__ float fsigmoid(float v) { return __builtin_amdgcn_rcpf(1.f + __builtin_amdgcn_exp2f(v * -1.4426950408889634f)); }
__device__ __forceinline__ float fsilu(float v) { return v * fsigmoid(v); }

constexpr int CW_GCNT = 64;

template <class SrcCol, class DstRow>
__device__ __forceinline__ void transpose_item(const float* W, int ldw, int K, bf16_t* WT, int k0, int n0, SrcCol sc, DstRow dr, LAS float* scr, int lane) {
    const int scol = sc(n0 + (lane & 31));
#pragma unroll 8
    for (int i = 0; i < 32; ++i) { const int kk = 2 * i + (lane >> 5); scr[kk * 33 + (lane & 31)] = W[(size_t)(k0 + kk) * ldw + scol]; }
    LDS_WAIT(); asm volatile("" ::: "memory");
    const int c = lane & 7;
#pragma unroll
    for (int j = 0; j < 4; ++j) { const int n = (lane >> 3) + 8 * j; const LAS float* s = scr + (8 * c) * 33 + n;
        v4u o; o.x = pk2(s[0 * 33], s[1 * 33]); o.y = pk2(s[2 * 33], s[3 * 33]); o.z = pk2(s[4 * 33], s[5 * 33]); o.w = pk2(s[6 * 33], s[7 * 33]);
        *(v4u*)(WT + (size_t)dr(n0 + n) * K + k0 + 8 * c) = o; }
    LDS_WAIT(); asm volatile("" ::: "memory");
}

__device__ __forceinline__ void ph_prologue(const P& p, unsigned char* lds_g, int bid, int nb) {
    int tid = threadIdx.x; asm volatile("" : "+v"(tid));
    const int lane = tid & 63, wv = __builtin_amdgcn_readfirstlane(tid >> 6);
    LAS unsigned char* lds = (LAS unsigned char*)lds_g;
    ph_tab(p, bid, nb);
    {
        bf16_t* Wr = (bf16_t*)(p.ws + WS_WR);
        for (int i = bid * 512 + tid; i < 48 * DM; i += nb * 512) { const int j = i >> 10, d = i & 1023;
            const float w = j < 4 ? p.w_gr[d * 4 + j] : (j < 36 ? p.w_er[d * 32 + (j - 4)] : 0.f); Wr[i] = f2bf(w); }
    }
    LAS float* wg = (LAS float*)(lds + 8 * 8448);
    for (int i = tid; i < 8 * 1024; i += 512) { const int d = i >> 3, c = i & 7; wg[c * 1024 + d] = p.w_in[(size_t)d * DIN + 2048 + c]; }
    __syncthreads();
    {
        bf16_t* xb = (bf16_t*)(p.ws + WS_MIX); float* gates = (float*)(p.ws + WS_GATES);
        for (int row = bid * 8 + wv; row < T; row += nb * 8) {
            const v4f* xr = (const v4f*)(p.x + (size_t)row * DM) + lane;
            v4f v[4];
#pragma unroll
            for (int j = 0; j < 4; ++j) v[j] = xr[64 * j];
            unsigned long long* o8 = (unsigned long long*)(xb + (size_t)row * DM) + lane;
#pragma unroll
            for (int j = 0; j < 4; ++j) o8[64 * j] = (unsigned long long)pk2(v[j].x, v[j].y) | ((unsigned long long)pk2(v[j].z, v[j].w) << 32);
            float g[8];
#pragma unroll
            for (int c = 0; c < 8; ++c) { float a = 0.f;
#pragma unroll
                for (int j = 0; j < 4; ++j) { const v4f w = *(const LAS v4f*)(wg + c * 1024 + 256 * j + 4 * lane); a += v[j].x * w.x + v[j].y * w.y + v[j].z * w.z + v[j].w * w.w; }
                g[c] = wave_sum(a); }
            float gv = g[0];
#pragma unroll
            for (int c = 1; c < 8; ++c) gv = (lane == c) ? g[c] : gv;
            if (lane < 8) gates[(size_t)row * 8 + lane] = gv + p.gate_bias[lane];
        }
    }
    {
        LAS float* scr = (LAS float*)(lds + wv * 8448);
        const int gw = bid * 8 + wv, NGW = nb * 8;
        bf16_t* Win = (bf16_t*)(p.ws + WS_WIN);
        constexpr int I_IN = 16 * (NV / 32);
        for (int r = gw; r < I_IN; r += NGW) { const int kb = r / (NV / 32), nbk = r % (NV / 32);
            transpose_item(p.w_in, DIN, DM, Win, kb * 64, nbk * 32, [](int v) { return vcol_to_orig(v); },
                           [](int v) { return (v >= PC_AQ && v < PC_AV) ? ((v & ~63) + rope_pos(v & 63)) : v; }, scr, lane); }
    }
}

constexpr int CW_CONVQ = 32;
__device__ __forceinline__ void ph_convert_rest(const P& p, unsigned char* lds_g) {
    int tid = threadIdx.x; asm volatile("" : "+v"(tid));
    const int lane = tid & 63, wv = __builtin_amdgcn_readfirstlane(tid >> 6);
    LAS float* scr = (LAS float*)((LAS unsigned char*)lds_g + wv * 8448);
    unsigned* q = (unsigned*)(p.ws + WS_CTL) + CW_CONVQ;
    bf16_t* Wout = (bf16_t*)(p.ws + WS_WOUT); bf16_t* Wgu = (bf16_t*)(p.ws + WS_WGU); bf16_t* Wd = (bf16_t*)(p.ws + WS_WD);
    constexpr int I_OUT = 16 * 32, I_G = NEXP * 16 * 8, I_D = NEXP * 4 * 32;
    constexpr int NITEMS = I_OUT + 2 * I_G + I_D;
    for (;;) {
        unsigned base = 0; if (lane == 0) base = __hip_atomic_fetch_add(q, 16u, __ATOMIC_RELAXED, __HIP_MEMORY_SCOPE_AGENT);
        base = (unsigned)__builtin_amdgcn_readfirstlane((int)base);
        if (base >= (unsigned)NITEMS) break;
        for (int it = (int)base; it < (int)base + 16 && it < NITEMS; ++it) {
            int r = it;
            if (r < I_OUT) { const int kb = r / 32, nbk = r % 32;
                transpose_item(p.w_out, DM, DM, Wout, kb * 64, nbk * 32, [](int v) { return v; }, [](int v) { return v; }, scr, lane); continue; }
            r -= I_OUT;
            if (r < 2 * I_G) { const int up = r >= I_G; if (up) r -= I_G; const int e = r / 128, qq = r % 128, kb = qq / 8, nbk = qq % 8;
                transpose_item((up ? p.w_eu : p.w_eg) + (size_t)e * DM * DEXP, DEXP, DM, Wgu + (size_t)e * 512 * DM, kb * 64, nbk * 32, [](int v) { return v; },
                               [up](int j) { return 8 * (j >> 2) + 4 * up + (j & 3); }, scr, lane); continue; }
            r -= 2 * I_G;
            { const int e = r / 128, qq = r % 128, kb = qq / 32, nbk = qq % 32;
                transpose_item(p.w_ed + (size_t)e * DEXP * DM, DM, DEXP, Wd + (size_t)e * DM * DEXP, kb * 64, nbk * 32, [](int v) { return v; }, [](int v) { return v; }, scr, lane); }
        }
    }
}

struct ProbPlain {
    const bf16_t* A; const bf16_t* Bt; int K;
    __device__ __forceinline__ int a_row(const pg8::Unit& u, int r) const { return u.pm * 256 + r; }
    __device__ __forceinline__ const char* b_tile(const pg8::Unit& u) const { return (const char*)(Bt + (size_t)u.pn * 256 * K); }
};
struct EpiInProj {
    static constexpr bool PERM = true;
    bf16_t* proj; const float* tab;
    __device__ __forceinline__ void operator()(const pg8::f32x4 (&acc)[2][2][4][2], const pg8::Unit& u, int wr, int wc, int fr, int fq) const {
        const int row0 = u.pm * 256 + wr * 64 + fr, colt = u.pn * 256 + wc * 32 + 8 * fq;
        const int g = 4 * (wc & 1) + fq;
#pragma unroll
        for (int ai = 0; ai < 2; ++ai)
#pragma unroll
            for (int m = 0; m < 4; ++m) {
                const int row = row0 + ai * 128 + m * 16; const int pos = row & (SEQ - 1);
                bf16_t* rowp = proj + (size_t)row * NV + colt;
#pragma unroll
                for (int bj = 0; bj < 2; ++bj) {
                    pg8::f32x4 v0 = acc[ai][bj][m][0], v1 = acc[ai][bj][m][1];
                    const bool rope = (u.pn == 8) || (u.pn == 9) || (u.pn == 10 && bj == 0);
                    if (rope) {
                        const v4f t0 = *(const v4f*)(tab + (size_t)(pos * 32 + 4 * g) * 2), t1 = *(const v4f*)(tab + (size_t)(pos * 32 + 4 * g) * 2 + 4);
                        const pg8::f32x4 a = v0, b = v1;
                        v0[0] = a[0] * t0.x - b[0] * t0.y; v1[0] = a[0] * t0.y + b[0] * t0.x;
                        v0[1] = a[1] * t0.z - b[1] * t0.w; v1[1] = a[1] * t0.w + b[1] * t0.z;
                        v0[2] = a[2] * t1.x - b[2] * t1.y; v1[2] = a[2] * t1.y + b[2] * t1.x;
                        v0[3] = a[3] * t1.z - b[3] * t1.w; v1[3] = a[3] * t1.w + b[3] * t1.z;
                    }
                    pg8::u32x4 w; w.x = pg8::cvt_pk_bf16(v0[0], v0[1]); w.y = pg8::cvt_pk_bf16(v0[2], v0[3]); w.z = pg8::cvt_pk_bf16(v1[0], v1[1]); w.w = pg8::cvt_pk_bf16(v1[2], v1[3]);
                    *(pg8::u32x4*)(rowp + bj * 128) = w;
                }
                asm volatile("" ::: "memory");
            }
    }
};
__device__ __forceinline__ void ph_inproj(const P& p, unsigned char* lds_g, int bid, int nb) {
    ProbPlain G{(const bf16_t*)(p.ws + WS_MIX), (const bf16_t*)(p.ws + WS_WIN), DM};
    pg8::StaticOrder S; S.init(T, NV, nb, bid);
    EpiInProj E{(bf16_t*)(p.ws + WS_PROJ), (const float*)(p.ws + WS_TAB)};
    pg8::gemm_phase(( PG8_LAS unsigned char*)lds_g, G, S, E);
}

struct EpiOutProj {
    static constexpr bool PERM = true;
    const float* x; bf16_t* V;
    __device__ __forceinline__ void operator()(const pg8::f32x4 (&acc)[2][2][4][2], const pg8::Unit& u, int wr, int wc, int fr, int fq) const {
        const int row0 = u.pm * 256 + wr * 64 + fr, col0 = u.pn * 256 + wc * 32 + 8 * fq;
#pragma unroll
        for (int ai = 0; ai < 2; ++ai)
#pragma unroll
            for (int m = 0; m < 4; ++m) {
                const size_t off = (size_t)(row0 + ai * 128 + m * 16) * DM + col0;
#pragma unroll
                for (int bj = 0; bj < 2; ++bj) {
                    const pg8::f32x4 x0 = *(const pg8::f32x4*)(x + off + bj * 128), x1 = *(const pg8::f32x4*)(x + off + bj * 128 + 4);
                    const pg8::f32x4 v0 = x0 * ALPHA + acc[ai][bj][m][0], v1 = x1 * ALPHA + acc[ai][bj][m][1];
                    pg8::u32x4 w; w.x = pg8::cvt_pk_bf16(v0[0], v0[1]); w.y = pg8::cvt_pk_bf16(v0[2], v0[3]); w.z = pg8::cvt_pk_bf16(v1[0], v1[1]); w.w = pg8::cvt_pk_bf16(v1[2], v1[3]);
                    *(pg8::u32x4*)(V + off + bj * 128) = w; }
                if (m & 1) asm volatile("" ::: "memory");
            }
    }
};
__device__ __forceinline__ void ph_outproj(const P& p, unsigned char* lds_g, int bid, int nb) {
    ProbPlain G{(const bf16_t*)(p.ws + WS_MIX), (const bf16_t*)(p.ws + WS_WOUT), DM};
    pg8::StaticOrder S; S.init(T, DM, nb, bid);
    EpiOutProj E{p.x, (bf16_t*)(p.ws + WS_X1F)};
    pg8::gemm_phase((PG8_LAS unsigned char*)lds_g, G, S, E);
}

__device__ __forceinline__ void ph_rowpass1(const P& p, unsigned char* lds_g, int bid, int nb) {
    int tid = threadIdx.x; asm volatile("" : "+v"(tid));
    const int lane = tid & 63, wv = __builtin_amdgcn_readfirstlane(tid >> 6);
    LAS unsigned char* lds = (LAS unsigned char*)lds_g;
    constexpr int XT_STRIDE = 2064;
    LAS unsigned char* xt = lds;
    LAS float* lg = (LAS float*)(lds + 32 * XT_STRIDE);
    LAS int* lcnt = (LAS int*)(lds + 32 * XT_STRIDE + 6144);
    LAS int* lbase = lcnt + 32;
    LAS int* recn = lbase + 32;
    LAS int* rec_e = recn + 32;
    LAS int* rec_li = rec_e + 256;
    LAS int* rec_v = rec_li + 256;
    LAS float* rec_w = (LAS float*)(rec_v + 256);
    const bf16_t* V = (const bf16_t*)(p.ws + WS_X1F); bf16_t* x1b = (bf16_t*)(p.ws + WS_X1B);
    const bf16_t* Wr = (const bf16_t*)(p.ws + WS_WR);
    unsigned* gcnt = (unsigned*)(p.ws + WS_CTL) + CW_GCNT;
    int* slot_list = (int*)(p.ws + WS_SLOT); float* w_list = (float*)(p.ws + WS_WLIST);
    if (tid < 32) { lcnt[tid] = 0; if (tid == 0) recn[0] = 0; }
    v4f lw[4], lb[4];
#pragma unroll
    for (int j = 0; j < 4; ++j) { lw[j] = *((const v4f*)p.ln1_w + lane + 64 * j); lb[j] = *((const v4f*)p.ln1_b + lane + 64 * j); }
    __syncthreads();
    for (int tile = bid; tile < T / 32; tile += nb) {
        const int row0 = tile * 32;
#pragma unroll 1
        for (int rr = 0; rr < 4; ++rr) {
            const int lr = wv * 4 + rr; const size_t row = (size_t)(row0 + lr);
            const unsigned long long* vr = (const unsigned long long*)(V + row * DM) + lane;
            v4f v[4]; float s = 0.f;
#pragma unroll
            for (int j = 0; j < 4; ++j) { const unsigned long long a = vr[64 * j];
                v[j].x = __uint_as_float((unsigned)a << 16); v[j].y = __uint_as_float((unsigned)a & 0xffff0000u);
                v[j].z = __uint_as_float((unsigned)(a >> 32) << 16); v[j].w = __uint_as_float((unsigned)(a >> 32) & 0xffff0000u);
                s += (v[j].x + v[j].y) + (v[j].z + v[j].w); }
            const float mu = wave_sum(s) * (1.f / DM); float q = 0.f;
#pragma unroll
            for (int j = 0; j < 4; ++j) { v[j] = v[j] - mu; q += (v[j].x * v[j].x + v[j].y * v[j].y) + (v[j].z * v[j].z + v[j].w * v[j].w); }
            const float rs = 1.f / sqrtf(wave_sum(q) * (1.f / DM) + LN_EPS);
            unsigned long long* o8 = (unsigned long long*)(x1b + row * DM) + lane;
#pragma unroll
            for (int j = 0; j < 4; ++j) { const v4f o = v[j] * rs * lw[j] + lb[j];
                const unsigned long long pk = (unsigned long long)pk2(o.x, o.y) | ((unsigned long long)pk2(o.z, o.w) << 32);
                o8[64 * j] = pk; *(LAS unsigned long long*)(xt + lr * XT_STRIDE + (256 * j + 4 * lane) * 2) = pk; }
        }
        __syncthreads();
        if (wv < 6) {
            const int mt = wv / 3, ntl = wv % 3;
            pg8::f32x4 acc = {0.f, 0.f, 0.f, 0.f};
            const LAS unsigned char* ap = xt + (mt * 16 + (lane & 15)) * XT_STRIDE + (lane >> 4) * 16;
            const bf16_t* bp = Wr + (size_t)(ntl * 16 + (lane & 15)) * DM + (lane >> 4) * 8;
#pragma unroll 8
            for (int ks = 0; ks < 32; ++ks) {
                const pg8::bf16x8 a = *(const LAS pg8::bf16x8*)(ap + ks * 64);
                const pg8::bf16x8 b = *(const pg8::bf16x8*)(bp + ks * 32);
                acc = __builtin_amdgcn_mfma_f32_16x16x32_bf16(a, b, acc, 0, 0, 0);
            }
#pragma unroll
            for (int j = 0; j < 4; ++j) lg[(mt * 16 + 4 * (lane >> 4) + j) * 48 + ntl * 16 + (lane & 15)] = acc[j];
        }
        __syncthreads();
        if (tid < 32) {
            const LAS float* l = lg + tid * 48; const int row = row0 + tid;
            float g[4]; int gi = 0;
#pragma unroll
            for (int j = 0; j < 4; ++j) g[j] = l[j] + p.b_gr[j];
            float gm = g[0];
#pragma unroll
            for (int j = 1; j < 4; ++j) if (g[j] > gm) { gm = g[j]; gi = j; }
            float gs = 0.f;
#pragma unroll
            for (int j = 0; j < 4; ++j) gs += expf(g[j] - gm);
            const float gp = 1.f / gs;
            float ev[8];
#pragma unroll
            for (int j = 0; j < 8; ++j) ev[j] = l[4 + gi * 8 + j] + p.b_er[gi * 8 + j];
            int i0 = 0; float v0 = ev[0];
#pragma unroll
            for (int j = 1; j < 8; ++j) if (ev[j] > v0) { v0 = ev[j]; i0 = j; }
            int i1 = -1; float v1 = -INFINITY;
#pragma unroll
            for (int j = 0; j < 8; ++j) if (j != i0 && ev[j] > v1) { v1 = ev[j]; i1 = j; }
            const float e1 = expf(v1 - v0); const float w0 = gp / (1.f + e1), w1 = gp * e1 / (1.f + e1);
            const int e_0 = gi * 8 + i0, e_1 = gi * 8 + i1;
            const int li0 = atomicAdd((int*)(lcnt + e_0), 1), li1 = atomicAdd((int*)(lcnt + e_1), 1);
            const int ri = atomicAdd((int*)recn, 2);
            rec_e[ri] = e_0; rec_li[ri] = li0; rec_v[ri] = row * 2; rec_w[ri] = w0;
            rec_e[ri + 1] = e_1; rec_li[ri + 1] = li1; rec_v[ri + 1] = row * 2 + 1; rec_w[ri + 1] = w1;
        }
        __syncthreads();
    }
    if (tid < 32) lbase[tid] = (int)atomicAdd(gcnt + tid, (unsigned)lcnt[tid]);
    __syncthreads();
    const int nrec = recn[0];
    for (int i = tid; i < nrec; i += 512) { const int e = rec_e[i]; const int pos = lbase[e] + rec_li[i]; slot_list[(size_t)e * T + pos] = rec_v[i]; w_list[(size_t)e * T + pos] = rec_w[i]; }
    __syncthreads();
}

constexpr int MOE_TAB_OFF = 131072;
__device__ __forceinline__ void moe_tables(const P& p, unsigned char* lds_g) {
    LAS int* tab = (LAS int*)((LAS unsigned char*)lds_g + MOE_TAB_OFF);
    const unsigned* gcnt = (const unsigned*)(p.ws + WS_CTL) + CW_GCNT;
    if (threadIdx.x == 0) { int acc = 0;
        for (int e = 0; e < NEXP; ++e) { const int c = (int)__hip_atomic_load(gcnt + e, __ATOMIC_RELAXED, __HIP_MEMORY_SCOPE_AGENT); tab[e] = acc; tab[33 + e] = c; acc += (c + 255) >> 8; }
        tab[32] = acc; }
    __syncthreads();
}
struct MoeOrder {
    const LAS int* tab; int nN, G, c;
    __device__ __forceinline__ bool next(int i, pg8::Unit& u) const {
        const int L = i * G + c; const int ntile = tab[32];
        if (L >= ntile * nN) return false;
        const int ti = L / nN; int e = 0;
#pragma unroll 1
        for (int k = 1; k < NEXP; ++k) e = (tab[k] <= ti) ? k : e;
        u.e = e; u.mt = ti - tab[e]; u.pm = ti; u.pn = L % nN; return true;
    }
};
struct ProbGU {
    const bf16_t* A; const bf16_t* Bt; int K; const LAS int* tab; const int* slot_list;
    __device__ __forceinline__ int a_row(const pg8::Unit& u, int r) const { const int idx = u.mt * 256 + r; return idx < tab[33 + u.e] ? (slot_list[(size_t)u.e * T + idx] >> 1) : 0; }
    __device__ __forceinline__ const char* b_tile(const pg8::Unit& u) const { return (const char*)(Bt + ((size_t)u.e * 512 + (size_t)u.pn * 256) * DM); }
};
struct EpiGU {
    static constexpr bool PERM = true;
    bf16_t* H; const LAS int* tab; const float* w_list;
    __device__ __forceinline__ void operator()(const pg8::f32x4 (&acc)[2][2][4][2], const pg8::Unit& u, int wr, int wc, int fr, int fq) const {
        const int r0 = wr * 64 + fr; const int cnt = tab[33 + u.e];
        float wrow[2][4];
#pragma unroll
        for (int ai = 0; ai < 2; ++ai)
#pragma unroll
            for (int m = 0; m < 4; ++m) { const int idx = u.mt * 256 + r0 + ai * 128 + m * 16; wrow[ai][m] = idx < cnt ? w_list[(size_t)u.e * T + idx] : 0.f; }
#pragma unroll
        for (int ai = 0; ai < 2; ++ai)
#pragma unroll
            for (int m = 0; m < 4; ++m) {
                bf16_t* hp = H + (size_t)(u.pm * 256 + r0 + ai * 128 + m * 16) * DEXP + u.pn * 128 + wc * 16 + 4 * fq;
#pragma unroll
                for (int bj = 0; bj < 2; ++bj) { const pg8::f32x4 g = acc[ai][bj][m][0], uu = acc[ai][bj][m][1]; float h[4];
#pragma unroll
                    for (int i = 0; i < 4; ++i) h[i] = g[i] * __builtin_amdgcn_rcpf(1.f + __expf(-g[i])) * uu[i] * wrow[ai][m];
                    pg8::u32x2 w; w.x = pg8::cvt_pk_bf16(h[0], h[1]); w.y = pg8::cvt_pk_bf16(h[2], h[3]);
                    *(pg8::u32x2*)(hp + bj * 64) = w; }
            }
    }
};
struct ProbDown {
    const bf16_t* A; const bf16_t* Bt; int K;
    __device__ __forceinline__ int a_row(const pg8::Unit& u, int r) const { return u.pm * 256 + r; }
    __device__ __forceinline__ const char* b_tile(const pg8::Unit& u) const { return (const char*)(Bt + ((size_t)u.e * DM + (size_t)u.pn * 256) * DEXP); }
};
struct EpiDown {
    static constexpr bool PERM = true;
    bf16_t* Y; const LAS int* tab; const int* slot_list;
    __device__ __forceinline__ void operator()(const pg8::f32x4 (&acc)[2][2][4][2], const pg8::Unit& u, int wr, int wc, int fr, int fq) const {
        const int r0 = wr * 64 + fr; const int cnt = tab[33 + u.e];
        int drow[2][4];
#pragma unroll
        for (int ai = 0; ai < 2; ++ai)
#pragma unroll
            for (int m = 0; m < 4; ++m) { const int idx = u.mt * 256 + r0 + ai * 128 + m * 16; drow[ai][m] = idx < cnt ? slot_list[(size_t)u.e * T + idx] : -1; }
#pragma unroll
        for (int ai = 0; ai < 2; ++ai)
#pragma unroll
            for (int m = 0; m < 4; ++m) if (drow[ai][m] >= 0) {
                bf16_t* yp = Y + (size_t)drow[ai][m] * DM + u.pn * 256 + wc * 32 + 8 * fq;
#pragma unroll
                for (int bj = 0; bj < 2; ++bj) { const pg8::f32x4 v0 = acc[ai][bj][m][0], v1 = acc[ai][bj][m][1];
                    pg8::u32x4 w; w.x = pg8::cvt_pk_bf16(v0[0], v0[1]); w.y = pg8::cvt_pk_bf16(v0[2], v0[3]); w.z = pg8::cvt_pk_bf16(v1[0], v1[1]); w.w = pg8::cvt_pk_bf16(v1[2], v1[3]);
                    *(pg8::u32x4*)(yp + bj * 128) = w; }
            }
    }
};
__device__ __forceinline__ void ph_moe_gu(const P& p, unsigned char* lds_g, int bid, int nb) {
    moe_tables(p, lds_g);
    const LAS int* tab = (const LAS int*)((LAS unsigned char*)lds_g + MOE_TAB_OFF);
    ProbGU G{(const bf16_t*)(p.ws + WS_X1B), (const bf16_t*)(p.ws + WS_WGU), DM, tab, (const int*)(p.ws + WS_SLOT)};
    MoeOrder S{tab, 2, nb, bid};
    EpiGU E{(bf16_t*)(p.ws + WS_H), tab, (const float*)(p.ws + WS_WLIST)};
    pg8::gemm_phase((PG8_LAS unsigned char*)lds_g, G, S, E);
}
__device__ __forceinline__ void ph_moe_down(const P& p, unsigned char* lds_g, int bid, int nb) {
    const LAS int* tab = (const LAS int*)((LAS unsigned char*)lds_g + MOE_TAB_OFF);
    ProbDown G{(const bf16_t*)(p.ws + WS_H), (const bf16_t*)(p.ws + WS_WD), DEXP};
    MoeOrder S{tab, 4, nb, bid};
    EpiDown E{(bf16_t*)(p.ws + WS_Y), tab, (const int*)(p.ws + WS_SLOT)};
    pg8::gemm_phase((PG8_LAS unsigned char*)lds_g, G, S, E);
}
__device__ __forceinline__ void ph_rowpass2(const P& p, int bid, int nb) {
    const int tid = threadIdx.x, lane = tid & 63, wv = tid >> 6;
    const bf16_t* x1b = (const bf16_t*)(p.ws + WS_X1B); const bf16_t* Y = (const bf16_t*)(p.ws + WS_Y);
    v4f lw[4], lb[4];
#pragma unroll
    for (int j = 0; j < 4; ++j) { lw[j] = *((const v4f*)p.ln2_w + lane + 64 * j); lb[j] = *((const v4f*)p.ln2_b + lane + 64 * j); }
    for (int row = bid * 8 + wv; row < T; row += nb * 8) {
        const unsigned long long* xr = (const unsigned long long*)(x1b + (size_t)row * DM) + lane;
        const unsigned long long* y0 = (const unsigned long long*)(Y + (size_t)row * 2 * DM) + lane;
        const unsigned long long* y1 = y0 + DM / 4;
        v4f v[4]; float s = 0.f;
#pragma unroll
        for (int j = 0; j < 4; ++j) { const unsigned long long a = xr[64 * j], b = y0[64 * j], c = y1[64 * j];
            v[j].x = ALPHA * __uint_as_float((unsigned)a << 16) + __uint_as_float((unsigned)b << 16) + __uint_as_float((unsigned)c << 16);
            v[j].y = ALPHA * __uint_as_float((unsigned)a & 0xffff0000u) + __uint_as_float((unsigned)b & 0xffff0000u) + __uint_as_float((unsigned)c & 0xffff0000u);
            v[j].z = ALPHA * __uint_as_float((unsigned)(a >> 32) << 16) + __uint_as_float((unsigned)(b >> 32) << 16) + __uint_as_float((unsigned)(c >> 32) << 16);
            v[j].w = ALPHA * __uint_as_float((unsigned)(a >> 32) & 0xffff0000u) + __uint_as_float((unsigned)(b >> 32) & 0xffff0000u) + __uint_as_float((unsigned)(c >> 32) & 0xffff0000u);
            s += (v[j].x + v[j].y) + (v[j].z + v[j].w); }
        const float mu = wave_sum(s) * (1.f / DM); float q = 0.f;
#pragma unroll
        for (int j = 0; j < 4; ++j) { v[j] = v[j] - mu; q += (v[j].x * v[j].x + v[j].y * v[j].y) + (v[j].z * v[j].z + v[j].w * v[j].w); }
        const float rs = 1.f / sqrtf(wave_sum(q) * (1.f / DM) + LN_EPS);
        v4f* o = (v4f*)(p.out + (size_t)row * DM) + lane;
#pragma unroll
        for (int j = 0; j < 4; ++j) o[64 * j] = v[j] * rs * lw[j] + lb[j];
    }
}

typedef float f32x16 __attribute__((ext_vector_type(16)));
typedef unsigned u32x2_t __attribute__((ext_vector_type(2)));
__device__ __forceinline__ void ph_swa(const P& p, unsigned char* lds_g, int bid, int nb) {
    int tid = threadIdx.x; asm volatile("" : "+v"(tid));
    const int lane = tid & 63, wv = __builtin_amdgcn_readfirstlane(tid >> 6);
    const int g = wv & 3, hf = wv >> 2, r32 = lane & 31, hi = lane >> 5;
    LAS unsigned char* Ks = (LAS unsigned char*)lds_g;
    LAS unsigned char* Vt = Ks + 256 * 144;
    const bf16_t* proj = (const bf16_t*)(p.ws + WS_PROJ); bf16_t* mix = (bf16_t*)(p.ws + WS_MIX);
    constexpr float LOG2E = 1.4426950408889634f, SC = 0.125f * LOG2E;
    for (int unit = bid; unit < BATCH * AKH * (SEQ / 128); unit += nb) {
        const int b = unit / (AKH * 64), rem = unit % (AKH * 64), kvh = rem / 64, blk = rem % 64, q0 = blk * 128;
#pragma unroll
        for (int i = 0; i < 4; ++i) {
            const int c = tid + 512 * i, wl = c >> 3, ch = c & 7, pos = q0 - 128 + wl;
            v4u kv = {0u, 0u, 0u, 0u}, vv = {0u, 0u, 0u, 0u};
            if (pos >= 0) { const bf16_t* rp = proj + (size_t)(b * SEQ + pos) * NV + kvh * 64 + ch * 8; kv = *(const v4u*)(rp + PC_AK); vv = *(const v4u*)(rp + PC_AV); }
            *(LAS v4u*)(Ks + wl * 144 + ch * 16) = kv;
#pragma unroll
            for (int j = 0; j < 8; ++j) *(LAS unsigned short*)(Vt + (ch * 8 + j) * 520 + wl * 2) = (unsigned short)(vv[j >> 1] >> (16 * (j & 1)));
        }
        __syncthreads();
        const int hq = kvh * 4 + g; const float sink2 = p.sinks[hq] * LOG2E;
#pragma unroll 1
        for (int i = 0; i < 2; ++i) {
            const size_t row = (size_t)(b * SEQ + q0 + 64 * hf + 32 * i + r32);
            pg8::bf16x8 qf[4];
#pragma unroll
            for (int ks = 0; ks < 4; ++ks) qf[ks] = *(const pg8::bf16x8*)(proj + row * NV + PC_AQ + hq * 64 + 16 * ks + 8 * hi);
            const int t0 = 2 * hf + i;
            f32x16 sacc[5];
#pragma unroll
            for (int kt = 0; kt < 5; ++kt) {
                f32x16 acc = {0.f, 0.f, 0.f, 0.f, 0.f, 0.f, 0.f, 0.f, 0.f, 0.f, 0.f, 0.f, 0.f, 0.f, 0.f, 0.f};
                const LAS unsigned char* kp = Ks + (32 * (t0 + kt) + r32) * 144 + 16 * hi;
#pragma unroll
                for (int ks = 0; ks < 4; ++ks) acc = __builtin_amdgcn_mfma_f32_32x32x16_bf16(*(const LAS pg8::bf16x8*)(kp + 32 * ks), qf[ks], acc, 0, 0, 0);
                sacc[kt] = acc;
            }
            float m2 = sink2;
#pragma unroll
            for (int kt = 0; kt < 5; ++kt) {
                const bool tvalid = (blk > 0) || (t0 + kt >= 4);
#pragma unroll
                for (int r = 0; r < 16; ++r) {
                    const int kc = (r & 3) + 8 * (r >> 2) + 4 * hi;
                    bool ok = tvalid;
                    if (kt == 0) ok = ok && (kc > r32);
                    if (kt == 4) ok = ok && (kc <= r32);
                    const float s = ok ? sacc[kt][r] * SC : -INFINITY;
                    sacc[kt][r] = s; m2 = fmaxf(m2, s);
                }
            }
            m2 = fmaxf(m2, __shfl_xor(m2, 32));
            float l = 0.f;
#pragma unroll
            for (int kt = 0; kt < 5; ++kt)
#pragma unroll
                for (int r = 0; r < 16; ++r) { const float e = __builtin_amdgcn_exp2f(sacc[kt][r] - m2); sacc[kt][r] = e; l += e; }
            l += __shfl_xor(l, 32); l += __builtin_amdgcn_exp2f(sink2 - m2);
            f32x16 o[2];
            o[0] = (f32x16){0.f, 0.f, 0.f, 0.f, 0.f, 0.f, 0.f, 0.f, 0.f, 0.f, 0.f, 0.f, 0.f, 0.f, 0.f, 0.f}; o[1] = o[0];
#pragma unroll
            for (int kt = 0; kt < 5; ++kt)
#pragma unroll
                for (int s2 = 0; s2 < 2; ++s2) {
                    v4u pw; pw.x = pg8::cvt_pk_bf16(sacc[kt][8 * s2 + 0], sacc[kt][8 * s2 + 1]); pw.y = pg8::cvt_pk_bf16(sacc[kt][8 * s2 + 2], sacc[kt][8 * s2 + 3]);
                    pw.z = pg8::cvt_pk_bf16(sacc[kt][8 * s2 + 4], sacc[kt][8 * s2 + 5]); pw.w = pg8::cvt_pk_bf16(sacc[kt][8 * s2 + 6], sacc[kt][8 * s2 + 7]);
                    const pg8::bf16x8 pf = __builtin_bit_cast(pg8::bf16x8, pw);
#pragma unroll
                    for (int dt = 0; dt < 2; ++dt) {
                        const LAS unsigned char* vp = Vt + (32 * dt + r32) * 520 + (32 * (t0 + kt) + 16 * s2 + 4 * hi) * 2;
                        const u32x2_t c1 = *(const LAS u32x2_t*)vp, c2 = *(const LAS u32x2_t*)(vp + 16);
                        v4u vw; vw.x = c1.x; vw.y = c1.y; vw.z = c2.x; vw.w = c2.y;
                        o[dt] = __builtin_amdgcn_mfma_f32_32x32x16_bf16(__builtin_bit_cast(pg8::bf16x8, vw), pf, o[dt], 0, 0, 0);
                    }
                }
            const float inv = 1.f / l;
            bf16_t* op = mix + row * DM + 512 + hq * 64 + 4 * hi;
#pragma unroll
            for (int dt = 0; dt < 2; ++dt)
#pragma unroll
                for (int r4 = 0; r4 < 4; ++r4) {
                    u32x2_t w; w.x = pg8::cvt_pk_bf16(o[dt][4 * r4] * inv, o[dt][4 * r4 + 1] * inv); w.y = pg8::cvt_pk_bf16(o[dt][4 * r4 + 2] * inv, o[dt][4 * r4 + 3] * inv);
                    *(u32x2_t*)(op + 32 * dt + 8 * r4) = w;
                }
        }
        __syncthreads();
    }
}

constexpr size_t WS_QKC = WS_X1B;
constexpr size_t WS_DC = WS_H;
constexpr size_t WS_DN = 336 * MiB, WS_NST = WS_DN + 512 * 1024, WS_SCAL = WS_NST + 512 * 1024;
constexpr int KT_STRIDE = 272;

__device__ __forceinline__ float scan_add64(float v, int lane) {
#pragma unroll
    for (int o = 1; o < 64; o <<= 1) { const float t = __shfl_up(v, o); v = (lane >= o) ? v + t : v; }
    return v;
}
__device__ __forceinline__ float scan_max64(float v, int lane) {
#pragma unroll
    for (int o = 1; o < 64; o <<= 1) { const float t = __shfl_up(v, o); v = (lane >= o) ? fmaxf(v, t) : v; }
    return v;
}
__device__ __forceinline__ void gate_scan(const float* gates, size_t row0, int h, int lane, float& b0, float& b1, float& a0, float& a1) {
    const float* g0 = gates + (row0 + 2 * lane) * 8; const float* g1 = g0 + 8;
    const float i0 = g0[h], i1 = g1[h], lf0 = logsigmoid_f(g0[4 + h]), lf1 = logsigmoid_f(g1[4 + h]);
    const float pair = lf0 + lf1, incl = scan_add64(pair, lane), excl = incl - pair;
    b0 = excl + lf0; b1 = incl; a0 = i0 - b0; a1 = i1 - b1;
}
template <int WHICH>
__device__ __forceinline__ void conv_stage(const P& p, const bf16_t* proj, bf16_t* qkc, LAS unsigned char* Kt, int b, int h, int chunk, int cc, int tg) {
    const int colb = WHICH * 512 + h * 128 + cc * 8;
    float w[4][8], bias[8];
#pragma unroll
    for (int j = 0; j < 4; ++j) { const v4f w0 = *(const v4f*)(p.conv_w + j * 1024 + colb), w1 = *(const v4f*)(p.conv_w + j * 1024 + colb + 4);
        w[j][0] = w0.x; w[j][1] = w0.y; w[j][2] = w0.z; w[j][3] = w0.w; w[j][4] = w1.x; w[j][5] = w1.y; w[j][6] = w1.z; w[j][7] = w1.w; }
    { const v4f b0 = *(const v4f*)(p.conv_b + colb), b1 = *(const v4f*)(p.conv_b + colb + 4);
      bias[0] = b0.x; bias[1] = b0.y; bias[2] = b0.z; bias[3] = b0.w; bias[4] = b1.x; bias[5] = b1.y; bias[6] = b1.z; bias[7] = b1.w; }
    v4u u[7];
#pragma unroll
    for (int rr = 0; rr < 7; ++rr) { const int t = chunk * 128 + 4 * tg - 3 + rr;
        u[rr] = (v4u){0u, 0u, 0u, 0u};
        if (t >= 0) u[rr] = *(const v4u*)(proj + (size_t)(b * SEQ + t) * NV + colb); }
#pragma unroll
    for (int tt = 0; tt < 4; ++tt) {
        float o[8];
#pragma unroll
        for (int c = 0; c < 8; ++c) o[c] = bias[c];
#pragma unroll
        for (int j = 0; j < 4; ++j)
#pragma unroll
            for (int c = 0; c < 8; ++c) { const unsigned wd = u[tt + j][c >> 1]; const float uv = __uint_as_float((c & 1) ? (wd & 0xffff0000u) : (wd << 16)); o[c] += w[j][c] * uv; }
#pragma unroll
        for (int c = 0; c < 8; ++c) { o[c] = fsilu(o[c]); if (WHICH) o[c] *= 0.08838834764831845f; }
        v4u pk; pk.x = pk2(o[0], o[1]); pk.y = pk2(o[2], o[3]); pk.z = pk2(o[4], o[5]); pk.w = pk2(o[6], o[7]);
        const int tok = 4 * tg + tt;
        *(v4u*)(qkc + (size_t)(b * SEQ + chunk * 128 + tok) * DM + colb) = pk;
        if (WHICH) {
#pragma unroll
            for (int c = 0; c < 8; ++c) *(LAS unsigned short*)(Kt + (cc * 8 + c) * KT_STRIDE + tok * 2) = (unsigned short)(pk[c >> 1] >> (16 * (c & 1)));
        }
    }
}

constexpr int A1_HALF_BYTES = 2 * 128 * KT_STRIDE + 512;
__device__ __forceinline__ void ph_mlstm_a1(const P& p, unsigned char* lds_g, int bid, int nb) {
    int tid = threadIdx.x; asm volatile("" : "+v"(tid));
    const int lane = tid & 63, wv = __builtin_amdgcn_readfirstlane(tid >> 6), r32 = lane & 31, hi = lane >> 5;
    const int half = wv >> 2, hw = wv & 3, htid = tid & 255;
    LAS unsigned char* Kt = (LAS unsigned char*)lds_g + half * A1_HALF_BYTES;
    LAS unsigned char* Vt = Kt + 128 * KT_STRIDE;
    LAS float* wsh = (LAS float*)(Vt + 128 * KT_STRIDE);
    const bf16_t* proj = (const bf16_t*)(p.ws + WS_PROJ); const float* gates = (const float*)(p.ws + WS_GATES);
    bf16_t* qkc = (bf16_t*)(p.ws + WS_QKC); bf16_t* dC = (bf16_t*)(p.ws + WS_DC);
    float* dn = (float*)(p.ws + WS_DN); float* scal = (float*)(p.ws + WS_SCAL);
    for (int it0 = bid * 2; it0 < BATCH * MLH * 64; it0 += nb * 2) {
        const int item = it0 + half;
        const int bh = item >> 6, chunk = item & 63, b = bh >> 2, h = bh & 3; const size_t row0 = (size_t)b * SEQ + chunk * 128;
        if (hw == 0) {
            float b0, b1, a0, a1; gate_scan(gates, row0, h, lane, b0, b1, a0, a1);
            const float amax = wave_max(fmaxf(a0, a1)); const float blast = __shfl(b1, 63);
            wsh[2 * lane] = expf(a0 - amax); wsh[2 * lane + 1] = expf(a1 - amax);
            if (lane == 0) { scal[bh * 64 + chunk] = blast + amax; scal[1024 + bh * 64 + chunk] = blast; }
        }
#pragma unroll 1
        for (int tq = 0; tq < 2; ++tq) {
            conv_stage<0>(p, proj, qkc, Kt, b, h, chunk, htid & 15, (htid >> 4) + 16 * tq);
            conv_stage<1>(p, proj, qkc, Kt, b, h, chunk, htid & 15, (htid >> 4) + 16 * tq);
        }
        __syncthreads();
#pragma unroll
        for (int i = 0; i < 8; ++i) { const int idx = htid + 256 * i, s = idx >> 4, ec = idx & 15;
            const v4u vv = *(const v4u*)(proj + (row0 + s) * NV + PC_MV + h * 128 + ec * 8); const float ws = wsh[s];
#pragma unroll
            for (int j2 = 0; j2 < 4; ++j2) { const unsigned wd = vv[j2]; const unsigned pk = pk2(__uint_as_float(wd << 16) * ws, __uint_as_float(wd & 0xffff0000u) * ws);
                *(LAS unsigned short*)(Vt + (ec * 8 + 2 * j2) * KT_STRIDE + s * 2) = (unsigned short)pk; *(LAS unsigned short*)(Vt + (ec * 8 + 2 * j2 + 1) * KT_STRIDE + s * 2) = (unsigned short)(pk >> 16); } }
        __syncthreads();
        {
            f32x16 acc[4];
#pragma unroll
            for (int j = 0; j < 4; ++j) acc[j] = (f32x16){0.f, 0.f, 0.f, 0.f, 0.f, 0.f, 0.f, 0.f, 0.f, 0.f, 0.f, 0.f, 0.f, 0.f, 0.f, 0.f};
            const LAS unsigned char* ap = Vt + (32 * hw + r32) * KT_STRIDE + 16 * hi;
#pragma unroll
            for (int ks = 0; ks < 8; ++ks) { const pg8::bf16x8 a = *(const LAS pg8::bf16x8*)(ap + 32 * ks);
#pragma unroll
                for (int j = 0; j < 4; ++j) {
                    const pg8::bf16x8 bb = *(const LAS pg8::bf16x8*)(Kt + (32 * j + r32) * KT_STRIDE + 16 * hi + 32 * ks);
                    acc[j] = __builtin_amdgcn_mfma_f32_32x32x16_bf16(a, bb, acc[j], 0, 0, 0); } }
            bf16_t* out = dC + ((size_t)item * 128) * 128;
#pragma unroll
            for (int j = 0; j < 4; ++j)
#pragma unroll
                for (int r = 0; r < 16; r += 2) { const int e = 32 * hw + (r & 3) + 8 * (r >> 2) + 4 * hi; const unsigned pk = pk2(acc[j][r], acc[j][r + 1]);
                    out[(size_t)e * 128 + 32 * j + r32] = (bf16_t)pk; out[(size_t)(e + 1) * 128 + 32 * j + r32] = (bf16_t)(pk >> 16); }
        }
        if (htid < 128) {
            float a = 0.f; const LAS unsigned char* kp = Kt + htid * KT_STRIDE;
            for (int s8 = 0; s8 < 16; ++s8) { const v4u kk = *(const LAS v4u*)(kp + s8 * 16);
#pragma unroll
                for (int j = 0; j < 8; ++j) { const unsigned wd = kk[j >> 1]; a += __uint_as_float((j & 1) ? (wd & 0xffff0000u) : (wd << 16)) * wsh[s8 * 8 + j]; } }
            dn[(size_t)item * 128 + htid] = a;
        }
        __syncthreads();
    }
}

__device__ __forceinline__ void ph_mlstm_a2(const P& p, unsigned char* lds_g, int bid, int nb) {
    const int tid = threadIdx.x;
    LAS float* dec = (LAS float*)lds_g; LAS float* gg = dec + 64;
    const bf16_t* dC = (const bf16_t*)(p.ws + WS_DC); bf16_t* Cst = (bf16_t*)(p.ws + WS_CST);
    const float* dn = (const float*)(p.ws + WS_DN); float* nst = (float*)(p.ws + WS_NST); float* scal = (float*)(p.ws + WS_SCAL);
    for (int it = bid; it < 256; it += nb) {
        const int bh = it >> 4, part = it & 15;
        if (tid == 0) { float m = 0.f;
            for (int k = 0; k < 64; ++k) { const float al = scal[bh * 64 + k], bl = scal[1024 + bh * 64 + k]; const float mn = fmaxf(bl + m, al);
                dec[k] = expf(bl + m - mn); gg[k] = expf(al - mn); if (part == 0) scal[2048 + bh * 64 + k] = m; m = mn; } }
        __syncthreads();
        {
            const size_t eoff = (size_t)part * 1024 + 2 * tid;
            const unsigned* src = (const unsigned*)(dC + (size_t)bh * 64 * 16384 + eoff); unsigned* dst = (unsigned*)(Cst + (size_t)bh * 64 * 16384 + eoff);
            float c0 = 0.f, c1 = 0.f;
#pragma unroll 8
            for (int k = 0; k < 64; ++k) { const unsigned d = src[(size_t)k * 8192];
                dst[(size_t)k * 8192] = pk2(c0, c1);
                c0 = dec[k] * c0 + gg[k] * __uint_as_float(d << 16); c1 = dec[k] * c1 + gg[k] * __uint_as_float(d & 0xffff0000u); }
        }
        if (part == 0 && tid < 128) { float n = 0.f;
            for (int k = 0; k < 64; ++k) { nst[((size_t)bh * 64 + k) * 128 + tid] = n; n = dec[k] * n + gg[k] * dn[((size_t)bh * 64 + k) * 128 + tid]; } }
        __syncthreads();
    }
}

constexpr int VT_STRIDE = 264;
constexpr int B_HALF_BYTES = 128 * KT_STRIDE + 128 * VT_STRIDE + 2048;
__device__ __forceinline__ void ph_mlstm_b(const P& p, unsigned char* lds_g, int bid, int nb) {
    int tid = threadIdx.x; asm volatile("" : "+v"(tid));
    const int lane = tid & 63, wv = __builtin_amdgcn_readfirstlane(tid >> 6), r32 = lane & 31, hi = lane >> 5;
    const int half = wv >> 2, lt = wv & 3, htid = tid & 255;
    LAS unsigned char* Ks = (LAS unsigned char*)lds_g + half * B_HALF_BYTES;
    LAS unsigned char* Vt = Ks + 128 * KT_STRIDE;
    LAS float* a2s = (LAS float*)(Vt + 128 * VT_STRIDE);
    LAS float* M2s = a2s + 128;
    LAS float* wis = M2s + 128;
    LAS float* ems = wis + 128;
    const bf16_t* proj = (const bf16_t*)(p.ws + WS_PROJ); const float* gates = (const float*)(p.ws + WS_GATES);
    const bf16_t* qkc = (const bf16_t*)(p.ws + WS_QKC); const bf16_t* Cst = (const bf16_t*)(p.ws + WS_CST);
    const float* nst = (const float*)(p.ws + WS_NST); const float* scal = (const float*)(p.ws + WS_SCAL);
    bf16_t* mix = (bf16_t*)(p.ws + WS_MIX);
    constexpr float LOG2E = 1.4426950408889634f;
    for (int it0 = bid * 2; it0 < BATCH * MLH * 64; it0 += nb * 2) {
        const int item = it0 + half;
        const int bh = item >> 6, chunk = item & 63, b = bh >> 2, h = bh & 3; const size_t row0 = (size_t)b * SEQ + chunk * 128;
        const float mk = scal[2048 + bh * 64 + chunk];
        if (lt == 0) {
            float b0, b1, a0, a1; gate_scan(gates, row0, h, lane, b0, b1, a0, a1);
            const float incl = scan_max64(fmaxf(a0, a1), lane); float excl = __shfl_up(incl, 1); if (lane == 0) excl = -INFINITY;
            const float M0 = fmaxf(mk, fmaxf(excl, a0)), M1 = fmaxf(mk, incl);
            a2s[2 * lane] = a0 * LOG2E; a2s[2 * lane + 1] = a1 * LOG2E; M2s[2 * lane] = M0 * LOG2E; M2s[2 * lane + 1] = M1 * LOG2E;
            wis[2 * lane] = expf(mk - M0); wis[2 * lane + 1] = expf(mk - M1); ems[2 * lane] = expf(-b0 - M0); ems[2 * lane + 1] = expf(-b1 - M1);
        }
#pragma unroll
        for (int i = 0; i < 8; ++i) { const int idx = htid + 256 * i, s = idx >> 4, ch = idx & 15;
            *(LAS v4u*)(Ks + s * KT_STRIDE + ch * 16) = *(const v4u*)(qkc + (row0 + s) * DM + 512 + h * 128 + ch * 8);
            const v4u vv = *(const v4u*)(proj + (row0 + s) * NV + PC_MV + h * 128 + ch * 8);
#pragma unroll
            for (int j = 0; j < 8; ++j) *(LAS unsigned short*)(Vt + (ch * 8 + j) * VT_STRIDE + s * 2) = (unsigned short)(vv[j >> 1] >> (16 * (j & 1))); }
        const int l = 32 * lt + r32; const size_t row = row0 + l;
        pg8::bf16x8 qf[8];
#pragma unroll
        for (int ks = 0; ks < 8; ++ks) qf[ks] = *(const pg8::bf16x8*)(qkc + row * DM + h * 128 + 16 * ks + 8 * hi);
        f32x16 acc[4];
#pragma unroll
        for (int j = 0; j < 4; ++j) acc[j] = (f32x16){0.f, 0.f, 0.f, 0.f, 0.f, 0.f, 0.f, 0.f, 0.f, 0.f, 0.f, 0.f, 0.f, 0.f, 0.f, 0.f};
        float dq = 0.f;
        {
            const bf16_t* Cb = Cst + (size_t)item * 16384; const float* nb_ = nst + (size_t)item * 128;
#pragma unroll
            for (int ks = 0; ks < 8; ++ks) {
#pragma unroll
                for (int j = 0; j < 4; ++j) {
                    const pg8::bf16x8 cf = *(const pg8::bf16x8*)(Cb + (size_t)(32 * j + r32) * 128 + 16 * ks + 8 * hi);
                    acc[j] = __builtin_amdgcn_mfma_f32_32x32x16_bf16(cf, qf[ks], acc[j], 0, 0, 0); }
                const v4f n0 = *(const v4f*)(nb_ + 16 * ks + 8 * hi), n1 = *(const v4f*)(nb_ + 16 * ks + 8 * hi + 4);
                const v4u qw = __builtin_bit_cast(v4u, qf[ks]);
                dq += n0.x * __uint_as_float(qw.x << 16) + n0.y * __uint_as_float(qw.x & 0xffff0000u) + n0.z * __uint_as_float(qw.y << 16) + n0.w * __uint_as_float(qw.y & 0xffff0000u)
                    + n1.x * __uint_as_float(qw.z << 16) + n1.y * __uint_as_float(qw.z & 0xffff0000u) + n1.z * __uint_as_float(qw.w << 16) + n1.w * __uint_as_float(qw.w & 0xffff0000u);
            }
            dq += __shfl_xor(dq, 32);
        }
        __syncthreads();
        const float M2 = M2s[l], wint = wis[l], emr = ems[l];
#pragma unroll
        for (int j = 0; j < 4; ++j)
#pragma unroll
            for (int r = 0; r < 16; ++r) acc[j][r] *= wint;
        float ssum = 0.f;
#pragma unroll 1
        for (int st = 0; st <= lt; ++st) {
            f32x16 sa = {0.f, 0.f, 0.f, 0.f, 0.f, 0.f, 0.f, 0.f, 0.f, 0.f, 0.f, 0.f, 0.f, 0.f, 0.f, 0.f};
            const LAS unsigned char* kp = Ks + (32 * st + r32) * KT_STRIDE + 16 * hi;
#pragma unroll
            for (int ks = 0; ks < 8; ++ks) sa = __builtin_amdgcn_mfma_f32_32x32x16_bf16(*(const LAS pg8::bf16x8*)(kp + 32 * ks), qf[ks], sa, 0, 0, 0);
#pragma unroll
            for (int r4 = 0; r4 < 4; ++r4) { const v4f av = *(const LAS v4f*)(a2s + 32 * st + 8 * r4 + 4 * hi);
#pragma unroll
                for (int q = 0; q < 4; ++q) { const int s = 32 * st + 8 * r4 + 4 * hi + q;
                    const float wgt = (s <= l) ? __builtin_amdgcn_exp2f(av[q] - M2) : 0.f; const float sw = sa[4 * r4 + q] * wgt; sa[4 * r4 + q] = sw; ssum += sw; } }
#pragma unroll
            for (int s2 = 0; s2 < 2; ++s2) {
                v4u pw; pw.x = pg8::cvt_pk_bf16(sa[8 * s2 + 0], sa[8 * s2 + 1]); pw.y = pg8::cvt_pk_bf16(sa[8 * s2 + 2], sa[8 * s2 + 3]);
                pw.z = pg8::cvt_pk_bf16(sa[8 * s2 + 4], sa[8 * s2 + 5]); pw.w = pg8::cvt_pk_bf16(sa[8 * s2 + 6], sa[8 * s2 + 7]);
                const pg8::bf16x8 pf = __builtin_bit_cast(pg8::bf16x8, pw);
#pragma unroll
                for (int j = 0; j < 4; ++j) {
                    const LAS unsigned char* vp = Vt + (32 * j + r32) * VT_STRIDE + (32 * st + 16 * s2 + 4 * hi) * 2;
                    const u32x2_t c1 = *(const LAS u32x2_t*)vp, c2 = *(const LAS u32x2_t*)(vp + 16);
                    v4u vw; vw.x = c1.x; vw.y = c1.y; vw.z = c2.x; vw.w = c2.y;
                    acc[j] = __builtin_amdgcn_mfma_f32_32x32x16_bf16(__builtin_bit_cast(pg8::bf16x8, vw), pf, acc[j], 0, 0, 0);
                }
            }
        }
        ssum += __shfl_xor(ssum, 32);
        const float den = wint * dq + ssum; const float inv = 1.f / fmaxf(fabsf(den), emr);
        float s1 = 0.f;
#pragma unroll
        for (int j = 0; j < 4; ++j)
#pragma unroll
            for (int r = 0; r < 16; ++r) { const float hv = acc[j][r] * inv; acc[j][r] = hv; s1 += hv; }
        s1 += __shfl_xor(s1, 32);
        const float mu = s1 * (1.f / 128.f); float s2q = 0.f;
#pragma unroll
        for (int j = 0; j < 4; ++j)
#pragma unroll
            for (int r = 0; r < 16; ++r) { const float dv = acc[j][r] - mu; acc[j][r] = dv; s2q += dv * dv; }
        s2q += __shfl_xor(s2q, 32);
        const float rs = 1.f / sqrtf(s2q * (1.f / 128.f) + LN_EPS);
#pragma unroll
        for (int j = 0; j < 4; ++j)
#pragma unroll
            for (int r4 = 0; r4 < 4; ++r4) { const int e0 = 32 * j + 8 * r4 + 4 * hi;
                const u32x2_t ow = *(const u32x2_t*)(proj + row * NV + PC_MO + h * 128 + e0); const v4f nw = *(const v4f*)(p.norm_w + h * 128 + e0);
                const float o0 = __uint_as_float(ow.x << 16), o1 = __uint_as_float(ow.x & 0xffff0000u), o2 = __uint_as_float(ow.y << 16), o3 = __uint_as_float(ow.y & 0xffff0000u);
                const float y0 = fsigmoid(o0) * acc[j][4 * r4] * rs * nw.x, y1 = fsigmoid(o1) * acc[j][4 * r4 + 1] * rs * nw.y;
                const float y2 = fsigmoid(o2) * acc[j][4 * r4 + 2] * rs * nw.z, y3 = fsigmoid(o3) * acc[j][4 * r4 + 3] * rs * nw.w;
                u32x2_t w; w.x = pg8::cvt_pk_bf16(y0, y1); w.y = pg8::cvt_pk_bf16(y2, y3);
                *(u32x2_t*)(mix + row * DM + h * 128 + e0) = w; }
        __syncthreads();
    }
}
#define GAS __attribute__((address_space(1)))
#define XB_TMO      128
#define XB_XCNT(j)  (256  + 64 * (j))
#define XB_XSUB(j)  (1280 + 64 * (j))
#define XB_XGEN(j)  (2304 + 64 * (j))
#define XB_TOP      3328
#define XB_TOPGEN   3392
#define XCD_BAR_WORDS 3456
#define XB_SPIN_CAP (1u << 18)

__device__ __forceinline__ unsigned xb_ld(unsigned* p)              { return __hip_atomic_load(p, __ATOMIC_RELAXED, __HIP_MEMORY_SCOPE_AGENT); }
__device__ __forceinline__ unsigned xb_add(unsigned* p, unsigned v) { return __hip_atomic_fetch_add(p, v, __ATOMIC_RELAXED, __HIP_MEMORY_SCOPE_AGENT); }
__device__ __forceinline__ unsigned xb_xcc_id() { return (unsigned)__builtin_amdgcn_s_getreg((3 << 11) | 20) & 0xFu; }
#define XB_SPIN(cond, bar) do { unsigned _sp = 0; while (cond) { __builtin_amdgcn_s_sleep(1); \
    if ((++_sp & 255u) == 0u) { if (xb_ld(&(bar)[XB_TMO])) break; if (_sp > XB_SPIN_CAP) { atomicAdd(&(bar)[XB_TMO], 1u); break; } } } } while (0)

struct XcdBarrier {
    unsigned* bar; unsigned x;
    volatile LAS unsigned* st;
};

__device__ __forceinline__ XcdBarrier xcd_barrier_post(unsigned* bar, volatile LAS unsigned* st) {
    XcdBarrier b; b.bar = bar; b.x = xb_xcc_id(); b.st = st;
    if (threadIdx.x == 0) (void)xb_add(&bar[XB_XCNT(b.x)], 1u);
    return b;
}
__device__ __forceinline__ void xcd_barrier_complete(unsigned* bar, unsigned x, unsigned& nloc, unsigned& nx) {
    const unsigned G = gridDim.x * gridDim.y * gridDim.z;
    unsigned sum, cnt, mine, sp = 0u;
    for (;;) {
        sum = 0u; cnt = 0u; mine = 0u;
#pragma unroll
        for (unsigned j = 0; j < 16; ++j) { const unsigned c = xb_ld(&bar[XB_XCNT(j)]); sum += c; cnt += (c > 0u) ? 1u : 0u; mine = (j == x) ? c : mine; }
        if (sum == G) break;
        __builtin_amdgcn_s_sleep(1);
        if ((++sp & 255u) == 0u) { if (xb_ld(&bar[XB_TMO])) break; if (sp > XB_SPIN_CAP) { atomicAdd(&bar[XB_TMO], 1u); break; } }
    }
    nloc = mine > 0u ? mine : 1u; nx = cnt > 0u ? cnt : 1u;
}

__device__ __forceinline__ void xcd_barrier(const XcdBarrier& b) {
    asm volatile("s_waitcnt vmcnt(0)" ::: "memory");
    __syncthreads();
    if (threadIdx.x == 0) {
        unsigned* bar = b.bar;
        __builtin_amdgcn_s_waitcnt(0);
        unsigned nloc = b.st[0], nx = b.st[1];
        if (nloc == 0u) { xcd_barrier_complete(bar, b.x, nloc, nx); b.st[0] = nloc; b.st[1] = nx; }
        const unsigned old = xb_add(&bar[XB_XSUB(b.x)], 1u);
        const unsigned gen = old / nloc;
        if (old + 1u == (gen + 1u) * nloc) {
            __builtin_amdgcn_fence(__ATOMIC_RELEASE, "agent");
            asm volatile("s_waitcnt vmcnt(0)" ::: "memory");
            const unsigned og = xb_add(&bar[XB_TOP], 1u);
            const unsigned tg = og / nx;
            if (og + 1u == (tg + 1u) * nx) xb_add(&bar[XB_TOPGEN], 1u);
            else XB_SPIN(xb_ld(&bar[XB_TOPGEN]) == tg, bar);
            __builtin_amdgcn_fence(__ATOMIC_ACQUIRE, "agent");
            xb_add(&bar[XB_XGEN(b.x)], 1u);
            asm volatile("s_waitcnt vmcnt(0)" ::: "memory");
        } else {
            XB_SPIN(xb_ld(&bar[XB_XGEN(b.x)]) == gen, bar);
            __builtin_amdgcn_fence(__ATOMIC_ACQUIRE, "agent");
            asm volatile("s_waitcnt vmcnt(0)" ::: "memory");
        }
    }
    __syncthreads();
}

extern __shared__ __attribute__((aligned(16))) unsigned char g_lds[];
constexpr int BAR_ST_OFF = 147456 - 64;
constexpr int CW_BAR = 4096;
constexpr size_t CTL_ZERO_BYTES = 65536;
constexpr int LDS_BYTES = 147456;
#ifndef PROBE_DUP
#define PROBE_DUP -1
#endif
#define RUN(k, call) do { call; if (PROBE_DUP == (k)) { __syncthreads(); call; } } while (0);
__global__ void __launch_bounds__(512, 2) mega_fwd(P p) {
    const int bid = blockIdx.x, nb = gridDim.x;
    volatile LAS unsigned* bst = (volatile LAS unsigned*)((LAS unsigned char*)g_lds + BAR_ST_OFF);
    if (threadIdx.x < 2) bst[threadIdx.x] = 0u;
    __syncthreads();
    XcdBarrier bar = xcd_barrier_post((unsigned*)(p.ws + WS_CTL) + CW_BAR, bst);
    RUN(0, ph_prologue(p, g_lds, bid, nb))
    xcd_barrier(bar);
    RUN(1, ph_inproj(p, g_lds, bid, nb))
    ph_convert_rest(p, g_lds);
    xcd_barrier(bar);
    RUN(2, ph_swa(p, g_lds, bid, nb))
    __syncthreads();
    RUN(3, ph_mlstm_a1(p, g_lds, bid, nb))
    xcd_barrier(bar);
    RUN(4, ph_mlstm_a2(p, g_lds, bid, nb))
    xcd_barrier(bar);
    RUN(5, ph_mlstm_b(p, g_lds, bid, nb))
    xcd_barrier(bar);
    RUN(6, ph_outproj(p, g_lds, bid, nb))
    xcd_barrier(bar);
    ph_rowpass1(p, g_lds, bid, nb);
    xcd_barrier(bar);
    RUN(8, ph_moe_gu(p, g_lds, bid, nb))
    xcd_barrier(bar);
    RUN(9, ph_moe_down(p, g_lds, bid, nb))
    xcd_barrier(bar);
    if (PROBE_DUP == 11) { for (int i = 0; i < 10; ++i) xcd_barrier(bar); }
    RUN(10, ph_rowpass2(p, bid, nb))
}

extern "C" void kernel_launch(void* const* d_in, const int* in_sizes, int n_in, void* d_out, int out_size, void* d_ws, size_t ws_size, hipStream_t stream) {
    if (n_in != 19 || in_sizes[0] != T * DM || out_size != T * DM || ws_size < WS_END) {
        fprintf(stderr, "kernel_launch: unexpected shapes (n_in %d in0 %d out %d ws %zu)\n", n_in, n_in > 0 ? in_sizes[0] : -1, out_size, ws_size); return; }
    static int grid_blocks = 0;
    if (!grid_blocks) {
        int dev = 0, cus = 0, per_cu = 0;
        (void)hipGetDevice(&dev);
        (void)hipDeviceGetAttribute(&cus, hipDeviceAttributeMultiprocessorCount, dev);
        (void)hipFuncSetAttribute((const void*)mega_fwd, hipFuncAttributeMaxDynamicSharedMemorySize, LDS_BYTES);
        (void)hipOccupancyMaxActiveBlocksPerMultiprocessor(&per_cu, (const void*)mega_fwd, 512, LDS_BYTES);
        if (per_cu < 1) { fprintf(stderr, "kernel_launch: occupancy query says %d blocks per CU\n", per_cu); per_cu = 1; }
        if (per_cu > 1) per_cu = 1;
        grid_blocks = cus * per_cu;
        (void)hipGetLastError();
    }
    P p{};
    const float** f = (const float**)&p;
    for (int i = 0; i < 19; ++i) f[i] = (const float*)d_in[i];
    p.out = (float*)d_out; p.ws = (unsigned char*)d_ws;
    (void)hipMemsetAsync((char*)d_ws + WS_CTL, 0, CTL_ZERO_BYTES, stream);
    void* args[] = {&p};
    hipError_t e = hipLaunchCooperativeKernel((const void*)mega_fwd, dim3(grid_blocks), dim3(512), args, LDS_BYTES, stream);
    if (e != hipSuccess) fprintf(stderr, "cooperative launch failed: %s (grid %d)\n", hipGetErrorString(e), grid_blocks);
}
```
